# Optimizing an MI355X kernel written in HIP

```python
import math
import jax, jax.numpy as jnp
from jax import lax
import numpy as np

D_MODEL = 2048
BATCH = 4
SEQ = 8192
DEPTH = 4
DEC_BATCH = 1
DEC_SEQ = 8192
PAST_LEN = 128

GRID_W = 64
N_MEM = 256
XA_HEADS = 4
XA_HEAD_DIM = D_MODEL // XA_HEADS
D_SSD = D_MODEL
SSD_HEAD_DIM = 64
SSD_HEADS = D_SSD // SSD_HEAD_DIM
SSD_GROUPS = 4
SSD_STATE = 128
SSD_CONV_W = 5
SSD_CHUNK = 128
SSD_CONV_CH = D_SSD + 2 * SSD_GROUPS * SSD_STATE
ATTN_HEAD_DIM = 128
ATTN_HEADS = D_MODEL // ATTN_HEAD_DIM
ATTN_KV_HEADS = 4
ATTN_Q_GROUP = ATTN_HEADS // ATTN_KV_HEADS
D_ATTN = ATTN_HEADS * ATTN_HEAD_DIM
D_KV = ATTN_KV_HEADS * ATTN_HEAD_DIM
ROPE_THETA = 10000.0
Q_BLOCK = 128
EVEN_IN_W = D_SSD + SSD_CONV_CH + 2 * SSD_HEADS + D_ATTN + 2 * D_KV
EVEN_OUT_W = D_SSD + D_ATTN
HY_SHORT_W = 3
HY_EMB = 33
HY_BANDS = (HY_EMB - 1) // 2
HY_FILTER_W = 64
HY_TARGET = 1e-2
HY_FAST_PCT = 0.3
HY_SLOW_PCT = 1.5
D_FF = 5632
FFN_CONV_W = 3
N_EVEN = (DEPTH + 1) // 2
N_ODD = DEPTH // 2
EPS = 1e-6

kernel_name = "hybrid_ssd_gqa_hyena_encoder"

F32 = jnp.float32


def rms_norm(x, g):
    xf = x.astype(F32)
    y = xf * lax.rsqrt(jnp.mean(xf * xf, axis=-1, keepdims=True) + EPS)
    return (y * g.astype(F32)).astype(x.dtype)


def dwconv_centred(x, w, b):
    width = w.shape[0]
    half = width // 2
    seq = x.shape[1]
    xp = jnp.pad(x, ((0, 0), (half, half), (0, 0)))
    out = xp[:, 0:seq] * w[0]
    for k in range(1, width):
        out = out + xp[:, k:k + seq] * w[k]
    return out + b


def axial_rope_tables(seq):
    rows = seq // GRID_W
    row = jnp.repeat(jnp.arange(rows), GRID_W).astype(F32)
    col = jnp.tile(jnp.arange(GRID_W), rows).astype(F32)
    axis_dim = ATTN_HEAD_DIM // 2
    inv_freq = ROPE_THETA ** (-jnp.arange(0, axis_dim, 2, dtype=F32) / axis_dim)
    ang = jnp.concatenate([row[:, None] * inv_freq, col[:, None] * inv_freq], axis=-1)
    return jnp.cos(ang), jnp.sin(ang)


def apply_rope(x, cos, sin):
    xf = x.astype(F32).reshape(x.shape[:-1] + (-1, 2))
    xe, xo = xf[..., 0], xf[..., 1]
    c = cos[None, :, None, :]
    s = sin[None, :, None, :]
    out = jnp.stack([xe * c - xo * s, xe * s + xo * c], axis=-1)
    return out.reshape(x.shape).astype(x.dtype)


def hyena_pos_features(seq):
    t = jnp.linspace(0.0, 1.0, seq, dtype=F32)
    w = 2.0 * math.pi * jnp.arange(seq, dtype=F32) / seq
    f = jnp.linspace(1e-4, HY_BANDS - 1, HY_BANDS, dtype=F32)
    fw = w[:, None] * f[None, :]
    z = jnp.concatenate([t[:, None], jnp.cos(fw), -jnp.sin(fw)], axis=-1)
    deltas = jnp.abs(jnp.linspace(math.log(HY_TARGET) / HY_SLOW_PCT,
                                  math.log(HY_TARGET) / HY_FAST_PCT, D_MODEL, dtype=F32))
    window = jnp.exp(-t[:, None] * deltas[None, :])
    return z, window


def segsum_exp(cs):
    T = cs.shape[-1]
    diff = cs[..., :, None] - cs[..., None, :]
    mask = jnp.tril(jnp.ones((T, T), dtype=bool))
    return jnp.exp(jnp.where(mask, diff, -jnp.inf))


def ssd_scan(x, dt, a, bm, cm):
    bsz, seq = x.shape[:2]
    nc = seq // SSD_CHUNK
    R = SSD_HEADS // SSD_GROUPS
    dt = dt.astype(F32)
    xc = (x.astype(F32) * dt[..., None]).reshape(bsz, nc, SSD_CHUNK, SSD_GROUPS, R, SSD_HEAD_DIM)
    la = (dt * a.astype(F32)).reshape(bsz, nc, SSD_CHUNK, SSD_GROUPS, R).transpose(0, 3, 4, 1, 2)
    bc = bm.astype(F32).reshape(bsz, nc, SSD_CHUNK, SSD_GROUPS, SSD_STATE)
    cc = cm.astype(F32).reshape(bsz, nc, SSD_CHUNK, SSD_GROUPS, SSD_STATE)
    cs = jnp.cumsum(la, axis=-1)
    cb = jnp.einsum('bclgn,bcsgn->bgcls', cc, bc)
    wgt = cb[:, :, None] * segsum_exp(cs)
    y_diag = jnp.einsum('bgrcls,bcsgrp->bclgrp', wgt, xc)
    ds = jnp.exp(cs[..., -1:] - cs).transpose(0, 3, 4, 1, 2)
    states = jnp.einsum('bcsgn,bcsgrp->bcgrpn', bc, xc * ds[..., None])
    chunk_tot = jnp.pad(cs[..., -1], ((0, 0), (0, 0), (0, 0), (1, 0)))
    decay_chunk = segsum_exp(jnp.cumsum(chunk_tot, axis=-1))
    states = jnp.concatenate([jnp.zeros_like(states[:, :1]), states], axis=1)
    states_in = jnp.einsum('bgrzc,bcgrpn->bzgrpn', decay_chunk, states)[:, :-1]
    y_off = jnp.einsum('bclgn,bcgrpn->bclgrp', cc, states_in) * jnp.exp(cs).transpose(0, 3, 4, 1, 2)[..., None]
    return (y_diag + y_off).reshape(bsz, seq, SSD_HEADS, SSD_HEAD_DIM)


def block_attention(q, k, v):
    bsz, seq = q.shape[:2]
    nb = seq // Q_BLOCK
    scale = ATTN_HEAD_DIM ** -0.5
    qb = jnp.moveaxis(q.reshape(bsz, nb, Q_BLOCK, ATTN_KV_HEADS, ATTN_Q_GROUP, ATTN_HEAD_DIM), 1, 0)

    def one_block(qblk):
        s = jnp.einsum('bqkgd,bskd->bkgqs', qblk, k).astype(F32) * scale
        p = jax.nn.softmax(s, axis=-1).astype(v.dtype)
        return jnp.einsum('bkgqs,bskd->bqkgd', p, v)

    ob = lax.map(one_block, qb)
    return jnp.moveaxis(ob, 0, 1).reshape(bsz, seq, D_ATTN)


def ssd_attn_mixer(h, rope, w_in, w_out, conv_w, conv_b, a_log, dt_bias, d_skip, ssd_norm, q_norm, k_norm):
    bsz, seq = h.shape[:2]
    cos, sin = rope
    proj = h @ w_in
    o1 = D_SSD
    o2 = o1 + SSD_CONV_CH
    o3 = o2 + 2 * SSD_HEADS
    o4 = o3 + D_ATTN
    o5 = o4 + D_KV
    z, xbc, dt, q, k, v = jnp.split(proj, [o1, o2, o3, o4, o5], axis=-1)
    xbc = jax.nn.silu(dwconv_centred(xbc, conv_w, conv_b))
    xs, bm, cm = jnp.split(xbc, [D_SSD, D_SSD + SSD_GROUPS * SSD_STATE], axis=-1)
    xs = xs.reshape(bsz, seq, SSD_HEADS, SSD_HEAD_DIM)
    bm = bm.reshape(bsz, seq, SSD_GROUPS, SSD_STATE)
    cm = cm.reshape(bsz, seq, SSD_GROUPS, SSD_STATE)
    dt_f = jax.nn.softplus(dt[..., :SSD_HEADS] + dt_bias[0])
    dt_b = jax.nn.softplus(dt[..., SSD_HEADS:] + dt_bias[1])
    a_f = -jnp.exp(a_log[0].astype(F32))
    a_b = -jnp.exp(a_log[1].astype(F32))
    flip = lambda t: jnp.flip(t, axis=1)
    y = (ssd_scan(xs, dt_f, a_f, bm, cm)
         + flip(ssd_scan(flip(xs), flip(dt_b), a_b, flip(bm), flip(cm)))
         + xs.astype(F32) * d_skip.astype(F32)[:, None])
    y = y.reshape(bsz, seq, D_SSD).astype(h.dtype)
    y_ssd = rms_norm(y * jax.nn.silu(z), ssd_norm)
    q = apply_rope(rms_norm(q.reshape(bsz, seq, ATTN_HEADS, ATTN_HEAD_DIM), q_norm), cos, sin)
    k = apply_rope(rms_norm(k.reshape(bsz, seq, ATTN_KV_HEADS, ATTN_HEAD_DIM), k_norm), cos, sin)
    v = v.reshape(bsz, seq, ATTN_KV_HEADS, ATTN_HEAD_DIM)
    q = q.reshape(bsz, seq, ATTN_KV_HEADS, ATTN_Q_GROUP, ATTN_HEAD_DIM)
    y_attn = block_attention(q, k, v)
    return jnp.concatenate([y_ssd, y_attn], axis=-1) @ w_out


def hyena_kernel(z, window, w1, b1, w2, b2, w3, b3, freq, w_out):
    h = jnp.sin(freq * (z @ w1 + b1))
    h = jnp.sin(freq * (h @ w2 + b2))
    h = jnp.sin(freq * (h @ w3 + b3))
    h = (h @ w_out).astype(F32)
    h_fwd = h[:, :D_MODEL] * window
    h_bwd = h[:, D_MODEL:] * window
    kern = jnp.concatenate([h_fwd, jnp.zeros((1, D_MODEL), F32), h_bwd[:0:-1]], axis=0)
    return kern / jnp.sum(jnp.abs(kern), axis=0, keepdims=True)


def bidir_long_conv(u, kern, skip):
    seq = u.shape[1]
    n = 2 * seq
    uf = jnp.fft.rfft(u.astype(F32), n=n, axis=1)
    kf = jnp.fft.rfft(kern, n=n, axis=0)
    y = jnp.fft.irfft(uf * kf[None], n=n, axis=1)[:, :seq]
    return (y + u.astype(F32) * skip.astype(F32)).astype(u.dtype)


def hyena_mixer(h, hz, window, w_in, conv_w, conv_b, f_w1, f_b1, f_w2, f_b2, f_w3, f_b3, f_freq, f_w_out, skip, w_out):
    u = dwconv_centred(h @ w_in, conv_w, conv_b)
    x0, x1, v = jnp.split(u, 3, axis=-1)
    kern = hyena_kernel(hz, window, f_w1, f_b1, f_w2, f_b2, f_w3, f_b3, f_freq, f_w_out)
    y = x0 * bidir_long_conv(v * x1, kern, skip)
    return y @ w_out


def memory_cross_attention(h, mem_n, wq, wk, wv, wo):
    bsz, seq = h.shape[:2]
    n_mem = mem_n.shape[1]
    q = (h @ wq).reshape(bsz, seq, XA_HEADS, XA_HEAD_DIM)
    k = (mem_n @ wk).reshape(bsz, n_mem, XA_HEADS, XA_HEAD_DIM)
    v = (mem_n @ wv).reshape(bsz, n_mem, XA_HEADS, XA_HEAD_DIM)
    s = jnp.einsum('blhd,bmhd->bhlm', q, k).astype(F32) * (XA_HEAD_DIM ** -0.5)
    p = jax.nn.softmax(s, axis=-1).astype(v.dtype)
    o = jnp.einsum('bhlm,bmhd->blhd', p, v).reshape(bsz, seq, D_MODEL)
    return o @ wo


def conv_ffn(h, w_in, conv_w, conv_b, w_out):
    u = dwconv_centred(h @ w_in, conv_w, conv_b)
    g, up = jnp.split(u, 2, axis=-1)
    return (jax.nn.silu(g) * up) @ w_out


def trunk(x, mem, prm):
    seq = x.shape[1]
    rope = axial_rope_tables(seq)
    hz, window = hyena_pos_features(seq)
    for i in range(DEPTH):
        h = rms_norm(x, prm['norm_mix'][i])
        if i % 2 == 0:
            e = i // 2
            x = x + ssd_attn_mixer(h, rope, prm['mix_w_in'][e], prm['mix_w_out'][e],
                                   prm['ssd_conv_w'][e], prm['ssd_conv_b'][e], prm['ssd_a_log'][e],
                                   prm['ssd_dt_bias'][e], prm['ssd_d'][e], prm['ssd_norm'][e],
                                   prm['attn_q_norm'][e], prm['attn_k_norm'][e])
        else:
            o = i // 2
            x = x + hyena_mixer(h, hz, window, prm['hy_w_in'][o], prm['hy_conv_w'][o], prm['hy_conv_b'][o],
                                prm['hy_f_w1'][o], prm['hy_f_b1'][o], prm['hy_f_w2'][o], prm['hy_f_b2'][o],
                                prm['hy_f_w3'][o], prm['hy_f_b3'][o], prm['hy_f_freq'][o], prm['hy_f_w_out'][o],
                                prm['hy_skip'][o], prm['hy_w_out'][o])
        x = x + memory_cross_attention(rms_norm(x, prm['norm_xa'][i]), rms_norm(mem, prm['norm_mem'][i]),
                                       prm['xa_wq'][i], prm['xa_wk'][i], prm['xa_wv'][i], prm['xa_wo'][i])
        x = x + conv_ffn(rms_norm(x, prm['norm_ffn'][i]), prm['ffn_w_in'][i], prm['ffn_conv_w'][i],
                         prm['ffn_conv_b'][i], prm['ffn_w_out'][i])
    return rms_norm(x, prm['final_norm'])


def setup_inputs(seed: int = 0) -> dict:
    key = jax.random.key(seed)
    ks = iter(jax.random.split(key, 64))

    def w(shape, fan_in):
        return jax.random.normal(next(ks), shape, F32) * (fan_in ** -0.5)

    def gain(shape):
        return 1.0 + 0.02 * jax.random.normal(next(ks), shape, F32)

    def small(shape):
        return 0.01 * jax.random.normal(next(ks), shape, F32)

    F2 = 2 * D_FF
    dt0 = jnp.exp(jax.random.uniform(next(ks), (N_EVEN, 2, SSD_HEADS), F32, math.log(1e-3), math.log(1e-1)))
    dt_bias = dt0 + jnp.log(-jnp.expm1(-dt0))
    a_log = jnp.log(jax.random.uniform(next(ks), (N_EVEN, 2, SSD_HEADS), F32, 1.0, 16.0))
    return {
        'x_prompt': jax.random.normal(next(ks), (BATCH, SEQ, D_MODEL), F32),
        'x_sample': jax.random.normal(next(ks), (DEC_BATCH, DEC_SEQ, D_MODEL), F32),
        'mem_prompt': jax.random.normal(next(ks), (BATCH, N_MEM, D_MODEL), F32),
        'mem_sample': jax.random.normal(next(ks), (DEC_BATCH, N_MEM, D_MODEL), F32),
        'norm_mix': gain((DEPTH, D_MODEL)),
        'norm_xa': gain((DEPTH, D_MODEL)),
        'norm_mem': gain((DEPTH, D_MODEL)),
        'norm_ffn': gain((DEPTH, D_MODEL)),
        'xa_wq': w((DEPTH, D_MODEL, D_MODEL), D_MODEL),
        'xa_wk': w((DEPTH, D_MODEL, D_MODEL), D_MODEL),
        'xa_wv': w((DEPTH, D_MODEL, D_MODEL), D_MODEL),
        'xa_wo': w((DEPTH, D_MODEL, D_MODEL), D_MODEL),
        'ffn_w_in': w((DEPTH, D_MODEL, F2), D_MODEL),
        'ffn_conv_w': w((DEPTH, FFN_CONV_W, F2), FFN_CONV_W),
        'ffn_conv_b': small((DEPTH, F2)),
        'ffn_w_out': w((DEPTH, D_FF, D_MODEL), D_FF),
        'mix_w_in': w((N_EVEN, D_MODEL, EVEN_IN_W), D_MODEL),
        'mix_w_out': w((N_EVEN, EVEN_OUT_W, D_MODEL), EVEN_OUT_W),
        'ssd_conv_w': w((N_EVEN, SSD_CONV_W, SSD_CONV_CH), SSD_CONV_W),
        'ssd_conv_b': small((N_EVEN, SSD_CONV_CH)),
        'ssd_a_log': a_log,
        'ssd_dt_bias': dt_bias,
        'ssd_d': gain((N_EVEN, SSD_HEADS)),
        'ssd_norm': gain((N_EVEN, D_SSD)),
        'attn_q_norm': gain((N_EVEN, ATTN_HEAD_DIM)),
        'attn_k_norm': gain((N_EVEN, ATTN_HEAD_DIM)),
        'hy_w_in': w((N_ODD, D_MODEL, 3 * D_MODEL), D_MODEL),
        'hy_conv_w': w((N_ODD, HY_SHORT_W, 3 * D_MODEL), HY_SHORT_W),
        'hy_conv_b': small((N_ODD, 3 * D_MODEL)),
        'hy_f_w1': w((N_ODD, HY_EMB, HY_FILTER_W), HY_EMB),
        'hy_f_b1': small((N_ODD, HY_FILTER_W)),
        'hy_f_w2': w((N_ODD, HY_FILTER_W, HY_FILTER_W), HY_FILTER_W),
        'hy_f_b2': small((N_ODD, HY_FILTER_W)),
        'hy_f_w3': w((N_ODD, HY_FILTER_W, HY_FILTER_W), HY_FILTER_W),
        'hy_f_b3': small((N_ODD, HY_FILTER_W)),
        'hy_f_freq': gain((N_ODD, HY_FILTER_W)),
        'hy_f_w_out': w((N_ODD, HY_FILTER_W, 2 * D_MODEL), HY_FILTER_W),
        'hy_skip': jax.random.normal(next(ks), (N_ODD, D_MODEL), F32),
        'hy_w_out': w((N_ODD, D_MODEL, D_MODEL), D_MODEL),
        'final_norm': gain((D_MODEL,)),
    }


def reference(x_prompt, x_sample, mem_prompt, mem_sample, norm_mix, norm_xa, norm_mem, norm_ffn,
              xa_wq, xa_wk, xa_wv, xa_wo, ffn_w_in, ffn_conv_w, ffn_conv_b, ffn_w_out,
              mix_w_in, mix_w_out, ssd_conv_w, ssd_conv_b, ssd_a_log, ssd_dt_bias, ssd_d, ssd_norm,
              attn_q_norm, attn_k_norm, hy_w_in, hy_conv_w, hy_conv_b, hy_f_w1, hy_f_b1, hy_f_w2, hy_f_b2,
              hy_f_w3, hy_f_b3, hy_f_freq, hy_f_w_out, hy_skip, hy_w_out, final_norm):
    prm = dict(norm_mix=norm_mix, norm_xa=norm_xa, norm_mem=norm_mem, norm_ffn=norm_ffn,
               xa_wq=xa_wq, xa_wk=xa_wk, xa_wv=xa_wv, xa_wo=xa_wo,
               ffn_w_in=ffn_w_in, ffn_conv_w=ffn_conv_w, ffn_conv_b=ffn_conv_b, ffn_w_out=ffn_w_out,
               mix_w_in=mix_w_in, mix_w_out=mix_w_out, ssd_conv_w=ssd_conv_w, ssd_conv_b=ssd_conv_b,
               ssd_a_log=ssd_a_log, ssd_dt_bias=ssd_dt_bias, ssd_d=ssd_d, ssd_norm=ssd_norm,
               attn_q_norm=attn_q_norm, attn_k_norm=attn_k_norm,
               hy_w_in=hy_w_in, hy_conv_w=hy_conv_w, hy_conv_b=hy_conv_b,
               hy_f_w1=hy_f_w1, hy_f_b1=hy_f_b1, hy_f_w2=hy_f_w2, hy_f_b2=hy_f_b2,
               hy_f_w3=hy_f_w3, hy_f_b3=hy_f_b3, hy_f_freq=hy_f_freq, hy_f_w_out=hy_f_w_out,
               hy_skip=hy_skip, hy_w_out=hy_w_out, final_norm=final_norm)
    y_prompt = trunk(x_prompt, mem_prompt, prm)
    y_sample = trunk(x_sample, mem_sample, prm)
    return (y_prompt, y_sample)
```

```cpp
#include <hip/hip_runtime.h>
#include <cstdio>
#include <cstdint>
#ifndef MK_FUSED
#define MK_FUSED 1
#endif
#ifndef MK_FPAR
#define MK_FPAR 0
#endif
#ifndef MK_FSET
#define MK_FSET 0x8u
#endif
#ifndef MK_CUTS
#define MK_CUTS 0, 128
#endif

#define GAS __attribute__((address_space(1)))
#define LAS __attribute__((address_space(3)))
typedef unsigned short bf16_t;
typedef short bf16x8 __attribute__((ext_vector_type(8)));
typedef short s16x4 __attribute__((ext_vector_type(4)));
typedef float f32x4 __attribute__((ext_vector_type(4)));
typedef float f32x2 __attribute__((ext_vector_type(2)));
typedef float f32x16 __attribute__((ext_vector_type(16)));
typedef unsigned u32x4 __attribute__((ext_vector_type(4)));
typedef unsigned u32x2 __attribute__((ext_vector_type(2)));

constexpr int DM = 2048, SEQ = 8192, NSEQ = 5, T = NSEQ * SEQ, NMEM = 256, MROWS = NSEQ * NMEM;
constexpr int XAH = 4, XAD = 512;
constexpr int SSH = 32, SSP = 64, SSG = 4, SSN = 128, SSQ = 128, NCH = SEQ / SSQ;
constexpr int AH = 16, AKV = 4, AD = 128;
constexpr int PW = 8192, PC_Z = 0, PC_Q = 2048, PC_X = 4096, PC_K = 7168, PC_V = 7680;
constexpr int DFF = 5632, F2 = 11264, HYW = 6144;
constexpr int FCH = 20480, FCHP = 81;
constexpr float EPS = 1e-6f;
constexpr int FFTN = 16384;

constexpr size_t MiB = 1u << 20;
constexpr size_t WS_CTL = 0, CTL_BYTES = 1 * MiB;
constexpr size_t WS_TW = 1 * MiB;
constexpr size_t WS_H3 = 2 * MiB;
constexpr size_t WS_MEMN = 4 * MiB, WS_MK = 9 * MiB, WS_MV = 14 * MiB;
constexpr size_t WS_DT = 19 * MiB;
constexpr size_t WS_TOT = 29 * MiB;
constexpr size_t WS_W = 32 * MiB;
constexpr size_t W_IN = WS_W, W_DT = WS_W + 32 * MiB, W_OUT = WS_W + 33 * MiB;
constexpr size_t HW_IN = WS_W, HW_OUT = WS_W + 24 * MiB;
constexpr size_t W_Q = WS_W + 49 * MiB, W_K = WS_W + 57 * MiB, W_V = WS_W + 65 * MiB, W_O = WS_W + 73 * MiB, W_FIN = WS_W + 81 * MiB, W_FOUT = WS_W + 125 * MiB;
constexpr size_t WS_H = 184 * MiB;
constexpr size_t WS_BIG = 344 * MiB;
constexpr size_t WS_PROJ = WS_BIG, WS_BC = WS_BIG + 640 * MiB, WS_STF = WS_BIG + 720 * MiB, WS_STB = WS_BIG + 880 * MiB;
constexpr size_t WS_SC = WS_BIG + 160 * MiB, WS_P = WS_BIG + 320 * MiB;
constexpr size_t WS_PS = WS_BIG + 700 * MiB;
constexpr size_t WS_WQK = WS_BIG + 640 * MiB, WS_VWOT = WS_BIG + 660 * MiB;
constexpr size_t WS_ACT = WS_BIG, WS_SB = WS_BIG + 440 * MiB;
constexpr size_t WS_PHY = WS_BIG, WS_UT = WS_BIG + 480 * MiB, WS_KERN = WS_BIG + 640 * MiB, WS_KS = WS_BIG + 768 * MiB;
constexpr size_t WS_END = WS_BIG + 1040 * MiB;
static_assert(W_FOUT + (size_t)DM * DFF * 2 <= WS_H, "weights region");
static_assert(WS_ACT + (size_t)T * DFF * 2 <= WS_SB && WS_SB + (size_t)(T / 64) * 4 * F2 * 2 <= WS_END && WS_KERN + (size_t)DM * FFTN * 4 <= WS_END, "big region");

constexpr int LDS_BYTES = 163840, LDS_CTL = 161792;

__device__ __forceinline__ float bf2f(unsigned b) { return __uint_as_float(b << 16); }
__device__ __forceinline__ float bflo(unsigned w) { return __uint_as_float(w << 16); }
__device__ __forceinline__ float bfhi(unsigned w) { return __uint_as_float(w & 0xffff0000u); }
__device__ __forceinline__ unsigned cvt_pk_bf16(float lo, float hi) { unsigned r; asm volatile("v_cvt_pk_bf16_f32 %0, %1, %2" : "=v"(r) : "v"(lo), "v"(hi)); return r; }
typedef __bf16 bf16x2_t __attribute__((ext_vector_type(2)));
__device__ __forceinline__ unsigned cvt_pk_c(float lo, float hi) { f32x2 v; v.x = lo; v.y = hi; bf16x2_t r = __builtin_convertvector(v, bf16x2_t); return __builtin_bit_cast(unsigned, r); }
__device__ __forceinline__ unsigned short f2bf(float f) { return (unsigned short)(cvt_pk_bf16(f, 0.f) & 0xffffu); }
__device__ __forceinline__ float wave_sum(float v) {
#pragma unroll
    for (int o = 1; o < 64; o <<= 1) v += __shfl_xor(v, o);
    return v;
}
__device__ __forceinline__ float wave_max(float v) {
#pragma unroll
    for (int o = 1; o < 64; o <<= 1) v = fmaxf(v, __shfl_xor(v, o));
    return v;
}
__device__ __forceinline__ float silu_f(float x) { return x * __builtin_amdgcn_rcpf(1.f + __builtin_amdgcn_exp2f(x * -1.4426950408889634f)); }
__device__ __forceinline__ void unpack8(const u32x4 w, float (&f)[8]) {
    f[0] = bflo(w.x); f[1] = bfhi(w.x); f[2] = bflo(w.y); f[3] = bfhi(w.y); f[4] = bflo(w.z); f[5] = bfhi(w.z); f[6] = bflo(w.w); f[7] = bfhi(w.w);
}
__device__ __forceinline__ u32x4 pack8(const float (&f)[8]) {
    u32x4 w; w.x = cvt_pk_bf16(f[0], f[1]); w.y = cvt_pk_bf16(f[2], f[3]); w.z = cvt_pk_bf16(f[4], f[5]); w.w = cvt_pk_bf16(f[6], f[7]); return w;
}
#define LDS_WAIT() asm volatile("s_waitcnt lgkmcnt(0)" ::: "memory")
#define LDS_BARRIER() do { asm volatile("s_waitcnt lgkmcnt(0)" ::: "memory"); __builtin_amdgcn_s_barrier(); asm volatile("" ::: "memory"); } while (0)
#define VM_WAIT() asm volatile("s_waitcnt vmcnt(0)" ::: "memory")
namespace pg8 {
constexpr int BM = 256, BK = 64, HALF = 128, HTB = HALF * BK * 2, STAGE_BYTES = 8 * HTB, NXCD = 8, WGM = 8;
__host__ __device__ __forceinline__ int lds_byte(int r, int c) { const int st = (r >> 4) * 2 + (c >> 5), rr = r & 15, cc = c & 31, ob = rr * 64 + cc * 2; return st * 1024 + (ob ^ (((ob >> 9) & 1) << 5)); }
__host__ __device__ __forceinline__ void stage_rc(int b, int& R, int& C) { const int st = b / 1024, sb = b % 1024, swz = sb ^ (((sb >> 9) & 1) << 5); R = (st >> 1) * 16 + swz / 64; C = (st & 1) * 32 + (swz % 64) / 2; }
__host__ __device__ __forceinline__ int perm32(int rho) { const int n = rho >> 4, i = rho & 15; return 8 * (i >> 2) + 4 * n + (i & 3); }

struct Unit { int pm, pn, z; };
struct Gemm { const bf16_t* A; const bf16_t* Bt; int lda, ldb, K, nM, nN, nZ, zdiv; long aZhi, aZlo, bZhi, bZlo; };
__device__ __forceinline__ const char* a_ptr(const Gemm& g, const Unit& u) { return (const char*)g.A + ((size_t)(u.z / g.zdiv) * g.aZhi + (size_t)(u.z % g.zdiv) * g.aZlo + (size_t)u.pm * BM * g.lda) * 2; }
__device__ __forceinline__ const char* b_ptr(const Gemm& g, const Unit& u) { return (const char*)g.Bt + ((size_t)(u.z / g.zdiv) * g.bZhi + (size_t)(u.z % g.zdiv) * g.bZlo + (size_t)u.pn * BM * g.ldb) * 2; }

struct Order {
    int nM, nN, per, nwg, G, c;
    __device__ __forceinline__ void init(const Gemm& g, int G_, int c_) { nM = g.nM; nN = g.nN; per = nM * nN; nwg = per * g.nZ; G = G_; c = c_; }
    __device__ __forceinline__ bool next(int i, Unit& u) const {
        const long Lid = (long)i * G + c; if (Lid >= nwg) return false;
        u.z = (int)(Lid / per); int wgid = (int)(Lid % per);
        { const int q = per / NXCD, r = per % NXCD, xcd = wgid % NXCD, off = wgid / NXCD; wgid = (xcd < r ? xcd * (q + 1) : r * (q + 1) + (xcd - r) * q) + off; }
        const int nig = WGM * nN, gid = wgid / nig, fm = gid * WGM, gsz = (nM - fm) < WGM ? (nM - fm) : WGM;
        u.pm = fm + ((wgid % nig) % gsz); u.pn = (wgid % nig) / gsz; return true;
    }
};

struct EpiBf16 {
    static constexpr bool PERM = true; static constexpr bool PERMA = false;
    bf16_t* O; int ldc, zdiv; long cZhi, cZlo; float scale;
    __device__ __forceinline__ void operator()(const f32x4 (&acc)[2][2][4][2], const Unit& u, int wr, int wc, int fr, int fq) const {
        bf16_t* base = O + (size_t)(u.z / zdiv) * cZhi + (size_t)(u.z % zdiv) * cZlo;
        const int row0 = u.pm * BM + wr * 64 + fr, col0 = u.pn * BM + wc * 32 + 8 * fq;
#pragma unroll
        for (int ai = 0; ai < 2; ++ai)
#pragma unroll
            for (int m = 0; m < 4; ++m) { bf16_t* rowp = base + (size_t)(row0 + ai * HALF + m * 16) * ldc + col0;
#pragma unroll
                for (int bj = 0; bj < 2; ++bj) { const f32x4 v0 = acc[ai][bj][m][0] * scale, v1 = acc[ai][bj][m][1] * scale;
                    u32x4 w; w.x = cvt_pk_bf16(v0[0], v0[1]); w.y = cvt_pk_bf16(v0[2], v0[3]); w.z = cvt_pk_bf16(v1[0], v1[1]); w.w = cvt_pk_bf16(v1[2], v1[3]);
                    *(u32x4*)(rowp + bj * HALF) = w; } }
    }
};
struct EpiF32 {
    static constexpr bool PERM = false; static constexpr bool PERMA = false;
    float* C; int ldc, zdiv; long cZhi, cZlo; float scale;
    __device__ __forceinline__ void operator()(const f32x4 (&acc)[2][2][4][2], const Unit& u, int wr, int wc, int fr, int fq) const {
        float* base = C + (size_t)(u.z / zdiv) * cZhi + (size_t)(u.z % zdiv) * cZlo;
        const int row0 = u.pm * BM + wr * 64 + fr, col0 = u.pn * BM + wc * 32 + 4 * fq;
#pragma unroll
        for (int ai = 0; ai < 2; ++ai)
#pragma unroll
            for (int m = 0; m < 4; ++m) { float* rowp = base + (size_t)(row0 + ai * HALF + m * 16) * ldc + col0;
#pragma unroll
                for (int bj = 0; bj < 2; ++bj)
#pragma unroll
                    for (int n = 0; n < 2; ++n) *(f32x4*)(rowp + bj * HALF + n * 16) = acc[ai][bj][m][n] * scale; }
    }
};
struct EpiResAdd {
    static constexpr bool PERM = true; static constexpr bool PERMA = false;
    bf16_t* X; int ldc; long cZ;
    __device__ __forceinline__ void operator()(const f32x4 (&acc)[2][2][4][2], const Unit& u, int wr, int wc, int fr, int fq) const {
        const int row0 = u.pm * BM + wr * 64 + fr, col0 = u.pn * BM + wc * 32 + 8 * fq;
#pragma unroll
        for (int ai = 0; ai < 2; ++ai) {
            u32x4 old[4][2];
#pragma unroll
            for (int m = 0; m < 4; ++m)
#pragma unroll
                for (int bj = 0; bj < 2; ++bj) old[m][bj] = *(const u32x4*)(X + (size_t)u.z * cZ + (size_t)(row0 + ai * HALF + m * 16) * ldc + col0 + bj * HALF);
#pragma unroll
            for (int m = 0; m < 4; ++m)
#pragma unroll
                for (int bj = 0; bj < 2; ++bj) { float v[8]; unpack8(old[m][bj], v);
                    const f32x4 a0 = acc[ai][bj][m][0], a1 = acc[ai][bj][m][1];
                    u32x4 w; w.x = cvt_pk_c(v[0] + a0[0], v[1] + a0[1]); w.y = cvt_pk_c(v[2] + a0[2], v[3] + a0[3]); w.z = cvt_pk_c(v[4] + a1[0], v[5] + a1[1]); w.w = cvt_pk_c(v[6] + a1[2], v[7] + a1[3]);
                    *(u32x4*)(X + (size_t)u.z * cZ + (size_t)(row0 + ai * HALF + m * 16) * ldc + col0 + bj * HALF) = w; }
            asm volatile("" ::: "memory"); }
    }
};
struct EpiResAddPS {
    static constexpr bool PERM = true; static constexpr bool PERMA = false;
    bf16_t* X; int ldc; float* PS;
    __device__ __forceinline__ void operator()(const f32x4 (&acc)[2][2][4][2], const Unit& u, int wr, int wc, int fr, int fq) const {
        const int row0 = u.pm * BM + wr * 64 + fr, col0 = u.pn * BM + wc * 32 + 8 * fq;
#pragma unroll
        for (int ai = 0; ai < 2; ++ai) {
            u32x4 old[4][2];
#pragma unroll
            for (int m = 0; m < 4; ++m)
#pragma unroll
                for (int bj = 0; bj < 2; ++bj) old[m][bj] = *(const u32x4*)(X + (size_t)(row0 + ai * HALF + m * 16) * ldc + col0 + bj * HALF);
#pragma unroll
            for (int m = 0; m < 4; ++m) { float ss = 0.f;
#pragma unroll
                for (int bj = 0; bj < 2; ++bj) { float v[8]; unpack8(old[m][bj], v);
                    const f32x4 a0 = acc[ai][bj][m][0], a1 = acc[ai][bj][m][1];
                    v[0] += a0[0]; v[1] += a0[1]; v[2] += a0[2]; v[3] += a0[3]; v[4] += a1[0]; v[5] += a1[1]; v[6] += a1[2]; v[7] += a1[3];
                    ss += ((v[0] * v[0] + v[1] * v[1]) + (v[2] * v[2] + v[3] * v[3])) + ((v[4] * v[4] + v[5] * v[5]) + (v[6] * v[6] + v[7] * v[7]));
                    u32x4 w; w.x = cvt_pk_c(v[0], v[1]); w.y = cvt_pk_c(v[2], v[3]); w.z = cvt_pk_c(v[4], v[5]); w.w = cvt_pk_c(v[6], v[7]);
                    *(u32x4*)(X + (size_t)(row0 + ai * HALF + m * 16) * ldc + col0 + bj * HALF) = w; }
                ss += __shfl_xor(ss, 16); ss += __shfl_xor(ss, 32);
                if (fq == 0) PS[(size_t)(row0 + ai * HALF + m * 16) * 32 + u.pn * 4 + wc] = ss; }
            asm volatile("" ::: "memory"); }
    }
};
struct EpiBf16G {
    static constexpr bool PERM = true; static constexpr bool PERMA = false;
    bf16_t* O; int ldc, zdiv; long cZhi, cZlo; const float* cg;
    __device__ __forceinline__ void operator()(const f32x4 (&acc)[2][2][4][2], const Unit& u, int wr, int wc, int fr, int fq) const {
        bf16_t* base = O + (size_t)(u.z / zdiv) * cZhi + (size_t)(u.z % zdiv) * cZlo;
        const int row0 = u.pm * BM + wr * 64 + fr, col0 = u.pn * BM + wc * 32 + 8 * fq;
        f32x4 gn[2][2];
#pragma unroll
        for (int bj = 0; bj < 2; ++bj) { gn[bj][0] = *(const f32x4*)(cg + col0 + bj * HALF); gn[bj][1] = *(const f32x4*)(cg + col0 + bj * HALF + 4); }
#pragma unroll
        for (int ai = 0; ai < 2; ++ai)
#pragma unroll
            for (int m = 0; m < 4; ++m) { bf16_t* rowp = base + (size_t)(row0 + ai * HALF + m * 16) * ldc + col0;
#pragma unroll
                for (int bj = 0; bj < 2; ++bj) { const f32x4 v0 = acc[ai][bj][m][0] * gn[bj][0], v1 = acc[ai][bj][m][1] * gn[bj][1];
                    u32x4 w; w.x = cvt_pk_c(v0[0], v0[1]); w.y = cvt_pk_c(v0[2], v0[3]); w.z = cvt_pk_c(v1[0], v1[1]); w.w = cvt_pk_c(v1[2], v1[3]);
                    *(u32x4*)(rowp + bj * HALF) = w; } }
    }
};
struct EpiDt {
    static constexpr bool PERM = false; static constexpr bool PERMA = false;
    float* DT; const float* bias;
    __device__ __forceinline__ void operator()(const f32x4 (&acc)[2][2][4][2], const Unit& u, int wr, int wc, int fr, int fq) const {
        if (wc >= 2 || u.pn != 0) return;
        const int row0 = u.pm * BM + wr * 64 + fr, col0 = wc * 32 + 4 * fq;
#pragma unroll
        for (int ai = 0; ai < 2; ++ai)
#pragma unroll
            for (int m = 0; m < 4; ++m) { float* rowp = DT + (size_t)(row0 + ai * HALF + m * 16) * 64 + col0;
#pragma unroll
                for (int n = 0; n < 2; ++n) { const f32x4 bv = *(const f32x4*)(bias + col0 + n * 16); f32x4 v = acc[ai][0][m][n] + bv;
#pragma unroll
                    for (int j = 0; j < 4; ++j) v[j] = v[j] > 20.f ? v[j] : log1pf(__expf(v[j]));
                    *(f32x4*)(rowp + n * 16) = v; } }
    }
};

struct EpiFfnGate {
    static constexpr bool PERM = true; static constexpr bool PERMA = true;
    bf16_t* ACT; bf16_t* SB; const float* cw; const float* cb;
    __device__ __forceinline__ void operator()(const f32x4 (&acc)[2][2][4][2], const Unit& u, int wr, int wc, int fr, int fq) const {
        const int lane = fr + 16 * fq, src_prev = (lane & 48) | ((fr + 15) & 15), src_next = (lane & 48) | ((fr + 1) & 15);
        f32x4 wgs[2][3], wus[2][3], bgs[2], bus[2];
#pragma unroll
        for (int n = 0; n < 2; ++n) { const int f = u.pn * 128 + wc * 32 + 8 * fq + 4 * n;
#pragma unroll
            for (int k = 0; k < 3; ++k) { wgs[n][k] = *(const f32x4*)(cw + k * F2 + f); wus[n][k] = *(const f32x4*)(cw + k * F2 + DFF + f); }
            bgs[n] = *(const f32x4*)(cb + f); bus[n] = *(const f32x4*)(cb + DFF + f); }
#pragma unroll
        for (int n = 0; n < 2; ++n) {
            const int f = u.pn * 128 + wc * 32 + 8 * fq + 4 * n;
            const f32x4 (&wg)[3] = wgs[n]; const f32x4 (&wu)[3] = wus[n]; const f32x4 bg = bgs[n], bu = bus[n];
#pragma unroll
            for (int ai = 0; ai < 2; ++ai) {
                f32x4 gpl, upl, gnl, unl;
#pragma unroll
                for (int j = 0; j < 4; ++j) { gpl[j] = __shfl(acc[ai][0][3][n][j], src_prev); upl[j] = __shfl(acc[ai][1][3][n][j], src_prev);
                                              gnl[j] = __shfl(acc[ai][0][0][n][j], src_next); unl[j] = __shfl(acc[ai][1][0][n][j], src_next); }
#pragma unroll
                for (int m = 0; m < 4; ++m) {
                    const int lr = 4 * fr + m, row = u.pm * BM + ai * HALF + wr * 64 + lr;
                    const f32x4 g0 = acc[ai][0][m][n], u0 = acc[ai][1][m][n];
                    const f32x4 gp = m > 0 ? acc[ai][0][m > 0 ? m - 1 : 0][n] : gpl, up = m > 0 ? acc[ai][1][m > 0 ? m - 1 : 0][n] : upl;
                    const f32x4 gn = m < 3 ? acc[ai][0][m < 3 ? m + 1 : 3][n] : gnl, un = m < 3 ? acc[ai][1][m < 3 ? m + 1 : 3][n] : unl;
                    const f32x4 G = bg + wg[0] * gp + wg[1] * g0 + wg[2] * gn;
                    const f32x4 U = bu + wu[0] * up + wu[1] * u0 + wu[2] * un;
                    float o[4];
#pragma unroll
                    for (int j = 0; j < 4; ++j) o[j] = silu_f(G[j]) * U[j];
                    if (lr >= 1 && lr <= 62) { u32x2 w; w.x = cvt_pk_c(o[0], o[1]); w.y = cvt_pk_c(o[2], o[3]); *(u32x2*)(ACT + (size_t)row * DFF + f) = w; }
                    if (lr <= 1 || lr >= 62) {
                        const int slot = lr <= 1 ? lr : lr - 60; bf16_t* sb = SB + ((size_t)(row >> 6) * 4 + slot) * F2 + f;
                        u32x2 w; w.x = cvt_pk_c(g0[0], g0[1]); w.y = cvt_pk_c(g0[2], g0[3]); *(u32x2*)sb = w;
                        w.x = cvt_pk_c(u0[0], u0[1]); w.y = cvt_pk_c(u0[2], u0[3]); *(u32x2*)(sb + DFF) = w; }
                }
            }
        }
    }
};

struct EpiSoftmax {
    static constexpr bool PERM = true; static constexpr bool PERMA = false;
    bf16_t* P; int ldc; long cZ; float c; LAS float* xch; const float* PS;
    __device__ __forceinline__ void operator()(f32x4 (&acc)[2][2][4][2], const Unit& u, int wr, int wc, int fr, int fq) const {
        float mw[2][4], cr[2][4];
#pragma unroll
        for (int ai = 0; ai < 2; ++ai)
#pragma unroll
            for (int m = 0; m < 4; ++m) { const float* pp = PS + (size_t)(u.z * SEQ + u.pm * BM + ai * HALF + wr * 64 + m * 16 + fr) * 32 + fq * 8;
                const f32x4 a = *(const f32x4*)pp, b = *(const f32x4*)(pp + 4); float t = ((a.x + a.y) + (a.z + a.w)) + ((b.x + b.y) + (b.z + b.w));
                t += __shfl_xor(t, 16); t += __shfl_xor(t, 32); cr[ai][m] = c * (1.0f / sqrtf(t * (1.f / DM) + EPS)); }
#pragma unroll
        for (int ai = 0; ai < 2; ++ai)
#pragma unroll
            for (int m = 0; m < 4; ++m) {
                float v = -3.0e38f;
#pragma unroll
                for (int bj = 0; bj < 2; ++bj)
#pragma unroll
                    for (int n = 0; n < 2; ++n) { const f32x4 a = acc[ai][bj][m][n]; v = fmaxf(v, fmaxf(fmaxf(a[0], a[1]), fmaxf(a[2], a[3]))); }
                v = fmaxf(v, __shfl_xor(v, 16)); v = fmaxf(v, __shfl_xor(v, 32));
                mw[ai][m] = v;
                float s = 0.f;
#pragma unroll
                for (int bj = 0; bj < 2; ++bj)
#pragma unroll
                    for (int n = 0; n < 2; ++n) { f32x4 a = acc[ai][bj][m][n];
#pragma unroll
                        for (int j = 0; j < 4; ++j) { a[j] = __builtin_amdgcn_exp2f((a[j] - v) * cr[ai][m]); s += a[j]; }
                        acc[ai][bj][m][n] = a; }
                s += __shfl_xor(s, 16); s += __shfl_xor(s, 32);
                if (fq == 0) { f32x2 t; t.x = v; t.y = s; *(LAS f32x2*)(xch + ((wr * 128 + ai * 64 + m * 16 + fr) * 4 + wc) * 2) = t; }
            }
        asm volatile("s_waitcnt lgkmcnt(0)" ::: "memory"); __builtin_amdgcn_s_barrier(); asm volatile("" ::: "memory");
#pragma unroll
        for (int ai = 0; ai < 2; ++ai)
#pragma unroll
            for (int m = 0; m < 4; ++m) {
                const LAS f32x4* q = (const LAS f32x4*)(xch + (wr * 128 + ai * 64 + m * 16 + fr) * 8); const f32x4 q0 = q[0], q1 = q[1];
                const float M = fmaxf(fmaxf(q0.x, q0.z), fmaxf(q1.x, q1.z));
                const float cc = cr[ai][m];
                const float S = (q0.y * __builtin_amdgcn_exp2f((q0.x - M) * cc) + q0.w * __builtin_amdgcn_exp2f((q0.z - M) * cc)) + (q1.y * __builtin_amdgcn_exp2f((q1.x - M) * cc) + q1.w * __builtin_amdgcn_exp2f((q1.z - M) * cc));
                const float f = __builtin_amdgcn_exp2f((mw[ai][m] - M) * cc) / S;
                bf16_t* rowp = P + (size_t)u.z * cZ + (size_t)(u.pm * BM + ai * HALF + wr * 64 + m * 16 + fr) * ldc + u.pn * BM + wc * 32 + 8 * fq;
#pragma unroll
                for (int bj = 0; bj < 2; ++bj) { const f32x4 v0 = acc[ai][bj][m][0] * f, v1 = acc[ai][bj][m][1] * f;
                    u32x4 w; w.x = cvt_pk_c(v0[0], v0[1]); w.y = cvt_pk_c(v0[2], v0[3]); w.z = cvt_pk_c(v1[0], v1[1]); w.w = cvt_pk_c(v1[2], v1[3]);
                    *(u32x4*)(rowp + bj * HALF) = w; }
            }
    }
};

template <class Epi>
__device__ __forceinline__ void gemm_phase(LAS unsigned char* lds, const Gemm g, const Order& S, const Epi& E) {
    int tid_ = threadIdx.x; asm volatile("" : "+v"(tid_));
    const int tid = tid_, wid = __builtin_amdgcn_readfirstlane(tid >> 6), lane = tid & 63, wr = wid >> 2, wc = wid & 3, fr = lane & 15, fq = lane >> 4;
    const int K = g.K, nt = K / BK;
    unsigned voffA[2], voffB[2];
#pragma unroll
    for (int i = 0; i < 2; ++i) { int R, C; stage_rc(tid * 16 + i * 8192, R, C); const int Rb = Epi::PERM ? ((R & ~31) + perm32(R & 31)) : R;
        const int Ra = Epi::PERMA ? ((R & ~63) + 4 * (R & 15) + ((R >> 4) & 3)) : R;
        voffA[i] = (unsigned)(Ra * g.lda + C) * 2u; voffB[i] = (unsigned)(Rb * g.ldb + C) * 2u; }
    const size_t kstep = (size_t)(BK * 2);
    const size_t hsA = (size_t)HALF * g.lda * 2, hsB = (size_t)HALF * g.ldb * 2;
    const unsigned ldsw = (unsigned)wid * 1024u;
    const int aoff = lds_byte(wr * 64 + fr, fq * 8), boff = lds_byte(wc * 32 + fr, fq * 8);
#define PG8_SA(b, h) (((b) * 2 + (h)) * HTB)
#define PG8_SB(b, h) ((4 + (b) * 2 + (h)) * HTB)
#define PG8_STAGE(bufoff, gbase, voff) do { _Pragma("unroll") for (int _i = 0; _i < 2; ++_i) \
        __builtin_amdgcn_global_load_lds((const unsigned*)((const char*)(gbase) + (voff)[_i]), (LAS unsigned*)(lds + (bufoff) + ldsw + _i * 8192), 16, 0, 0); } while (0)
#define PG8_LDA(dst, b, h) do { _Pragma("unroll") for (int m = 0; m < 4; ++m) _Pragma("unroll") for (int k = 0; k < 2; ++k) dst[m][k] = *(const LAS bf16x8*)(lds + PG8_SA(b, h) + aoff + m * 2048 + k * 1024); } while (0)
#define PG8_LDB(dst, b, h) do { _Pragma("unroll") for (int n = 0; n < 2; ++n) _Pragma("unroll") for (int k = 0; k < 2; ++k) dst[n][k] = *(const LAS bf16x8*)(lds + PG8_SB(b, h) + boff + n * 2048 + k * 1024); } while (0)
#define PG8_MMA(ai, bj, At, Bt) do { __builtin_amdgcn_s_setprio(1); _Pragma("unroll") for (int m = 0; m < 4; ++m) _Pragma("unroll") for (int n = 0; n < 2; ++n) _Pragma("unroll") for (int k = 0; k < 2; ++k) \
        acc[ai][bj][m][n] = __builtin_amdgcn_mfma_f32_16x16x32_bf16(Bt[n][k], At[m][k], acc[ai][bj][m][n], 0, 0, 0); __builtin_amdgcn_s_setprio(0); } while (0)
#define PG8_WAIT_V(n) asm volatile("s_waitcnt vmcnt(" #n ")" ::: "memory")
#define PG8_WAIT_L(n) asm volatile("s_waitcnt lgkmcnt(" #n ")" ::: "memory")
#define PG8_BAR __builtin_amdgcn_s_barrier()
#define PG8_SCHED __builtin_amdgcn_sched_barrier(0)
    Unit cur, nxt; int ui = 0;
    if (!S.next(0, cur)) return;
    f32x4 acc[2][2][4][2];
#pragma unroll
    for (int a = 0; a < 2; ++a)
#pragma unroll
        for (int b = 0; b < 2; ++b)
#pragma unroll
            for (int m = 0; m < 4; ++m)
#pragma unroll
                for (int n = 0; n < 2; ++n) acc[a][b][m][n] = (f32x4){0.f, 0.f, 0.f, 0.f};
    bf16x8 At[4][2], B0[2][2], B1[2][2];
    const char* cA = a_ptr(g, cur); const char* cB = b_ptr(g, cur);
    PG8_STAGE(PG8_SB(0, 0), cB, voffB); PG8_STAGE(PG8_SA(0, 0), cA, voffA); PG8_STAGE(PG8_SB(0, 1), cB + hsB, voffB); PG8_STAGE(PG8_SA(0, 1), cA + hsA, voffA);
    if (wr == 1) PG8_BAR;
    PG8_WAIT_V(4); PG8_BAR;
    PG8_STAGE(PG8_SB(1, 0), cB + kstep, voffB); PG8_STAGE(PG8_SA(1, 0), cA + kstep, voffA); PG8_STAGE(PG8_SB(1, 1), cB + hsB + kstep, voffB);
    PG8_WAIT_V(6); PG8_BAR;
    for (;;) {
        const bool has_next = S.next(ui + 1, nxt);
        const char* nA = has_next ? a_ptr(g, nxt) : cA; const char* nB = has_next ? b_ptr(g, nxt) : cB;
        for (int t = 0; t < nt; t += 2) {
            const bool last = (t == nt - 2);
            const char* a1 = cA + (size_t)(t + 1) * kstep;
            const char* a2 = last ? nA : cA + (size_t)(t + 2) * kstep; const char* b2 = last ? nB : cB + (size_t)(t + 2) * kstep;
            const char* a3 = a2 + kstep; const char* b3 = b2 + kstep;
            PG8_LDB(B0, 0, 0); PG8_SCHED; PG8_LDA(At, 0, 0); PG8_STAGE(PG8_SA(1, 1), a1 + hsA, voffA);
            PG8_WAIT_L(8); PG8_BAR; PG8_WAIT_L(0); PG8_MMA(0, 0, At, B0); PG8_BAR; PG8_SCHED;
            PG8_LDB(B1, 0, 1); PG8_STAGE(PG8_SB(0, 0), b2, voffB);
            PG8_BAR; PG8_WAIT_L(0); PG8_MMA(0, 1, At, B1); PG8_BAR;
            PG8_LDA(At, 0, 1); PG8_STAGE(PG8_SA(0, 0), a2, voffA);
            PG8_BAR; PG8_WAIT_L(0); PG8_MMA(1, 0, At, B0); PG8_BAR; PG8_SCHED;
            PG8_STAGE(PG8_SB(0, 1), b2 + hsB, voffB);
            PG8_WAIT_V(6); PG8_BAR; PG8_MMA(1, 1, At, B1); PG8_BAR;
            PG8_LDB(B0, 1, 0); PG8_SCHED; PG8_LDA(At, 1, 0); PG8_STAGE(PG8_SA(0, 1), a2 + hsA, voffA);
            PG8_WAIT_L(8); PG8_BAR; PG8_WAIT_L(0); PG8_MMA(0, 0, At, B0); PG8_BAR; PG8_SCHED;
            PG8_LDB(B1, 1, 1); PG8_STAGE(PG8_SB(1, 0), b3, voffB);
            PG8_BAR; PG8_WAIT_L(0); PG8_MMA(0, 1, At, B1); PG8_BAR;
            PG8_LDA(At, 1, 1); PG8_STAGE(PG8_SA(1, 0), a3, voffA);
            PG8_BAR; PG8_WAIT_L(0); PG8_MMA(1, 0, At, B0); PG8_BAR; PG8_SCHED;
            PG8_STAGE(PG8_SB(1, 1), b3 + hsB, voffB);
            PG8_WAIT_V(6); PG8_BAR; PG8_MMA(1, 1, At, B1); PG8_BAR;
        }
        E(acc, cur, wr, wc, fr, fq);
        if (!has_next) break;
#pragma unroll
        for (int a = 0; a < 2; ++a)
#pragma unroll
            for (int b = 0; b < 2; ++b)
#pragma unroll
                for (int m = 0; m < 4; ++m)
#pragma unroll
                    for (int n = 0; n < 2; ++n) acc[a][b][m][n] = (f32x4){0.f, 0.f, 0.f, 0.f};
        cur = nxt; cA = nA; cB = nB; ++ui;
    }
    PG8_WAIT_V(0);
    if (wr == 0) PG8_BAR;
    PG8_BAR;
#undef PG8_SA
#undef PG8_SB
#undef PG8_STAGE
#undef PG8_LDA
#undef PG8_LDB
#undef PG8_MMA
#undef PG8_WAIT_V
#undef PG8_WAIT_L
#undef PG8_BAR
#undef PG8_SCHED
}
}
#define XB_TMO      128
#define XB_XCNT(j)  (256  + 64 * (j))
#define XB_XSUB(j)  (1280 + 64 * (j))
#define XB_XGEN(j)  (2304 + 64 * (j))
#define XB_TOP      3328
#define XB_TOPGEN   3392
#define XCD_BAR_WORDS 3456
#define XB_SPIN_CAP (1u << 20)

__device__ __forceinline__ unsigned xb_ld(unsigned* p)              { return __hip_atomic_load(p, __ATOMIC_RELAXED, __HIP_MEMORY_SCOPE_AGENT); }
__device__ __forceinline__ unsigned xb_add(unsigned* p, unsigned v) { return __hip_atomic_fetch_add(p, v, __ATOMIC_RELAXED, __HIP_MEMORY_SCOPE_AGENT); }
__device__ __forceinline__ unsigned xb_xcc_id() { return (unsigned)__builtin_amdgcn_s_getreg((3 << 11) | 20) & 0xFu; }
#define XB_SPIN(cond, bar) do { unsigned _sp = 0; while (cond) { __builtin_amdgcn_s_sleep(1); \
    if ((++_sp & 255u) == 0u) { if (xb_ld(&(bar)[XB_TMO])) break; if (_sp > XB_SPIN_CAP) { atomicAdd(&(bar)[XB_TMO], 1u); break; } } } } while (0)

struct XcdBarrier { unsigned* bar; unsigned x; volatile LAS unsigned* st; };

__device__ __forceinline__ XcdBarrier xcd_barrier_post(unsigned* bar, volatile LAS unsigned* st) {
    XcdBarrier b; b.bar = bar; b.x = xb_xcc_id(); b.st = st;
    if (threadIdx.x == 0) (void)xb_add(&bar[XB_XCNT(b.x)], 1u);
    return b;
}
__device__ __forceinline__ void xcd_barrier_complete(unsigned* bar, unsigned x, unsigned& nloc, unsigned& nx) {
    const unsigned G = gridDim.x * gridDim.y * gridDim.z;
    unsigned sum, cnt, mine, sp = 0u;
    for (;;) {
        sum = 0u; cnt = 0u; mine = 0u;
#pragma unroll
        for (unsigned j = 0; j < 16; ++j) { const unsigned c = xb_ld(&bar[XB_XCNT(j)]); sum += c; cnt += (c > 0u) ? 1u : 0u; mine = (j == x) ? c : mine; }
        if (sum == G) break;
        __builtin_amdgcn_s_sleep(1);
        if ((++sp & 255u) == 0u) { if (xb_ld(&bar[XB_TMO])) break; if (sp > XB_SPIN_CAP) { atomicAdd(&bar[XB_TMO], 1u); break; } }
    }
    nloc = mine > 0u ? mine : 1u; nx = cnt > 0u ? cnt : 1u;
}
__device__ __forceinline__ void xcd_barrier(const XcdBarrier& b) {
    asm volatile("s_waitcnt vmcnt(0)" ::: "memory");
    __syncthreads();
    if (threadIdx.x == 0) {
        unsigned* bar = b.bar;
        __builtin_amdgcn_s_waitcnt(0);
        unsigned nloc = b.st[0], nx = b.st[1];
        if (nloc == 0u) { xcd_barrier_complete(bar, b.x, nloc, nx); b.st[0] = nloc; b.st[1] = nx; }
        const unsigned old = xb_add(&bar[XB_XSUB(b.x)], 1u);
        const unsigned gen = old / nloc;
        if (old + 1u == (gen + 1u) * nloc) {
            __builtin_amdgcn_fence(__ATOMIC_RELEASE, "agent");
            asm volatile("s_waitcnt vmcnt(0)" ::: "memory");
            const unsigned og = xb_add(&bar[XB_TOP], 1u);
            const unsigned tg = og / nx;
            if (og + 1u == (tg + 1u) * nx) xb_add(&bar[XB_TOPGEN], 1u);
            else XB_SPIN(xb_ld(&bar[XB_TOPGEN]) == tg, bar);
            __builtin_amdgcn_fence(__ATOMIC_ACQUIRE, "agent");
            xb_add(&bar[XB_XGEN(b.x)], 1u);
            asm volatile("s_waitcnt vmcnt(0)" ::: "memory");
        } else {
            XB_SPIN(xb_ld(&bar[XB_XGEN(b.x)]) == gen, bar);
            __builtin_amdgcn_fence(__ATOMIC_ACQUIRE, "agent");
            asm volatile("s_waitcnt vmcnt(0)" ::: "memory");
        }
    }
    __syncthreads();
}

struct Args { const float* in[40]; float* out; unsigned char* ws; int l_lo, l_hi, s_lo, s_hi, fused, pad; };
struct Frame {
    LAS unsigned char* lds;
    int tid, lane, wave, G, bid;
    float* out; unsigned char* ws;
    bf16_t* h;
    bf16_t* x16;
};
enum { I_XP = 0, I_XS, I_MP, I_MS, I_NMIX, I_NXA, I_NMEM, I_NFFN, I_WQ, I_WK, I_WV, I_WO, I_FIN, I_FCW, I_FCB, I_FOUT, I_MIN, I_MOUT, I_SCW, I_SCB, I_ALOG, I_DTB, I_SD, I_SNORM,
       I_QN, I_KN, I_HIN, I_HCW, I_HCB, I_FW1, I_FB1, I_FW2, I_FB2, I_FW3, I_FB3, I_FFREQ, I_FWO, I_HSKIP, I_HOUT, I_FNORM };

__device__ __forceinline__ const float* inp(int i) {
    unsigned off = (unsigned)i * 8u; asm volatile("" : "+s"(off));
    const char __attribute__((address_space(4)))* ka = (const char __attribute__((address_space(4)))*)__builtin_amdgcn_kernarg_segment_ptr();
    return *(const float* const __attribute__((address_space(4)))*)(ka + off);
}
__device__ __forceinline__ void tr_item(const float* W, int K, int Nsrc, int c0, bf16_t* WT, int r0, int nblk, LAS float* scr, int item, int lane) {
    const int kb = item / nblk, nb = item % nblk, k0 = 64 * kb, n0 = 32 * nb;
#pragma unroll 8
    for (int i = 0; i < 32; ++i) { const int kk = 2 * i + (lane >> 5); scr[kk * 33 + (lane & 31)] = W[(size_t)(k0 + kk) * Nsrc + c0 + n0 + (lane & 31)]; }
    LDS_WAIT(); asm volatile("" ::: "memory");
    const int c = lane & 7;
#pragma unroll
    for (int j = 0; j < 4; ++j) { const int n = (lane >> 3) + 8 * j; const LAS float* s = scr + (8 * c) * 33 + n;
        u32x4 o; o.x = cvt_pk_bf16(s[0 * 33], s[1 * 33]); o.y = cvt_pk_bf16(s[2 * 33], s[3 * 33]); o.z = cvt_pk_bf16(s[4 * 33], s[5 * 33]); o.w = cvt_pk_bf16(s[6 * 33], s[7 * 33]);
        *(u32x4*)(WT + (size_t)(r0 + n0 + n) * K + k0 + 8 * c) = o; }
    LDS_WAIT(); asm volatile("" ::: "memory");
}
__device__ __forceinline__ void tr_seg(const float* W, int K, int Nsrc, int c0, int ncols, bf16_t* WT, int r0, LAS float* scr, int gw, int NGW, int lane) {
    const int nblk = ncols / 32, nit = (K / 64) * nblk;
    for (int it = gw; it < nit; it += NGW) tr_item(W, K, Nsrc, c0, WT, r0, nblk, scr, it, lane);
}
__device__ __forceinline__ void rms_row(const float* xrow, const float* gain, bf16_t* orow, float* copy, int lane) {
    const f32x4* xr = (const f32x4*)xrow + lane; const f32x4* gr = (const f32x4*)gain + lane;
    f32x4 v[8]; float s = 0.f;
#pragma unroll
    for (int j = 0; j < 8; ++j) { v[j] = xr[64 * j]; s += (v[j].x * v[j].x + v[j].y * v[j].y) + (v[j].z * v[j].z + v[j].w * v[j].w); }
    if (copy) {
#pragma unroll
        for (int j = 0; j < 8; ++j) ((f32x4*)copy + lane)[64 * j] = v[j];
    }
    const float rstd = 1.0f / sqrtf(wave_sum(s) * (1.f / DM) + EPS);
    u32x2* o8 = (u32x2*)orow + lane;
#pragma unroll
    for (int j = 0; j < 8; ++j) { const f32x4 g = gr[64 * j]; u32x2 w; w.x = cvt_pk_bf16(v[j].x * rstd * g.x, v[j].y * rstd * g.y); w.y = cvt_pk_bf16(v[j].z * rstd * g.z, v[j].w * rstd * g.w); o8[64 * j] = w; }
}
__device__ __forceinline__ void phase_rms_x(Frame& F, const float* gain, bool from_inputs) {
    bf16_t* H = F.h; bf16_t* X = F.x16;
    const int gw = F.bid * 8 + F.wave, NGW = F.G * 8, lane = F.lane;
    f32x4 gn[4][2];
#pragma unroll
    for (int j = 0; j < 4; ++j) { gn[j][0] = *(const f32x4*)(gain + j * 512 + lane * 8); gn[j][1] = *(const f32x4*)(gain + j * 512 + lane * 8 + 4); }
    if (from_inputs) {
        for (int m = gw; m < T; m += NGW) {
            float v[4][8]; float s = 0.f;
            const float* src = (m < 4 * SEQ ? inp(I_XP) + (size_t)m * DM : inp(I_XS) + (size_t)(m - 4 * SEQ) * DM);
#pragma unroll
            for (int j = 0; j < 4; ++j) { const f32x4 a = *(const f32x4*)(src + j * 512 + lane * 8), b = *(const f32x4*)(src + j * 512 + lane * 8 + 4);
                v[j][0] = a.x; v[j][1] = a.y; v[j][2] = a.z; v[j][3] = a.w; v[j][4] = b.x; v[j][5] = b.y; v[j][6] = b.z; v[j][7] = b.w;
                *(u32x4*)(X + (size_t)m * DM + j * 512 + lane * 8) = pack8(v[j]); }
#pragma unroll
            for (int j = 0; j < 4; ++j)
#pragma unroll
                for (int i = 0; i < 8; ++i) s += v[j][i] * v[j][i];
            const float rstd = 1.0f / sqrtf(wave_sum(s) * (1.f / DM) + EPS);
#pragma unroll
            for (int j = 0; j < 4; ++j) { const f32x4 g0 = gn[j][0], g1 = gn[j][1];
                float o[8]; o[0] = v[j][0] * rstd * g0.x; o[1] = v[j][1] * rstd * g0.y; o[2] = v[j][2] * rstd * g0.z; o[3] = v[j][3] * rstd * g0.w;
                o[4] = v[j][4] * rstd * g1.x; o[5] = v[j][5] * rstd * g1.y; o[6] = v[j][6] * rstd * g1.z; o[7] = v[j][7] * rstd * g1.w;
                *(u32x4*)(H + (size_t)m * DM + j * 512 + lane * 8) = pack8(o); }
        }
    } else {
        for (int m = gw; m < T; m += 2 * NGW) {
            const int m1 = m + NGW; const bool has1 = m1 < T; const int mb = has1 ? m1 : m;
            u32x4 ra[4], rb[4];
#pragma unroll
            for (int j = 0; j < 4; ++j) { ra[j] = *(const u32x4*)(X + (size_t)m * DM + j * 512 + lane * 8); rb[j] = *(const u32x4*)(X + (size_t)mb * DM + j * 512 + lane * 8); }
#pragma unroll
            for (int q = 0; q < 2; ++q) {
                if (q == 1 && !has1) break;
                float v[4][8]; float s = 0.f;
#pragma unroll
                for (int j = 0; j < 4; ++j) unpack8(q ? rb[j] : ra[j], v[j]);
#pragma unroll
                for (int j = 0; j < 4; ++j)
#pragma unroll
                    for (int i = 0; i < 8; ++i) s += v[j][i] * v[j][i];
                const float rstd = 1.0f / sqrtf(wave_sum(s) * (1.f / DM) + EPS);
                const int mo = q ? m1 : m;
#pragma unroll
                for (int j = 0; j < 4; ++j) { const f32x4 g0 = gn[j][0], g1 = gn[j][1];
                    float o[8]; o[0] = v[j][0] * rstd * g0.x; o[1] = v[j][1] * rstd * g0.y; o[2] = v[j][2] * rstd * g0.z; o[3] = v[j][3] * rstd * g0.w;
                    o[4] = v[j][4] * rstd * g1.x; o[5] = v[j][5] * rstd * g1.y; o[6] = v[j][6] * rstd * g1.z; o[7] = v[j][7] * rstd * g1.w;
                    *(u32x4*)(H + (size_t)mo * DM + j * 512 + lane * 8) = pack8(o); }
            }
        }
    }
}
__device__ __forceinline__ void phase_final_norm(Frame& F) {
    const int gw = F.bid * 8 + F.wave, NGW = F.G * 8, lane = F.lane; const float* gain = inp(I_FNORM); const bf16_t* X = F.x16;
    f32x4 gn[4][2];
#pragma unroll
    for (int j = 0; j < 4; ++j) { gn[j][0] = *(const f32x4*)(gain + j * 512 + lane * 8); gn[j][1] = *(const f32x4*)(gain + j * 512 + lane * 8 + 4); }
    for (int m = gw; m < T; m += 2 * NGW) {
        const int m1 = m + NGW; const bool has1 = m1 < T; const int mb = has1 ? m1 : m;
        u32x4 ra[4], rb[4];
#pragma unroll
        for (int j = 0; j < 4; ++j) { ra[j] = *(const u32x4*)(X + (size_t)m * DM + j * 512 + lane * 8); rb[j] = *(const u32x4*)(X + (size_t)mb * DM + j * 512 + lane * 8); }
#pragma unroll
        for (int q = 0; q < 2; ++q) {
            if (q == 1 && !has1) break;
            float v[4][8]; float s = 0.f; const int mo = q ? m1 : m;
#pragma unroll
            for (int j = 0; j < 4; ++j) unpack8(q ? rb[j] : ra[j], v[j]);
#pragma unroll
            for (int j = 0; j < 4; ++j)
#pragma unroll
                for (int i = 0; i < 8; ++i) s += v[j][i] * v[j][i];
            const float rstd = 1.0f / sqrtf(wave_sum(s) * (1.f / DM) + EPS);
#pragma unroll
            for (int j = 0; j < 4; ++j) { const f32x4 g0 = gn[j][0], g1 = gn[j][1];
                f32x4 o0, o1; o0.x = v[j][0] * rstd * g0.x; o0.y = v[j][1] * rstd * g0.y; o0.z = v[j][2] * rstd * g0.z; o0.w = v[j][3] * rstd * g0.w;
                o1.x = v[j][4] * rstd * g1.x; o1.y = v[j][5] * rstd * g1.y; o1.z = v[j][6] * rstd * g1.z; o1.w = v[j][7] * rstd * g1.w;
                *(f32x4*)(F.out + (size_t)mo * DM + j * 512 + lane * 8) = o0; *(f32x4*)(F.out + (size_t)mo * DM + j * 512 + lane * 8 + 4) = o1; }
        }
    }
}

__device__ __forceinline__ void phase_prep(Frame& F, int layer) {
    LAS float* scr = (LAS float*)(F.lds + F.wave * 8448);
    const int gw = F.bid * 8 + F.wave, NGW = F.G * 8, lane = F.lane;
    unsigned char* ws = F.ws;
    const int e = layer >> 1;
    if (!(layer & 1)) {
        const float* win = inp(I_MIN) + (size_t)e * DM * 8256;
        bf16_t* WI = (bf16_t*)(ws + W_IN);
        tr_seg(win, DM, 8256, 0, 2048, WI, PC_Z, scr, gw, NGW, lane);
        tr_seg(win, DM, 8256, 5184, 2048, WI, PC_Q, scr, gw, NGW, lane);
        tr_seg(win, DM, 8256, 2048, 3072, WI, PC_X, scr, gw, NGW, lane);
        tr_seg(win, DM, 8256, 7232, 512, WI, PC_K, scr, gw, NGW, lane);
        tr_seg(win, DM, 8256, 7744, 512, WI, PC_V, scr, gw, NGW, lane);
        tr_seg(win, DM, 8256, 5120, 64, (bf16_t*)(ws + W_DT), 0, scr, gw, NGW, lane);
        { u32x4* z = (u32x4*)(ws + W_DT + (size_t)64 * DM * 2); const int n16 = 192 * DM * 2 / 16;
          for (int i = F.bid * 512 + F.tid; i < n16; i += F.G * 512) z[i] = (u32x4){0u, 0u, 0u, 0u}; }
        tr_seg(inp(I_MOUT) + (size_t)e * 4096 * DM, 4096, DM, 0, DM, (bf16_t*)(ws + W_OUT), 0, scr, gw, NGW, lane);
    } else {
        tr_seg(inp(I_HIN) + (size_t)e * DM * HYW, DM, HYW, 0, HYW, (bf16_t*)(ws + HW_IN), 0, scr, gw, NGW, lane);
        tr_seg(inp(I_HOUT) + (size_t)e * DM * DM, DM, DM, 0, DM, (bf16_t*)(ws + HW_OUT), 0, scr, gw, NGW, lane);
    }
    { const float* wq = inp(I_WQ) + (size_t)layer * DM * DM; bf16_t* o = (bf16_t*)(ws + W_Q);
      for (int i = F.bid * 512 + F.tid; i < DM * DM / 8; i += F.G * 512) { const f32x4 a = *(const f32x4*)(wq + (size_t)i * 8), b = *(const f32x4*)(wq + (size_t)i * 8 + 4);
          u32x4 w; w.x = cvt_pk_bf16(a.x, a.y); w.y = cvt_pk_bf16(a.z, a.w); w.z = cvt_pk_bf16(b.x, b.y); w.w = cvt_pk_bf16(b.z, b.w); *(u32x4*)(o + (size_t)i * 8) = w; } }
    tr_seg(inp(I_WK) + (size_t)layer * DM * DM, DM, DM, 0, DM, (bf16_t*)(ws + W_K), 0, scr, gw, NGW, lane);
    tr_seg(inp(I_WV) + (size_t)layer * DM * DM, DM, DM, 0, DM, (bf16_t*)(ws + W_V), 0, scr, gw, NGW, lane);
    tr_seg(inp(I_WO) + (size_t)layer * DM * DM, DM, DM, 0, DM, (bf16_t*)(ws + W_O), 0, scr, gw, NGW, lane);
    { const float* fin = inp(I_FIN) + (size_t)layer * DM * F2;
      for (int it = gw; it < 88 * 128; it += NGW) { const int sg = it >> 7, li = it & 127, j = sg >> 1, half = sg & 1;
          tr_item(fin, DM, F2, half * DFF + 128 * j, (bf16_t*)(ws + W_FIN), 128 * sg, 4, scr, li, lane); } }
    tr_seg(inp(I_FOUT) + (size_t)layer * DFF * DM, DFF, DM, 0, DM, (bf16_t*)(ws + W_FOUT), 0, scr, gw, NGW, lane);
    phase_rms_x(F, inp(I_NMIX) + (size_t)layer * DM, layer == 0);
    for (int m = gw; m < MROWS; m += NGW) {
        const float* src = m < 4 * NMEM ? inp(I_MP) + (size_t)m * DM : inp(I_MS) + (size_t)(m - 4 * NMEM) * DM;
        rms_row(src, inp(I_NMEM) + (size_t)layer * DM, (bf16_t*)(ws + WS_MEMN) + (size_t)m * DM, nullptr, lane);
    }
    if (layer & 1) {
        f32x2* tw = (f32x2*)(ws + WS_TW);
        for (int i = F.bid * 512 + F.tid; i < 4096; i += F.G * 512) { float s, c; sincospif(-(float)i * (1.0f / 8192.0f), &s, &c); { f32x2 tv; tv.x = c; tv.y = s; tw[i] = tv; } }
        const float* w1 = inp(I_FW1) + (size_t)e * 33 * 64; const float* b1 = inp(I_FB1) + e * 64;
        const float* w2 = inp(I_FW2) + (size_t)e * 64 * 64; const float* b2 = inp(I_FB2) + e * 64;
        const float* w3 = inp(I_FW3) + (size_t)e * 64 * 64; const float* b3 = inp(I_FB3) + e * 64;
        const float fr = inp(I_FFREQ)[e * 64 + lane];
        float* h3 = (float*)(ws + WS_H3);
        for (int t = gw; t < SEQ; t += NGW) {
            float z = 0.f;
            { const float wt = 6.283185307179586f * (float)t / (float)SEQ;
              if (lane == 0) z = (float)t / (float)(SEQ - 1);
              else if (lane <= 16) { const float f = 1e-4f + (float)(lane - 1) * ((15.0f - 1e-4f) / 15.0f); z = cosf(wt * f); }
              else if (lane <= 32) { const float f = 1e-4f + (float)(lane - 17) * ((15.0f - 1e-4f) / 15.0f); z = -sinf(wt * f); } }
            float a = b1[lane];
            for (int i = 0; i < 33; ++i) a += __shfl(z, i) * w1[i * 64 + lane];
            float h = sinf(fr * a);
            a = b2[lane];
            for (int i = 0; i < 64; ++i) a += __shfl(h, i) * w2[i * 64 + lane];
            h = sinf(fr * a);
            a = b3[lane];
            for (int i = 0; i < 64; ++i) a += __shfl(h, i) * w3[i * 64 + lane];
            h = sinf(fr * a);
            h3[(size_t)t * 64 + lane] = h;
        }
    }
}
__device__ __forceinline__ void phase_ssd_conv(Frame& F, int e) {
    const bf16_t* P = (const bf16_t*)(F.ws + WS_PROJ); bf16_t* XS = F.h; bf16_t* BC = (bf16_t*)(F.ws + WS_BC);
    const float* cw = inp(I_SCW) + (size_t)e * 5 * 3072; const float* cb = inp(I_SCB) + (size_t)e * 3072;
    const int nitem = (T / 16) * 384;
    for (int it = F.bid * 512 + F.tid; it < nitem; it += F.G * 512) {
        const int strip = it / 384, oc = it % 384, ch = oc * 8, m0 = strip * 16, t0 = m0 % SEQ;
        float w[5][8], bias[8];
#pragma unroll
        for (int k = 0; k < 5; ++k) { const f32x4 a = *(const f32x4*)(cw + k * 3072 + ch), b = *(const f32x4*)(cw + k * 3072 + ch + 4);
            w[k][0] = a.x; w[k][1] = a.y; w[k][2] = a.z; w[k][3] = a.w; w[k][4] = b.x; w[k][5] = b.y; w[k][6] = b.z; w[k][7] = b.w; }
        { const f32x4 a = *(const f32x4*)(cb + ch), b = *(const f32x4*)(cb + ch + 4); bias[0] = a.x; bias[1] = a.y; bias[2] = a.z; bias[3] = a.w; bias[4] = b.x; bias[5] = b.y; bias[6] = b.z; bias[7] = b.w; }
        u32x4 raw[20];
#pragma unroll
        for (int k = 0; k < 20; ++k) { const int tt = t0 + k - 2, tc = tt < 0 ? 0 : (tt >= SEQ ? SEQ - 1 : tt);
            raw[k] = *(const u32x4*)(P + (size_t)(m0 - t0 + tc) * PW + PC_X + ch); }
        if (t0 == 0) { raw[0] = (u32x4){0u, 0u, 0u, 0u}; raw[1] = (u32x4){0u, 0u, 0u, 0u}; }
        if (t0 + 16 == SEQ) { raw[18] = (u32x4){0u, 0u, 0u, 0u}; raw[19] = (u32x4){0u, 0u, 0u, 0u}; }
        float win[5][8];
#pragma unroll
        for (int k = 0; k < 4; ++k) unpack8(raw[k], win[k + 1]);
#pragma unroll
        for (int r = 0; r < 16; ++r) {
#pragma unroll
            for (int k = 0; k < 4; ++k)
#pragma unroll
                for (int j = 0; j < 8; ++j) win[k][j] = win[k + 1][j];
            unpack8(raw[r + 4], win[4]);
            float o[8];
#pragma unroll
            for (int j = 0; j < 8; ++j) { float a = bias[j];
#pragma unroll
                for (int k = 0; k < 5; ++k) a += win[k][j] * w[k][j];
                o[j] = silu_f(a); }
            const u32x4 ov = pack8(o);
            if (ch < 2048) *(u32x4*)(XS + (size_t)(m0 + r) * DM + ch) = ov;
            else *(u32x4*)(BC + (size_t)(m0 + r) * 1024 + (ch - 2048)) = ov;
        }
    }
}
__device__ __forceinline__ void phase_qk_rope(Frame& F, int e) {
    bf16_t* P = (bf16_t*)(F.ws + WS_PROJ);
    const int gw = F.bid * 8 + F.wave, NGW = F.G * 8, lane = F.lane;
    const float gq0 = inp(I_QN)[e * 128 + 2 * lane], gq1 = inp(I_QN)[e * 128 + 2 * lane + 1];
    const float gk0 = inp(I_KN)[e * 128 + 2 * lane], gk1 = inp(I_KN)[e * 128 + 2 * lane + 1];
    const float invf = exp2f(-13.287712379549449f * (float)(lane & 31) * (1.0f / 32.0f));
    for (int m = gw; m < T; m += NGW) {
        const int t = m % SEQ; const float pos = (lane < 32) ? (float)(t >> 6) : (float)(t & 63);
        float sn, cs; sincosf(pos * invf, &sn, &cs);
        unsigned* row = (unsigned*)(P + (size_t)m * PW);
        unsigned wv[20];
#pragma unroll
        for (int hd = 0; hd < 20; ++hd) { const int col = (hd < 16) ? (PC_Q + hd * 128) : (PC_K + (hd - 16) * 128); wv[hd] = row[(col >> 1) + lane]; }
#pragma unroll
        for (int hd = 0; hd < 20; ++hd) {
            const int col = (hd < 16) ? (PC_Q + hd * 128) : (PC_K + (hd - 16) * 128);
            float x0 = bflo(wv[hd]), x1 = bfhi(wv[hd]);
            const float ss = wave_sum(x0 * x0 + x1 * x1);
            const float rstd = __builtin_amdgcn_rsqf(ss * (1.f / 128.f) + EPS);
            x0 *= rstd * (hd < 16 ? gq0 : gk0); x1 *= rstd * (hd < 16 ? gq1 : gk1);
            row[(col >> 1) + lane] = cvt_pk_bf16(x0 * cs - x1 * sn, x0 * sn + x1 * cs);
        }
    }
}
__device__ __forceinline__ void phase_ssd_gate_norm(Frame& F, int e) {
    bf16_t* P = (bf16_t*)(F.ws + WS_PROJ);
    const int gw = F.bid * 8 + F.wave, NGW = F.G * 8, lane = F.lane; const float* gain = inp(I_SNORM) + (size_t)e * DM;
    f32x4 gn[4][2];
#pragma unroll
    for (int j = 0; j < 4; ++j) { gn[j][0] = *(const f32x4*)(gain + j * 512 + lane * 8); gn[j][1] = *(const f32x4*)(gain + j * 512 + lane * 8 + 4); }
    for (int m = gw; m < T; m += 2 * NGW) {
        const int m1 = m + NGW; const bool has1 = m1 < T; const int mb = has1 ? m1 : m;
        u32x4 ya[4], za[4], yb[4], zb[4];
#pragma unroll
        for (int j = 0; j < 4; ++j) { const int c = j * 512 + lane * 8;
            ya[j] = *(const u32x4*)(P + (size_t)m * PW + PC_X + c); za[j] = *(const u32x4*)(P + (size_t)m * PW + PC_Z + c);
            yb[j] = *(const u32x4*)(P + (size_t)mb * PW + PC_X + c); zb[j] = *(const u32x4*)(P + (size_t)mb * PW + PC_Z + c); }
#pragma unroll
        for (int q = 0; q < 2; ++q) {
            if (q == 1 && !has1) break;
            bf16_t* row = P + (size_t)(q ? m1 : m) * PW; float v[4][8]; float s = 0.f;
#pragma unroll
            for (int j = 0; j < 4; ++j) { float y[8], z[8];
                unpack8(q ? yb[j] : ya[j], y); unpack8(q ? zb[j] : za[j], z);
#pragma unroll
                for (int i = 0; i < 8; ++i) { v[j][i] = y[i] * silu_f(z[i]); s += v[j][i] * v[j][i]; } }
            const float rstd = 1.0f / sqrtf(wave_sum(s) * (1.f / DM) + EPS);
#pragma unroll
            for (int j = 0; j < 4; ++j) { const int c = j * 512 + lane * 8; const f32x4 g0 = gn[j][0], g1 = gn[j][1];
                float o[8]; o[0] = v[j][0] * rstd * g0.x; o[1] = v[j][1] * rstd * g0.y; o[2] = v[j][2] * rstd * g0.z; o[3] = v[j][3] * rstd * g0.w;
                o[4] = v[j][4] * rstd * g1.x; o[5] = v[j][5] * rstd * g1.y; o[6] = v[j][6] * rstd * g1.z; o[7] = v[j][7] * rstd * g1.w;
                *(u32x4*)(row + PC_Z + c) = pack8(o); }
        }
    }
}

constexpr int TP = 136;
__device__ __forceinline__ bf16x8 frag16(const LAS unsigned char* tile, int row, int k0, int lane) { return *(const LAS bf16x8*)(tile + row * (TP * 2) + (k0 + 8 * (lane >> 4)) * 2); }
constexpr int SC_CSF = 0, SC_EB = 128, SC_DTF = 256, SC_DTB = 384, SC_RSF = 512, SC_RSB = 640, SC_EBT = 768, SC_WORDS = 772;
__device__ __forceinline__ void ssd_scans(Frame& F, LAS float* sc, const float* dt, int m0, int h, float a_f, float a_b) {
    const int tid = F.tid;
    if (tid < 128) sc[SC_DTF + tid] = dt[(size_t)(m0 + tid) * 64 + h];
    else if (tid < 256) sc[SC_DTB + tid - 128] = dt[(size_t)(m0 + tid - 128) * 64 + 32 + h];
    __syncthreads();
    if (F.wave < 2) {
        const int lane = F.lane; const bool fw = (F.wave == 0);
        const float a0 = sc[(fw ? SC_DTF : SC_DTB) + 2 * lane] * (fw ? a_f : a_b), a1 = sc[(fw ? SC_DTF : SC_DTB) + 2 * lane + 1] * (fw ? a_f : a_b);
        float p = a0 + a1;
#pragma unroll
        for (int o = 1; o < 64; o <<= 1) { const float tt = __shfl_up(p, o); if (lane >= o) p += tt; }
        const float ex = p - (a0 + a1);
        if (fw) { sc[SC_CSF + 2 * lane] = ex + a0; sc[SC_CSF + 2 * lane + 1] = p; }
        else { sc[SC_EB + 2 * lane] = ex; sc[SC_EB + 2 * lane + 1] = ex + a0; if (lane == 63) sc[SC_EBT] = p; }
    }
    __syncthreads();
}
__device__ __forceinline__ void ssd_scans_r(Frame& F, LAS float* sc, float dtv, float a_f, float a_b) {
    const int tid = F.tid;
    if (tid < 128) sc[SC_DTF + tid] = dtv;
    else if (tid < 256) sc[SC_DTB + tid - 128] = dtv;
    LDS_BARRIER();
    if (F.wave < 2) {
        const int lane = F.lane; const bool fw = (F.wave == 0);
        const float a0 = sc[(fw ? SC_DTF : SC_DTB) + 2 * lane] * (fw ? a_f : a_b), a1 = sc[(fw ? SC_DTF : SC_DTB) + 2 * lane + 1] * (fw ? a_f : a_b);
        float p = a0 + a1;
#pragma unroll
        for (int o = 1; o < 64; o <<= 1) { const float tt = __shfl_up(p, o); if (lane >= o) p += tt; }
        const float ex = p - (a0 + a1);
        if (fw) { sc[SC_CSF + 2 * lane] = ex + a0; sc[SC_CSF + 2 * lane + 1] = p; }
        else { sc[SC_EB + 2 * lane] = ex; sc[SC_EB + 2 * lane + 1] = ex + a0; if (lane == 63) sc[SC_EBT] = p; }
    }
    LDS_BARRIER();
}
__device__ __forceinline__ void phase_ssd_states(Frame& F, int e) {
    LAS unsigned char* BT = F.lds; LAS unsigned char* XF = F.lds + 34816; LAS unsigned char* XB = F.lds + 52224; LAS float* sc = (LAS float*)(F.lds + 69632);
    const bf16_t* XS = F.h; const bf16_t* BC = (const bf16_t*)(F.ws + WS_BC); const float* dt = (const float*)(F.ws + WS_DT);
    bf16_t* STF = (bf16_t*)(F.ws + WS_STF); bf16_t* STB = (bf16_t*)(F.ws + WS_STB); float* TOT = (float*)(F.ws + WS_TOT);
    const int tid = F.tid, lane = F.lane, wave = F.wave;
    for (int u = F.bid; u < NSEQ * NCH * SSG; u += F.G) {
        const int g = u % SSG, c = (u / SSG) % NCH, b = u / (SSG * NCH), m0 = b * SEQ + c * SSQ;
        { const int s = tid & 127, og = tid >> 7;
#pragma unroll
          for (int i = 0; i < 4; ++i) { const int n0 = (og * 4 + i) * 8; const u32x4 v = *(const u32x4*)(BC + (size_t)(m0 + s) * 1024 + g * 128 + n0);
              const unsigned ws_[4] = {v.x, v.y, v.z, v.w};
#pragma unroll
              for (int j = 0; j < 8; ++j) *(LAS bf16_t*)(BT + ((n0 + j) * TP + s) * 2) = (bf16_t)((j & 1) ? (ws_[j >> 1] >> 16) : (ws_[j >> 1] & 0xffffu)); } }
        const int ps_ = tid & 127, pog = tid >> 7;
        const float* dtp = dt + (size_t)(m0 + ps_) * 64 + (tid < 128 ? 0 : 32);
        const bf16_t* xp = XS + (size_t)(m0 + ps_) * DM + pog * 16;
        float dtn = dtp[g * 8]; u32x4 xn0 = *(const u32x4*)(xp + g * 512), xn1 = *(const u32x4*)(xp + g * 512 + 8);
        for (int h8 = 0; h8 < 8; ++h8) {
            const int h = g * 8 + h8;
            const float a_f = -__expf(inp(I_ALOG)[e * 64 + h]), a_b = -__expf(inp(I_ALOG)[e * 64 + 32 + h]);
            const float dtv = dtn; const u32x4 xv0 = xn0, xv1 = xn1;
            if (h8 < 7) { dtn = dtp[h + 1]; xn0 = *(const u32x4*)(xp + (h + 1) * 64); xn1 = *(const u32x4*)(xp + (h + 1) * 64 + 8); }
            ssd_scans_r(F, sc, dtv, a_f, a_b);
            { const int s = ps_, og = pog; const float csl = sc[SC_CSF + 127];
              const float wf = sc[SC_DTF + s] * __expf(csl - sc[SC_CSF + s]), wb = sc[SC_DTB + s] * __expf(sc[SC_EB + s]);
#pragma unroll
              for (int i = 0; i < 2; ++i) { const int p0 = (og * 2 + i) * 8; float v[8]; unpack8(i ? xv1 : xv0, v);
#pragma unroll
                  for (int j = 0; j < 8; ++j) { *(LAS bf16_t*)(XF + ((p0 + j) * TP + s) * 2) = f2bf(v[j] * wf); *(LAS bf16_t*)(XB + ((p0 + j) * TP + s) * 2) = f2bf(v[j] * wb); } } }
            LDS_BARRIER();
            { const LAS unsigned char* X = (wave < 4) ? XF : XB; const int nb = (wave & 3) * 32;
              f32x4 acc[4][2];
#pragma unroll
              for (int pt = 0; pt < 4; ++pt)
#pragma unroll
                  for (int nt = 0; nt < 2; ++nt) acc[pt][nt] = (f32x4){0.f, 0.f, 0.f, 0.f};
#pragma unroll
              for (int k0 = 0; k0 < 128; k0 += 32) { bf16x8 a[2], bb[4];
#pragma unroll
                  for (int nt = 0; nt < 2; ++nt) a[nt] = frag16(BT, nb + nt * 16 + (lane & 15), k0, lane);
#pragma unroll
                  for (int pt = 0; pt < 4; ++pt) bb[pt] = frag16(X, pt * 16 + (lane & 15), k0, lane);
#pragma unroll
                  for (int pt = 0; pt < 4; ++pt)
#pragma unroll
                      for (int nt = 0; nt < 2; ++nt) acc[pt][nt] = __builtin_amdgcn_mfma_f32_16x16x32_bf16(a[nt], bb[pt], acc[pt][nt], 0, 0, 0); }
              bf16_t* ST = ((wave < 4) ? STF : STB) + (size_t)((b * NCH + c) * SSH + h) * (SSP * SSN);
#pragma unroll
              for (int pt = 0; pt < 4; ++pt)
#pragma unroll
                  for (int nt = 0; nt < 2; ++nt) { const int p = pt * 16 + (lane & 15), n = nb + nt * 16 + (lane >> 4) * 4;
                      u32x2 w; w.x = cvt_pk_c(acc[pt][nt][0], acc[pt][nt][1]); w.y = cvt_pk_c(acc[pt][nt][2], acc[pt][nt][3]);
                      *(u32x2*)(ST + p * SSN + n) = w; } }
            if (tid == 0) { TOT[((b * NCH + c) * SSH + h) * 2] = sc[SC_CSF + 127]; TOT[((b * NCH + c) * SSH + h) * 2 + 1] = sc[SC_EBT]; }
            LDS_BARRIER();
        }
    }
}
__device__ __forceinline__ void phase_ssd_scan(Frame& F) {
    bf16_t* STF = (bf16_t*)(F.ws + WS_STF); bf16_t* STB = (bf16_t*)(F.ws + WS_STB); const float* TOT = (const float*)(F.ws + WS_TOT);
    const int nitem = NSEQ * SSH * 2 * 1024;
    for (int it = F.bid * 512 + F.tid; it < nitem; it += F.G * 512) {
        const int o8 = it & 1023, dir = (it >> 10) & 1, h = (it >> 11) % SSH, b = it / (2048 * SSH);
        bf16_t* base = (dir ? STB : STF) + (size_t)o8 * 8;
        float carry[8];
#pragma unroll
        for (int j = 0; j < 8; ++j) carry[j] = 0.f;
        for (int cc0 = 0; cc0 < NCH; cc0 += 8) {
            u32x4 sv[8]; float tv[8];
#pragma unroll
            for (int k = 0; k < 8; ++k) { const int c = dir ? (NCH - 1 - cc0 - k) : (cc0 + k); const size_t idx = (size_t)((b * NCH + c) * SSH + h);
                sv[k] = *(const u32x4*)(base + idx * (SSP * SSN)); tv[k] = TOT[idx * 2 + dir]; }
#pragma unroll
            for (int k = 0; k < 8; ++k) { const int c = dir ? (NCH - 1 - cc0 - k) : (cc0 + k); const size_t idx = (size_t)((b * NCH + c) * SSH + h);
                float s[8]; unpack8(sv[k], s);
                *(u32x4*)(base + idx * (SSP * SSN)) = pack8(carry);
                const float dec = __expf(tv[k]);
#pragma unroll
                for (int j = 0; j < 8; ++j) carry[j] = carry[j] * dec + s[j]; }
        }
    }
}
__device__ __forceinline__ void phase_ssd_out(Frame& F, int e) {
    LAS unsigned char* CM = F.lds; LAS unsigned char* BM = F.lds + 34816; LAS unsigned char* SF = F.lds + 69632; LAS unsigned char* SB = F.lds + 87040;
    LAS unsigned char* XT = F.lds + 104448; LAS unsigned char* WM = BM; LAS float* sc = (LAS float*)(F.lds + 121856);
    const bf16_t* XS = F.h; const bf16_t* BC = (const bf16_t*)(F.ws + WS_BC); const float* dt = (const float*)(F.ws + WS_DT);
    const bf16_t* STF = (const bf16_t*)(F.ws + WS_STF); const bf16_t* STB = (const bf16_t*)(F.ws + WS_STB); bf16_t* P = (bf16_t*)(F.ws + WS_PROJ);
    const int tid = F.tid, lane = F.lane, wave = F.wave;
    for (int u = F.bid; u < NSEQ * NCH * SSG; u += F.G) {
        const int g = u % SSG, c = (u / SSG) % NCH, b = u / (SSG * NCH), m0 = b * SEQ + c * SSQ;
        { const int r = tid >> 2, q = tid & 3;
#pragma unroll
          for (int i = 0; i < 4; ++i) { const int o = q * 4 + i;
              *(LAS u32x4*)(CM + r * (TP * 2) + o * 16) = *(const u32x4*)(BC + (size_t)(m0 + r) * 1024 + 512 + g * 128 + o * 8);
              *(LAS u32x4*)(BM + r * (TP * 2) + o * 16) = *(const u32x4*)(BC + (size_t)(m0 + r) * 1024 + g * 128 + o * 8); } }
        LDS_BARRIER();
        const int lb = (wave >> 1) * 32, sb = (wave & 1) * 64;
        f32x4 cb[2][4];
#pragma unroll
        for (int lt = 0; lt < 2; ++lt)
#pragma unroll
            for (int st = 0; st < 4; ++st) cb[lt][st] = (f32x4){0.f, 0.f, 0.f, 0.f};
#pragma unroll
        for (int k0 = 0; k0 < 128; k0 += 32) { bf16x8 a[4], bb[2];
#pragma unroll
            for (int st = 0; st < 4; ++st) a[st] = frag16(BM, sb + st * 16 + (lane & 15), k0, lane);
#pragma unroll
            for (int lt = 0; lt < 2; ++lt) bb[lt] = frag16(CM, lb + lt * 16 + (lane & 15), k0, lane);
#pragma unroll
            for (int lt = 0; lt < 2; ++lt)
#pragma unroll
                for (int st = 0; st < 4; ++st) cb[lt][st] = __builtin_amdgcn_mfma_f32_16x16x32_bf16(a[st], bb[lt], cb[lt][st], 0, 0, 0); }
        const int ps_ = tid & 127, pog = tid >> 7;
        const float* dtp = dt + (size_t)(m0 + ps_) * 64 + (tid < 128 ? 0 : 32);
        const bf16_t* xp = XS + (size_t)(m0 + ps_) * DM + pog * 16;
        const size_t sb0 = (size_t)((b * NCH + c) * SSH) * (SSP * SSN) + (size_t)tid * 8;
        float dtn = dtp[g * 8]; u32x4 xn0 = *(const u32x4*)(xp + g * 512), xn1 = *(const u32x4*)(xp + g * 512 + 8);
        u32x4 fn0 = *(const u32x4*)(STF + sb0 + (size_t)(g * 8) * 8192), fn1 = *(const u32x4*)(STF + sb0 + (size_t)(g * 8) * 8192 + 4096);
        u32x4 bn0 = *(const u32x4*)(STB + sb0 + (size_t)(g * 8) * 8192), bn1 = *(const u32x4*)(STB + sb0 + (size_t)(g * 8) * 8192 + 4096);
        for (int h8 = 0; h8 < 8; ++h8) {
            const int h = g * 8 + h8;
            const float a_f = -__expf(inp(I_ALOG)[e * 64 + h]), a_b = -__expf(inp(I_ALOG)[e * 64 + 32 + h]), dsk = inp(I_SD)[e * 32 + h];
            const float dtv = dtn;
            {
#pragma unroll
              for (int i = 0; i < 2; ++i) { const int idx = tid + 512 * i, p = idx >> 4, o = idx & 15;
                  *(LAS u32x4*)(SF + p * (TP * 2) + o * 16) = i ? fn1 : fn0; *(LAS u32x4*)(SB + p * (TP * 2) + o * 16) = i ? bn1 : bn0; }
#pragma unroll
              for (int i = 0; i < 2; ++i) { const int p0 = (pog * 2 + i) * 8; const u32x4 v = i ? xn1 : xn0;
                  const unsigned ws_[4] = {v.x, v.y, v.z, v.w};
#pragma unroll
                  for (int j = 0; j < 8; ++j) *(LAS bf16_t*)(XT + ((p0 + j) * TP + ps_) * 2) = (bf16_t)((j & 1) ? (ws_[j >> 1] >> 16) : (ws_[j >> 1] & 0xffffu)); } }
            if (h8 < 7) { dtn = dtp[h + 1]; xn0 = *(const u32x4*)(xp + (h + 1) * 64); xn1 = *(const u32x4*)(xp + (h + 1) * 64 + 8);
                fn0 = *(const u32x4*)(STF + sb0 + (size_t)(h + 1) * 8192); fn1 = *(const u32x4*)(STF + sb0 + (size_t)(h + 1) * 8192 + 4096);
                bn0 = *(const u32x4*)(STB + sb0 + (size_t)(h + 1) * 8192); bn1 = *(const u32x4*)(STB + sb0 + (size_t)(h + 1) * 8192 + 4096); }
            ssd_scans_r(F, sc, dtv, a_f, a_b);
            if (tid < 128) { sc[SC_RSF + tid] = __expf(sc[SC_CSF + tid]); sc[SC_RSB + tid] = __expf(sc[SC_EBT] - sc[SC_EB + tid]); }
#pragma unroll
            for (int lt = 0; lt < 2; ++lt) { const int l = lb + lt * 16 + (lane & 15); const float csl = sc[SC_CSF + l], ebl = sc[SC_EB + l];
#pragma unroll
                for (int st = 0; st < 4; ++st) { const int s0 = sb + st * 16 + (lane >> 4) * 4; float w[4];
                    const int dtile = ((sb >> 4) + st) - ((lb >> 4) + lt);
                    if (dtile < 0) { const f32x4 cs4 = *(const LAS f32x4*)(sc + SC_CSF + s0), d4 = *(const LAS f32x4*)(sc + SC_DTF + s0);
#pragma unroll
                        for (int j = 0; j < 4; ++j) w[j] = cb[lt][st][j] * (__expf(csl - cs4[j]) * d4[j]); }
                    else if (dtile > 0) { const f32x4 eb4 = *(const LAS f32x4*)(sc + SC_EB + s0), d4 = *(const LAS f32x4*)(sc + SC_DTB + s0);
#pragma unroll
                        for (int j = 0; j < 4; ++j) w[j] = cb[lt][st][j] * (__expf(eb4[j] - ebl) * d4[j]); }
                    else { const f32x4 cs4 = *(const LAS f32x4*)(sc + SC_CSF + s0), df4 = *(const LAS f32x4*)(sc + SC_DTF + s0), eb4 = *(const LAS f32x4*)(sc + SC_EB + s0), db4 = *(const LAS f32x4*)(sc + SC_DTB + s0);
#pragma unroll
                        for (int j = 0; j < 4; ++j) { const int s = s0 + j; float mk = 0.f;
                            if (s <= l) mk += __expf(csl - cs4[j]) * df4[j];
                            if (s >= l) mk += __expf(eb4[j] - ebl) * db4[j];
                            w[j] = cb[lt][st][j] * mk + (s == l ? dsk : 0.f); } }
                    u32x2 pk; pk.x = cvt_pk_c(w[0], w[1]); pk.y = cvt_pk_c(w[2], w[3]);
                    *(LAS u32x2*)(WM + (l * TP + s0) * 2) = pk; } }
            LDS_BARRIER();
            { f32x4 aD[4], aF[4], aB[4];
#pragma unroll
              for (int pt = 0; pt < 4; ++pt) { aD[pt] = (f32x4){0.f, 0.f, 0.f, 0.f}; aF[pt] = aD[pt]; aB[pt] = aD[pt]; }
              const int l = wave * 16 + (lane & 15);
#pragma unroll
              for (int k0 = 0; k0 < 128; k0 += 32) { const bf16x8 wv = frag16(WM, l, k0, lane), cv = frag16(CM, l, k0, lane);
#pragma unroll
                  for (int pt = 0; pt < 4; ++pt) { const int pr = pt * 16 + (lane & 15);
                      aD[pt] = __builtin_amdgcn_mfma_f32_16x16x32_bf16(frag16(XT, pr, k0, lane), wv, aD[pt], 0, 0, 0);
                      aF[pt] = __builtin_amdgcn_mfma_f32_16x16x32_bf16(frag16(SF, pr, k0, lane), cv, aF[pt], 0, 0, 0);
                      aB[pt] = __builtin_amdgcn_mfma_f32_16x16x32_bf16(frag16(SB, pr, k0, lane), cv, aB[pt], 0, 0, 0); } }
              const float rsf = sc[SC_RSF + l], rsb = sc[SC_RSB + l];
              bf16_t* yrow = P + (size_t)(m0 + l) * PW + PC_X + h * 64;
#pragma unroll
              for (int pt = 0; pt < 4; ++pt) { const f32x4 y = aD[pt] + aF[pt] * rsf + aB[pt] * rsb; const int p = pt * 16 + (lane >> 4) * 4;
                  u32x2 pk; pk.x = cvt_pk_c(y[0], y[1]); pk.y = cvt_pk_c(y[2], y[3]); *(u32x2*)(yrow + p) = pk; } }
            LDS_BARRIER();
        }
    }
}
namespace att {
constexpr int D = 128, NW = 8, QBLK = 32, KVBLK = 64;
constexpr float SCALE = 0.088388347648318440f;
constexpr float THR = 8.f;
constexpr int LDQ = PW, LDK = PW, LDO = PW;
constexpr size_t SHM_V = KVBLK * D * 2, SHM_K = KVBLK * D * 2, SHM_ATTN = 3 * SHM_V + 2 * SHM_K + NW * 64 * 4;
#define KSWZ(row, colB) ((row) * 256 + ((colB) ^ (((row) & 7) << 4)))
#define SBAR() __builtin_amdgcn_sched_barrier(0)
__device__ __forceinline__ int crow(int r, int hi) { return (r & 3) + 8 * (r >> 2) + 4 * hi; }
__device__ __forceinline__ void partialSM(f32x16& p0, f32x16& p1, float& m_reg, float& mn, float& alpha) {
  constexpr float C = SCALE * 1.4426950408889634f;
  float pmax = p0[0]; for (int r = 1; r < 16; ++r) pmax = fmaxf(pmax, p0[r]); for (int r = 0; r < 16; ++r) pmax = fmaxf(pmax, p1[r]);
  { auto rr = __builtin_amdgcn_permlane32_swap(__float_as_uint(pmax), __float_as_uint(pmax), false, false);
    pmax = fmaxf(__uint_as_float(rr[0]), __uint_as_float(rr[1])); }
  if (__builtin_expect(__all(pmax - m_reg <= THR / SCALE), 1)) { mn = m_reg; alpha = 1.f; }
  else { mn = fmaxf(m_reg, pmax); alpha = __builtin_amdgcn_exp2f((m_reg - mn) * C); m_reg = mn; }
  float mnC = -mn * C;
  for (int r = 0; r < 16; ++r) p0[r] = fmaf(p0[r], C, mnC); for (int r = 0; r < 16; ++r) p1[r] = fmaf(p1[r], C, mnC);
  for (int r = 0; r < 16; ++r) p0[r] = __builtin_amdgcn_exp2f(p0[r]);
}
__device__ __forceinline__ void finishSM(f32x16& p0, f32x16& p1, float alpha, float& l_reg, bf16x8& pa0, bf16x8& pa1, bf16x8& pa2, bf16x8& pa3) {
  for (int r = 0; r < 16; ++r) p1[r] = __builtin_amdgcn_exp2f(p1[r]);
  float ps = 0; for (int r = 0; r < 16; ++r) ps += p0[r]; for (int r = 0; r < 16; ++r) ps += p1[r];
  { auto rr = __builtin_amdgcn_permlane32_swap(__float_as_uint(ps), __float_as_uint(ps), false, false);
    ps = __uint_as_float(rr[0]) + __uint_as_float(rr[1]); }
  l_reg = l_reg * alpha + ps;
#define PK4(P, BASE, OUT) do { unsigned a0 = cvt_pk_bf16(P[BASE + 0], P[BASE + 1]), a1 = cvt_pk_bf16(P[BASE + 2], P[BASE + 3]);   \
    unsigned b0 = cvt_pk_bf16(P[BASE + 4], P[BASE + 5]), b1 = cvt_pk_bf16(P[BASE + 6], P[BASE + 7]);                              \
    auto r0 = __builtin_amdgcn_permlane32_swap(a0, b0, false, false); auto r1 = __builtin_amdgcn_permlane32_swap(a1, b1, false, false); \
    u32x4 w = {r0[0], r1[0], r0[1], r1[1]}; OUT = *reinterpret_cast<bf16x8*>(&w); } while (0)
  PK4(p0, 0, pa0); PK4(p0, 8, pa1); PK4(p1, 0, pa2); PK4(p1, 8, pa3);
#undef PK4
}
__device__ __forceinline__ void qkt(f32x16& p0, f32x16& p1, const bf16_t* Ks, const bf16x8* qr, int r32, int hi) {
  p0 = f32x16{}; p1 = f32x16{};
  for (int d0 = 0; d0 < 8; ++d0) { int cb = (d0 * 16 + hi * 8) * 2;
    bf16x8 b0 = *reinterpret_cast<const bf16x8*>((const char*)Ks + KSWZ(r32, cb));
    bf16x8 b1 = *reinterpret_cast<const bf16x8*>((const char*)Ks + KSWZ(32 + r32, cb));
    p0 = __builtin_amdgcn_mfma_f32_32x32x16_bf16(b0, qr[d0], p0, 0, 0, 0);
    p1 = __builtin_amdgcn_mfma_f32_32x32x16_bf16(b1, qr[d0], p1, 0, 0, 0); }
}
__device__ __forceinline__ int v_st(int k, int c) { const int kk = (k & ~0xC) | ((k & 4) << 1) | ((k & 8) >> 1); return ((kk >> 3) * 4 + (c >> 5)) * 512 + ((kk & 7) * 32 + (c & 31)) * 2; }
__device__ __forceinline__ int v_rd_base(int lane) { return ((lane & 3) << 3) | (((lane >> 2) & 3) << 6) | (((lane >> 4) & 1) << 5) | (((lane >> 5) & 1) << 8); }
constexpr int v_rd_off(int d0, int ks, int half) { return d0 * 512 + ks * 4096 + half * 2048; }
template <int OFF> __device__ __forceinline__ s16x4 tr_read(int vb) {
  s16x4 r; asm volatile("ds_read_b64_tr_b16 %0, %1 offset:%2" : "=&v"(r) : "v"(vb), "i"(OFF) : "memory"); return r;
}
struct VFrag { s16x4 l0, h0, l1, h1, l2, h2, l3, h3; };
template <int D0> __device__ __forceinline__ void v_reads(VFrag& f, int vb) {
  f.l0 = tr_read<v_rd_off(D0, 0, 0)>(vb); f.h0 = tr_read<v_rd_off(D0, 0, 1)>(vb); f.l1 = tr_read<v_rd_off(D0, 1, 0)>(vb); f.h1 = tr_read<v_rd_off(D0, 1, 1)>(vb);
  f.l2 = tr_read<v_rd_off(D0, 2, 0)>(vb); f.h2 = tr_read<v_rd_off(D0, 2, 1)>(vb); f.l3 = tr_read<v_rd_off(D0, 3, 0)>(vb); f.h3 = tr_read<v_rd_off(D0, 3, 1)>(vb);
}
__device__ __forceinline__ void pv_mma(f32x16& od, const VFrag& f, bf16x8 pa0, bf16x8 pa1, bf16x8 pa2, bf16x8 pa3) {
#define PK(L, H) (bf16x8){L[0], L[1], L[2], L[3], H[0], H[1], H[2], H[3]}
  od = __builtin_amdgcn_mfma_f32_32x32x16_bf16(pa0, PK(f.l0, f.h0), od, 0, 0, 0);
  od = __builtin_amdgcn_mfma_f32_32x32x16_bf16(pa1, PK(f.l1, f.h1), od, 0, 0, 0);
  od = __builtin_amdgcn_mfma_f32_32x32x16_bf16(pa2, PK(f.l2, f.h2), od, 0, 0, 0);
  od = __builtin_amdgcn_mfma_f32_32x32x16_bf16(pa3, PK(f.l3, f.h3), od, 0, 0, 0);
#undef PK
}
__device__ __forceinline__ void pv_d0(f32x16* o, int vb, bf16x8 pa0, bf16x8 pa1, bf16x8 pa2, bf16x8 pa3) {
  VFrag A, B;
  v_reads<0>(A, vb); v_reads<1>(B, vb);
  asm volatile("s_waitcnt lgkmcnt(8)" ::: "memory"); SBAR(); pv_mma(o[0], A, pa0, pa1, pa2, pa3); SBAR();
  v_reads<2>(A, vb);
  asm volatile("s_waitcnt lgkmcnt(8)" ::: "memory"); SBAR(); pv_mma(o[1], B, pa0, pa1, pa2, pa3); SBAR();
  v_reads<3>(B, vb);
  asm volatile("s_waitcnt lgkmcnt(8)" ::: "memory"); SBAR(); pv_mma(o[2], A, pa0, pa1, pa2, pa3);
  asm volatile("s_waitcnt lgkmcnt(0)" ::: "memory"); SBAR(); pv_mma(o[3], B, pa0, pa1, pa2, pa3);
}
__device__ __forceinline__ void attn_dense_body(const bf16_t* Qb, const bf16_t* Kh, const bf16_t* Vh,
                                                bf16_t* Ob, int seq, LAS unsigned char* ldsl) {
#if MK_FUSED
  int tid_ = threadIdx.x; asm volatile("" : "+v"(tid_)); const int tid = tid_ & 511;
#else
  const int tid = threadIdx.x;
#endif
  char* lds = (char*)ldsl;
  const int wid = tid >> 6, lane = tid & 63, r32 = lane & 31, hi = lane >> 5, widu = __builtin_amdgcn_readfirstlane(wid);
  bf16_t* V_lds = (bf16_t*)lds; bf16_t* K_lds = (bf16_t*)(lds + 3 * SHM_V);
  float* ws = (float*)(lds + 3 * SHM_V + 2 * SHM_K) + wid * 64; float* li_l = ws; float* al_l = ws + 32;
  float m_reg = -1e30f, l_reg = 0; f32x16 o[4] = {}; bf16x8 qr[8];
  const bf16_t* Qw = Qb + (long)(wid * QBLK + r32) * LDQ + hi * 8;
#pragma unroll
  for (int d0 = 0; d0 < 8; ++d0) qr[d0] = *reinterpret_cast<const bf16x8*>(Qw + d0 * 16);
  const int vb0 = (int)(uintptr_t)V_lds + v_rd_base(lane);
  unsigned kof[2], vof[2];
#pragma unroll
  for (int i = 0; i < 2; ++i) { const int sl = i * 512 + tid, row = sl >> 4, ch = (sl & 15) ^ (row & 7);
    kof[i] = (unsigned)(row * LDK + ch * 8) * 2u;
    const int kk = ((sl >> 7) << 3) | ((sl & 31) >> 2), k = (kk & ~0xC) | ((kk & 4) << 1) | ((kk & 8) >> 1), c = ((sl >> 5) & 3) * 32 + (sl & 3) * 8;
    vof[i] = (unsigned)(k * LDK + c) * 2u; }
  const unsigned ldsw = (unsigned)widu * 1024u;
  if (widu >= 4) __builtin_amdgcn_s_setprio(1);
#define ADMA(t, kb, voff) do { const char* kp_ = (const char*)(Kh + (long)(t) * KVBLK * LDK); const char* vp_ = (const char*)(Vh + (long)(t) * KVBLK * LDK); \
    _Pragma("unroll") for (int i_ = 0; i_ < 2; ++i_) { \
      __builtin_amdgcn_global_load_lds((const unsigned*)(kp_ + kof[i_]), (LAS unsigned*)(ldsl + 3 * SHM_V + (kb) * SHM_K + ldsw + i_ * 8192), 16, 0, 0); \
      __builtin_amdgcn_global_load_lds((const unsigned*)(vp_ + vof[i_]), (LAS unsigned*)(ldsl + (voff) + ldsw + i_ * 8192), 16, 0, 0); } } while (0)
#define AWAIT() asm volatile("s_waitcnt vmcnt(0)" ::: "memory")
#define RESC(a) do { if (__any((a) < 1.f)) { if (hi == 0) al_l[r32] = (a); asm volatile("s_waitcnt lgkmcnt(0)" ::: "memory"); \
    for (int d = 0; d < 4; ++d) for (int r = 0; r < 16; ++r) o[d][r] *= al_l[crow(r, hi)]; } } while (0)
  f32x16 pA0, pA1, pB0, pB1; float mnA, mnB, alA, alB; bf16x8 pa0, pa1, pa2, pa3; const int NT = seq / KVBLK;
  int va = 0, vb = (int)SHM_V, vc = 2 * (int)SHM_V;
  ADMA(0, 0, 0); AWAIT(); __syncthreads();
  ADMA(1, 1, (unsigned)SHM_V);
  qkt(pA0, pA1, K_lds, qr, r32, hi); partialSM(pA0, pA1, m_reg, mnA, alA);
  AWAIT();
  for (int t = 1; t + 1 < NT; t += 2) {
    __syncthreads();
    ADMA(t + 1, 0, (unsigned)vc);
    SBAR(); qkt(pB0, pB1, (bf16_t*)((char*)K_lds + SHM_K), qr, r32, hi);
    finishSM(pA0, pA1, alA, l_reg, pa0, pa1, pa2, pa3); SBAR();
    pv_d0(o, vb0 + va, pa0, pa1, pa2, pa3); partialSM(pB0, pB1, m_reg, mnB, alB);
    RESC(alB);
    AWAIT();
    { const int t_ = va; va = vb; vb = vc; vc = t_; }
    __syncthreads();
    if (t + 2 < NT) ADMA(t + 2, 1, (unsigned)vc);
    SBAR(); qkt(pA0, pA1, K_lds, qr, r32, hi);
    finishSM(pB0, pB1, alB, l_reg, pa0, pa1, pa2, pa3); SBAR();
    pv_d0(o, vb0 + va, pa0, pa1, pa2, pa3); partialSM(pA0, pA1, m_reg, mnA, alA);
    RESC(alA);
    AWAIT();
    { const int t_ = va; va = vb; vb = vc; vc = t_; }
  }
  __syncthreads();
  SBAR(); qkt(pB0, pB1, (bf16_t*)((char*)K_lds + SHM_K), qr, r32, hi);
  finishSM(pA0, pA1, alA, l_reg, pa0, pa1, pa2, pa3); SBAR();
  pv_d0(o, vb0 + va, pa0, pa1, pa2, pa3); partialSM(pB0, pB1, m_reg, mnB, alB);
  RESC(alB);
  finishSM(pB0, pB1, alB, l_reg, pa0, pa1, pa2, pa3); SBAR();
  pv_d0(o, vb0 + vb, pa0, pa1, pa2, pa3);
  if (hi == 0) li_l[r32] = l_reg; asm volatile("s_waitcnt lgkmcnt(0)" ::: "memory");
  float rli[16];
#pragma unroll
  for (int r = 0; r < 16; ++r) rli[r] = __builtin_amdgcn_rcpf(li_l[crow(r, hi)]);
  bf16_t* Ow = Ob + (long)(wid * QBLK) * LDO;
#pragma unroll
  for (int r = 0; r < 16; r += 2) {
    const int odd = lane & 1, orow = crow(r + odd, hi);
    for (int d0 = 0; d0 < 4; ++d0) { const float a = o[d0][r] * rli[r], b = o[d0][r + 1] * rli[r + 1];
      const float recv = __shfl_xor(odd ? a : b, 1);
      *(unsigned*)(Ow + (long)orow * LDO + d0 * 32 + (r32 & ~1)) = odd ? cvt_pk_c(recv, b) : cvt_pk_c(a, recv); } }
  __builtin_amdgcn_s_setprio(0);
#undef ADMA
#undef AWAIT
#undef RESC
}
#undef KSWZ
#undef SBAR
}

__device__ __forceinline__ void phase_attention(Frame& F) {
    bf16_t* P = (bf16_t*)(F.ws + WS_PROJ);
    const int vcu = (F.G % 8 == 0) ? (F.bid % 8) * (F.G / 8) + F.bid / 8 : F.bid;
    for (int u = vcu; u < NSEQ * AH * (SEQ / 256); u += F.G) {
        const int qb = u % (SEQ / 256), h = (u / (SEQ / 256)) % AH, b = u / ((SEQ / 256) * AH), kvh = h / (AH / AKV);
        bf16_t* Qb = P + (size_t)(b * SEQ + qb * 256) * PW + PC_Q + h * AD;
        const bf16_t* Kh = P + (size_t)(b * SEQ) * PW + PC_K + kvh * AD; const bf16_t* Vh = P + (size_t)(b * SEQ) * PW + PC_V + kvh * AD;
        att::attn_dense_body(Qb, Kh, Vh, Qb, SEQ, F.lds);
        __syncthreads();
    }
}
__device__ __forceinline__ void phase_xa_softmax(Frame& F) {
    const float* SC = (const float*)(F.ws + WS_SC); bf16_t* Pm = (bf16_t*)(F.ws + WS_P);
    const int gw = F.bid * 8 + F.wave, NGW = F.G * 8, lane = F.lane;
    for (int m = gw; m < T; m += NGW) {
#pragma unroll
        for (int hh = 0; hh < XAH; ++hh) {
            const f32x4 s = *(const f32x4*)(SC + (size_t)m * 1024 + hh * 256 + lane * 4);
            const float mx = wave_max(fmaxf(fmaxf(s.x, s.y), fmaxf(s.z, s.w)));
            const float e0 = __expf(s.x - mx), e1 = __expf(s.y - mx), e2 = __expf(s.z - mx), e3 = __expf(s.w - mx);
            const float inv = 1.0f / wave_sum((e0 + e1) + (e2 + e3));
            u32x2 w; w.x = cvt_pk_bf16(e0 * inv, e1 * inv); w.y = cvt_pk_bf16(e2 * inv, e3 * inv);
            *(u32x2*)(Pm + (size_t)m * 1024 + hh * 256 + lane * 4) = w;
        }
    }
}
__device__ __forceinline__ void phase_ffn_fix(Frame& F, int layer) {
    const bf16_t* SB = (const bf16_t*)(F.ws + WS_SB); bf16_t* ACT = (bf16_t*)(F.ws + WS_ACT);
    const float* cw = inp(I_FCW) + (size_t)layer * 3 * F2; const float* cb = inp(I_FCB) + (size_t)layer * F2;
    const int nitem = (T / 64) * 2 * (DFF / 8);
    for (int it = F.bid * 512 + F.tid; it < nitem; it += F.G * 512) {
        const int oc = it % (DFF / 8), rest = it / (DFF / 8), which = rest & 1, blk = rest >> 1, f = oc * 8, bs = blk % (SEQ / 64);
        const bf16_t* pp = which ? SB + ((size_t)blk * 4 + 2) * F2 : SB + ((size_t)(blk - 1) * 4 + 3) * F2;
        const bf16_t* ps = which ? SB + ((size_t)blk * 4 + 3) * F2 : SB + ((size_t)blk * 4 + 0) * F2;
        const bf16_t* pn = which ? SB + ((size_t)(blk + 1) * 4 + 0) * F2 : SB + ((size_t)blk * 4 + 1) * F2;
        const bool hasp = which ? true : (bs != 0), hasn = which ? (bs != SEQ / 64 - 1) : true;
        float gp[8], gq[8], gn[8], up[8], uq[8], un[8];
        unpack8(*(const u32x4*)(ps + f), gq); unpack8(*(const u32x4*)(ps + DFF + f), uq);
        if (hasp) { unpack8(*(const u32x4*)(pp + f), gp); unpack8(*(const u32x4*)(pp + DFF + f), up); }
        else {
#pragma unroll
            for (int j = 0; j < 8; ++j) { gp[j] = 0.f; up[j] = 0.f; } }
        if (hasn) { unpack8(*(const u32x4*)(pn + f), gn); unpack8(*(const u32x4*)(pn + DFF + f), un); }
        else {
#pragma unroll
            for (int j = 0; j < 8; ++j) { gn[j] = 0.f; un[j] = 0.f; } }
        float o[8];
#pragma unroll
        for (int j = 0; j < 8; ++j) {
            const float G = cb[f + j] + cw[f + j] * gp[j] + cw[F2 + f + j] * gq[j] + cw[2 * F2 + f + j] * gn[j];
            const float U = cb[DFF + f + j] + cw[DFF + f + j] * up[j] + cw[F2 + DFF + f + j] * uq[j] + cw[2 * F2 + DFF + f + j] * un[j];
            o[j] = silu_f(G) * U; }
        *(u32x4*)(ACT + (size_t)(blk * 64 + (which ? 63 : 0)) * DFF + f) = pack8(o);
    }
}

__device__ __forceinline__ void phase_hy_kern(Frame& F, int e) {
    const float* h3 = (const float*)(F.ws + WS_H3); float* KERN = (float*)(F.ws + WS_KERN); const float* wo = inp(I_FWO) + (size_t)e * 64 * 4096;
    typedef float f32x16c __attribute__((ext_vector_type(16)));
    const f32x16c __attribute__((address_space(4)))* wo16 = (const f32x16c __attribute__((address_space(4)))*)(uintptr_t)wo;
    LAS f32x4* hl = (LAS f32x4*)F.lds;
    for (int u = F.bid; u < 16 * 32; u += F.G) {
        const int tb = u & 15, cbk = u >> 4, t = tb * 512 + F.tid;
#pragma unroll
        for (int j = 0; j < 16; ++j) hl[j * 512 + F.tid] = *(const f32x4*)(h3 + (size_t)t * 64 + j * 4);
        const float tl = (float)t / (float)(SEQ - 1);
#pragma unroll 1
        for (int cb16 = 0; cb16 < 8; ++cb16) {
            const int c2b = __builtin_amdgcn_readfirstlane(cbk * 128 + cb16 * 16);
            float a[16];
#pragma unroll
            for (int i = 0; i < 16; ++i) a[i] = 0.f;
#pragma unroll 1
            for (int j4 = 0; j4 < 16; ++j4) {
                const f32x4 h = hl[j4 * 512 + F.tid];
#pragma unroll
                for (int q = 0; q < 4; ++q) { const f32x16c w16 = wo16[((j4 * 4 + q) * 4096 + c2b) >> 4];
#pragma unroll
                    for (int i = 0; i < 16; ++i) a[i] += h[q] * w16[i]; }
            }
#pragma unroll
            for (int i = 0; i < 16; ++i) {
                const int c2 = c2b + i, ch = c2 & (DM - 1);
                const float delta = fabsf(-3.0701134573253944f + (float)ch * ((-15.350567286626972f + 3.0701134573253944f) / (float)(DM - 1)));
                const float val = a[i] * __expf(-tl * delta);
                if (c2 < DM) KERN[(size_t)ch * FFTN + t] = val;
                else { if (t >= 1) KERN[(size_t)ch * FFTN + FFTN - t] = val; else KERN[(size_t)ch * FFTN + SEQ] = 0.f; }
            }
        }
    }
}
__device__ __forceinline__ void phase_hy_tout(Frame& F, int e) {
    const bf16_t* PHT = (const bf16_t*)(F.ws + WS_PHY); const bf16_t* UT = (const bf16_t*)(F.ws + WS_UT); bf16_t* Y = F.h;
    const float* cw = inp(I_HCW) + (size_t)e * 3 * HYW; const float* cb = inp(I_HCB) + (size_t)e * HYW;
    LAS bf16_t* tile = (LAS bf16_t*)(F.lds + F.wave * (64 * 72 * 2));
    const int gw = F.bid * 8 + F.wave, NGW = F.G * 8, lane = F.lane;
    for (int it = gw; it < (T / 64) * (DM / 64); it += NGW) {
        const int cblk = it % (DM / 64), tblk = it / (DM / 64), m0 = tblk * 64, t0 = m0 % SEQ, b = m0 / SEQ, c0 = cblk * 64;
        u32x4 xw[8], yw[8]; unsigned xl[8], xh[8];
#pragma unroll
        for (int ps = 0; ps < 8; ++ps) { const int c = (lane >> 3) + 8 * ps, to = (lane & 7) * 8, ch = c0 + c, t = t0 + to;
            const bf16_t* xr = PHT + (size_t)ch * T + (size_t)b * SEQ + t;
            xw[ps] = *(const u32x4*)xr; yw[ps] = *(const u32x4*)(UT + ((size_t)(b * DM + ch)) * SEQ + t);
            xl[ps] = t > 0 ? (unsigned)xr[-1] : 0u; xh[ps] = t + 8 < SEQ ? (unsigned)xr[8] : 0u; }
#pragma unroll
        for (int ps = 0; ps < 8; ++ps) {
            const int c = (lane >> 3) + 8 * ps, to = (lane & 7) * 8, ch = c0 + c;
            float x[10], y[8];
            unpack8(xw[ps], *(float (*)[8])&x[1]); unpack8(yw[ps], y);
            x[0] = bf2f(xl[ps]); x[9] = bf2f(xh[ps]);
            const float w0 = cw[ch], w1 = cw[HYW + ch], w2 = cw[2 * HYW + ch], bb = cb[ch];
            float ov[8];
#pragma unroll
            for (int j = 0; j < 8; ++j) ov[j] = (bb + w0 * x[j] + w1 * x[j + 1] + w2 * x[j + 2]) * y[j];
            *(LAS u32x4*)(tile + c * 72 + to) = pack8(ov);
        }
        LDS_WAIT(); asm volatile("" ::: "memory");
        const int o = lane & 7, rs = lane >> 3;
        for (int ps = 0; ps < 8; ++ps) {
            const int r = rs + 8 * ps; unsigned short v[8];
#pragma unroll
            for (int j = 0; j < 8; ++j) v[j] = tile[(o * 8 + j) * 72 + r];
            u32x4 w; w.x = v[0] | ((unsigned)v[1] << 16); w.y = v[2] | ((unsigned)v[3] << 16); w.z = v[4] | ((unsigned)v[5] << 16); w.w = v[6] | ((unsigned)v[7] << 16);
            *(u32x4*)(Y + (size_t)(m0 + r) * DM + c0 + o * 8) = w;
        }
        LDS_WAIT(); asm volatile("" ::: "memory");
    }
}
__device__ __forceinline__ f32x2 mk2(float a, float b) { f32x2 r; r.x = a; r.y = b; return r; }
__device__ __forceinline__ void dft16(f32x2 (&x)[16]) {
  f32x2 a[4][4];
  { const f32x2 s0 = x[0] + x[8], s1 = x[0] - x[8], s2 = x[4] + x[12], t3 = x[4] - x[12]; const f32x2 s3 = mk2(t3.y, -t3.x);
    a[0][0] = s0 + s2; a[0][1] = s1 + s3; a[0][2] = s0 - s2; a[0][3] = s1 - s3; }
  { const f32x2 s0 = x[1] + x[9], s1 = x[1] - x[9], s2 = x[5] + x[13], t3 = x[5] - x[13]; const f32x2 s3 = mk2(t3.y, -t3.x);
    a[1][0] = s0 + s2; a[1][1] = s1 + s3; a[1][2] = s0 - s2; a[1][3] = s1 - s3; }
  { const f32x2 s0 = x[2] + x[10], s1 = x[2] - x[10], s2 = x[6] + x[14], t3 = x[6] - x[14]; const f32x2 s3 = mk2(t3.y, -t3.x);
    a[2][0] = s0 + s2; a[2][1] = s1 + s3; a[2][2] = s0 - s2; a[2][3] = s1 - s3; }
  { const f32x2 s0 = x[3] + x[11], s1 = x[3] - x[11], s2 = x[7] + x[15], t3 = x[7] - x[15]; const f32x2 s3 = mk2(t3.y, -t3.x);
    a[3][0] = s0 + s2; a[3][1] = s1 + s3; a[3][2] = s0 - s2; a[3][3] = s1 - s3; }
  a[1][1] = mk2(a[1][1].x * 0.9238795325112867f - a[1][1].y * -0.3826834323650898f, a[1][1].x * -0.3826834323650898f + a[1][1].y * 0.9238795325112867f);
  a[1][2] = mk2(a[1][2].x * 0.7071067811865476f - a[1][2].y * -0.7071067811865475f, a[1][2].x * -0.7071067811865475f + a[1][2].y * 0.7071067811865476f);
  a[1][3] = mk2(a[1][3].x * 0.38268343236508984f - a[1][3].y * -0.9238795325112867f, a[1][3].x * -0.9238795325112867f + a[1][3].y * 0.38268343236508984f);
  a[2][1] = mk2(a[2][1].x * 0.7071067811865476f - a[2][1].y * -0.7071067811865475f, a[2][1].x * -0.7071067811865475f + a[2][1].y * 0.7071067811865476f);
  a[2][2] = mk2(a[2][2].x * 6.123233995736766e-17f - a[2][2].y * -1.0f, a[2][2].x * -1.0f + a[2][2].y * 6.123233995736766e-17f);
  a[2][3] = mk2(a[2][3].x * -0.7071067811865475f - a[2][3].y * -0.7071067811865476f, a[2][3].x * -0.7071067811865476f + a[2][3].y * -0.7071067811865475f);
  a[3][1] = mk2(a[3][1].x * 0.38268343236508984f - a[3][1].y * -0.9238795325112867f, a[3][1].x * -0.9238795325112867f + a[3][1].y * 0.38268343236508984f);
  a[3][2] = mk2(a[3][2].x * -0.7071067811865475f - a[3][2].y * -0.7071067811865476f, a[3][2].x * -0.7071067811865476f + a[3][2].y * -0.7071067811865475f);
  a[3][3] = mk2(a[3][3].x * -0.9238795325112868f - a[3][3].y * 0.38268343236508967f, a[3][3].x * 0.38268343236508967f + a[3][3].y * -0.9238795325112868f);
  { const f32x2 s0 = a[0][0] + a[2][0], s1 = a[0][0] - a[2][0], s2 = a[1][0] + a[3][0], t3 = a[1][0] - a[3][0]; const f32x2 s3 = mk2(t3.y, -t3.x);
    x[0] = s0 + s2; x[4] = s1 + s3; x[8] = s0 - s2; x[12] = s1 - s3; }
  { const f32x2 s0 = a[0][1] + a[2][1], s1 = a[0][1] - a[2][1], s2 = a[1][1] + a[3][1], t3 = a[1][1] - a[3][1]; const f32x2 s3 = mk2(t3.y, -t3.x);
    x[1] = s0 + s2; x[5] = s1 + s3; x[9] = s0 - s2; x[13] = s1 - s3; }
  { const f32x2 s0 = a[0][2] + a[2][2], s1 = a[0][2] - a[2][2], s2 = a[1][2] + a[3][2], t3 = a[1][2] - a[3][2]; const f32x2 s3 = mk2(t3.y, -t3.x);
    x[2] = s0 + s2; x[6] = s1 + s3; x[10] = s0 - s2; x[14] = s1 - s3; }
  { const f32x2 s0 = a[0][3] + a[2][3], s1 = a[0][3] - a[2][3], s2 = a[1][3] + a[3][3], t3 = a[1][3] - a[3][3]; const f32x2 s3 = mk2(t3.y, -t3.x);
    x[3] = s0 + s2; x[7] = s1 + s3; x[11] = s0 - s2; x[15] = s1 - s3; }
}
constexpr int FFT_PAD_ELEMS = FFTN + FFTN / 16;
__device__ __forceinline__ int pidx(int i) { return i + (i >> 4); }
__device__ __forceinline__ f32x2 cmul(f32x2 a, f32x2 b) { return mk2(a.x * b.x - a.y * b.y, a.x * b.y + a.y * b.x); }
template <bool HALF_IN, int P>
__device__ __forceinline__ void fft_pass16(LAS f32x2* data, const f32x2* tw, f32x2 (&v)[32], int tid) {
    constexpr int sh = 4 * P, Ns = 1 << sh, pst = Ns + (Ns >> 4);
    { const LAS f32x2* rd = data + pidx(tid);
#pragma unroll
      for (int i = 0; i < 2; ++i)
#pragma unroll
          for (int r = 0; r < 16; ++r) { if (HALF_IN && P == 0 && r >= 8) v[16 * i + r] = mk2(0.f, 0.f); else v[16 * i + r] = rd[544 * i + 1088 * r]; } }
    LDS_BARRIER();
#pragma unroll
    for (int i = 0; i < 2; ++i) { const int j = tid + 512 * i, k = j & (Ns - 1);
        f32x2 (&x)[16] = *(f32x2 (*)[16])&v[16 * i];
        if (P > 0) {
            const f32x2 w1 = tw[k * (1024 >> sh)];
            const f32x2 w2 = cmul(w1, w1), w4 = cmul(w2, w2), w8 = cmul(w4, w4);
            x[1] = cmul(x[1], w1); x[2] = cmul(x[2], w2); x[4] = cmul(x[4], w4); x[8] = cmul(x[8], w8);
            { const f32x2 w3 = cmul(w2, w1); x[3] = cmul(x[3], w3); x[6] = cmul(x[6], cmul(w3, w3)); x[11] = cmul(x[11], cmul(w8, w3));
              const f32x2 w7 = cmul(w4, w3); x[7] = cmul(x[7], w7); x[14] = cmul(x[14], cmul(w7, w7)); x[15] = cmul(x[15], cmul(w8, w7)); x[12] = cmul(x[12], cmul(w8, w4)); }
            { const f32x2 w5 = cmul(w4, w1); x[5] = cmul(x[5], w5); x[10] = cmul(x[10], cmul(w5, w5)); x[13] = cmul(x[13], cmul(w8, w5)); x[9] = cmul(x[9], cmul(w8, w1)); }
        }
        dft16(x);
        LAS f32x2* wr = data + pidx(((j >> sh) << (sh + 4)) + k);
#pragma unroll
        for (int r = 0; r < 16; ++r) wr[r * pst] = x[r];
        __builtin_amdgcn_sched_barrier(0); }
    LDS_BARRIER();
}
template <bool HALF_IN>
__device__ __forceinline__ void fft16k(LAS f32x2* data, const f32x2* tw, f32x2 (&v)[32], int tid) {
    fft_pass16<HALF_IN, 0>(data, tw, v, tid); fft_pass16<HALF_IN, 1>(data, tw, v, tid); fft_pass16<HALF_IN, 2>(data, tw, v, tid);
    { const LAS f32x2* rd = data + pidx(tid);
#pragma unroll
      for (int i = 0; i < 8; ++i)
#pragma unroll
          for (int r = 0; r < 4; ++r) v[4 * i + r] = rd[544 * i + 4352 * r]; }
    LDS_BARRIER();
#pragma unroll
    for (int i = 0; i < 8; ++i) { const int j = tid + 512 * i;
        const f32x2 w1 = tw[j], w2 = cmul(w1, w1), w3 = cmul(w2, w1);
        const f32x2 x0 = v[4 * i], x1 = cmul(v[4 * i + 1], w1), x2 = cmul(v[4 * i + 2], w2), x3 = cmul(v[4 * i + 3], w3);
        const f32x2 a = x0 + x2, bq = x0 - x2, c = x1 + x3, d0 = x1 - x3; const f32x2 d = mk2(d0.y, -d0.x);
        v[4 * i] = a + c; v[4 * i + 1] = bq + d; v[4 * i + 2] = a - c; v[4 * i + 3] = bq - d; }
}
__device__ __forceinline__ void phase_hy_fft(Frame& F, int e) {
    LAS f32x2* data = (LAS f32x2*)F.lds; LAS float* red = (LAS float*)(F.lds + FFT_PAD_ELEMS * 8);
    const float* KERN = (const float*)(F.ws + WS_KERN); bf16_t* UT = (bf16_t*)(F.ws + WS_UT); const f32x2* tw = (const f32x2*)(F.ws + WS_TW);
    const bf16_t* PHT = (const bf16_t*)(F.ws + WS_PHY); const float* hcw = inp(I_HCW) + (size_t)e * 3 * HYW; const float* hcb = inp(I_HCB) + (size_t)e * HYW;
    const int tid = F.tid & 511, lane = F.lane, wave = F.wave; const unsigned utid = (unsigned)tid;
    const int pt = pidx(tid), pt8 = 8 * tid + (tid >> 1);
    for (int ch = F.bid; ch < DM; ch += F.G) {
        float asum = 0.f;
        for (int i = 0; i < 32; ++i) { const float val = (KERN + (size_t)ch * FFTN + 512 * i)[utid]; data[pt + 544 * i] = mk2(val, 0.f); asum += fabsf(val); }
        asum = wave_sum(asum);
        if (lane == 0) red[wave] = asum;
        LDS_BARRIER();
        float tot = 0.f;
#pragma unroll
        for (int w = 0; w < 8; ++w) tot += red[w];
        const float kscale = 1.0f / (tot * (float)FFTN), skip = inp(I_HSKIP)[e * DM + ch] * (1.0f / (float)FFTN);
        f32x2 v[32];
        f32x2* ks = (f32x2*)(F.ws + WS_KS) + (size_t)F.bid * FFTN;
        fft16k<false>(data, tw, v, tid);
#pragma unroll
        for (int q = 0; q < 32; ++q) (ks + q * 512)[utid] = mk2(v[q].x * kscale + skip, v[q].y * kscale);
        LDS_BARRIER();
        for (int pi = 0; pi < 3; ++pi) {
            const int b0 = 2 * pi, b1 = 2 * pi + 1;
            bf16_t* u0 = UT + ((size_t)(b0 * DM + ch)) * SEQ; bf16_t* u1 = UT + ((size_t)((b1 < NSEQ ? b1 : b0) * DM + ch)) * SEQ;
            {
              const float a0 = hcw[2048 + ch], a1 = hcw[HYW + 2048 + ch], a2 = hcw[2 * HYW + 2048 + ch], ab = hcb[2048 + ch];
              const float c0 = hcw[4096 + ch], c1 = hcw[HYW + 4096 + ch], c2 = hcw[2 * HYW + 4096 + ch], cbv = hcb[4096 + ch];
              const bf16_t* r1 = PHT + (size_t)(2048 + ch) * T; const bf16_t* rv = PHT + (size_t)(4096 + ch) * T;
#pragma unroll
              for (int i = 0; i < 2; ++i) { const unsigned t8 = (utid + 512u * i) * 8u; float pr[2][8];
#pragma unroll
                  for (int q = 0; q < 2; ++q) { const int bq = q ? b1 : b0;
                      if (bq < NSEQ) { const bf16_t* p1 = r1 + (size_t)bq * SEQ + t8; const bf16_t* pv = rv + (size_t)bq * SEQ + t8; float x[10], w[10];
                          unpack8(*(const u32x4*)p1, *(float (*)[8])&x[1]); unpack8(*(const u32x4*)pv, *(float (*)[8])&w[1]);
                          x[0] = t8 > 0u ? bf2f(p1[-1]) : 0.f; x[9] = t8 + 8u < (unsigned)SEQ ? bf2f(p1[8]) : 0.f;
                          w[0] = t8 > 0u ? bf2f(pv[-1]) : 0.f; w[9] = t8 + 8u < (unsigned)SEQ ? bf2f(pv[8]) : 0.f;
#pragma unroll
                          for (int j = 0; j < 8; ++j) pr[q][j] = (ab + a0 * x[j] + a1 * x[j + 1] + a2 * x[j + 2]) * (cbv + c0 * w[j] + c1 * w[j + 1] + c2 * w[j + 2]); }
                      else {
#pragma unroll
                          for (int j = 0; j < 8; ++j) pr[q][j] = 0.f; } }
#pragma unroll
                  for (int j = 0; j < 8; ++j) data[pt8 + 4352 * i + j] = mk2(pr[0][j], pr[1][j]); } }
            LDS_BARRIER();
            fft16k<true>(data, tw, v, tid);
            LDS_BARRIER();
#pragma unroll
            for (int i = 0; i < 8; ++i)
#pragma unroll
                for (int r = 0; r < 4; ++r) { const f32x2 a = v[4 * i + r], k = (ks + (4 * i + r) * 512)[utid];
                    data[pt + 544 * i + 4352 * r] = mk2(a.x * k.x - a.y * k.y, -(a.x * k.y + a.y * k.x)); }
            LDS_BARRIER();
            fft16k<false>(data, tw, v, tid);
#pragma unroll
            for (int i = 0; i < 8; ++i)
#pragma unroll
                for (int r = 0; r < 2; ++r) { (u0 + 512 * i + 4096 * r)[utid] = f2bf(v[4 * i + r].x); if (b1 < NSEQ) (u1 + 512 * i + 4096 * r)[utid] = f2bf(-v[4 * i + r].y); }
            LDS_BARRIER();
        }
    }
}
constexpr int SPL = 32;
#ifndef EVEN_ON
#define EVEN_ON 1
#endif
#ifndef ODD_ON
#define ODD_ON 1
#endif
#ifndef STEPMASK
#define STEPMASK 0xffffffffu
#endif
#define RUN(k) ((ONLY >= 0) ? ((k) == ONLY) : ((((STEPMASK >> (k)) & 1u) != 0u) && (layer * SPL + (k)) >= args.s_lo && (layer * SPL + (k)) < args.s_hi))
#define PH() do { int t_ = threadIdx.x; asm volatile("" : "+v"(t_)); F.tid = t_; F.lane = t_ & 63; F.wave = __builtin_amdgcn_readfirstlane(t_ >> 6); } while (0)
#ifndef MK_DUP
#define MK_DUP 0u
#endif
#define REP(k) for (int rep_ = 0; rep_ < (((MK_DUP >> (k)) & 1u) ? 2 : 1); ++rep_)
#define SEAM() do { if (ONLY < 0) xcd_barrier(bar); } while (0)
template <int ONLY, int PAR, int LAYER> __device__ __forceinline__ void layer_body(const Args& args, Frame& F, const XcdBarrier& bar) {
    unsigned char* ws = args.ws;
    bf16_t* H = F.h;
    const int layer = (LAYER >= 0) ? LAYER : args.l_lo;
    {
        const int e = layer >> 1;
        if (RUN(0)) { PH(); REP(0) phase_prep(F, layer); SEAM(); }
        if (!(layer & 1) && EVEN_ON && PAR != 1) {
            bf16_t* PR = (bf16_t*)(ws + WS_PROJ);
            if (RUN(1)) { PH();
                { pg8::Gemm g{H, (const bf16_t*)(ws + W_IN), DM, DM, DM, T / 256, PW / 256, 1, 1, 0, 0, 0, 0}; pg8::Order S; S.init(g, F.G, F.bid);
                  pg8::EpiBf16 E{PR, PW, 1, 0, 0, 1.0f}; pg8::gemm_phase(F.lds, g, S, E); }
                { pg8::Gemm g{H, (const bf16_t*)(ws + W_DT), DM, DM, DM, T / 256, 1, 1, 1, 0, 0, 0, 0}; pg8::Order S; S.init(g, F.G, F.bid);
                  pg8::EpiDt E{(float*)(ws + WS_DT), inp(I_DTB) + e * 64}; pg8::gemm_phase(F.lds, g, S, E); }
                { pg8::Gemm g{(const bf16_t*)(ws + WS_MEMN), (const bf16_t*)(ws + W_K), DM, DM, DM, MROWS / 256, DM / 256, 1, 1, 0, 0, 0, 0}; pg8::Order S; S.init(g, F.G, (F.bid + F.G - 160) % F.G);
                  pg8::EpiBf16 E{(bf16_t*)(ws + WS_MK), DM, 1, 0, 0, 1.0f}; pg8::gemm_phase(F.lds, g, S, E); }
                { pg8::Gemm g{(const bf16_t*)(ws + WS_MEMN), (const bf16_t*)(ws + W_V), DM, DM, DM, MROWS / 256, DM / 256, 1, 1, 0, 0, 0, 0}; pg8::Order S; S.init(g, F.G, (F.bid + F.G - 200) % F.G);
                  pg8::EpiBf16 E{(bf16_t*)(ws + WS_MV), DM, 1, 0, 0, 1.0f}; pg8::gemm_phase(F.lds, g, S, E); }
                SEAM();
            }
            if (RUN(2)) { PH(); REP(2) phase_ssd_conv(F, e); phase_qk_rope(F, e); SEAM(); }
            if (RUN(3)) { PH(); REP(3) phase_ssd_states(F, e); SEAM(); }
            if (RUN(4)) { PH(); phase_ssd_scan(F); SEAM(); }
            if (RUN(5)) { PH(); REP(5) phase_ssd_out(F, e); SEAM(); }
            if (RUN(6)) { PH(); phase_attention(F); SEAM(); }
            if (RUN(7)) { PH(); phase_ssd_gate_norm(F, e); SEAM(); }
            if (RUN(8)) { PH();
                pg8::Gemm g{PR, (const bf16_t*)(ws + W_OUT), PW, 4096, 4096, T / 256, DM / 256, 1, 1, 0, 0, 0, 0}; pg8::Order S; S.init(g, F.G, F.bid);
                pg8::EpiResAddPS E{F.x16, DM, (float*)(ws + WS_PS)}; pg8::gemm_phase(F.lds, g, S, E);
                { pg8::Gemm g{(const bf16_t*)(ws + WS_MK), (const bf16_t*)(ws + W_Q), DM, DM, XAD, 1, DM / 256, NSEQ * XAH, XAH, (long)NMEM * DM, XAD, 0, XAD}; pg8::Order S; S.init(g, F.G, F.bid);
                  pg8::EpiBf16G E{(bf16_t*)(ws + WS_WQK), DM, XAH, (long)XAH * NMEM * DM, (long)NMEM * DM, inp(I_NXA) + (size_t)layer * DM}; pg8::gemm_phase(F.lds, g, S, E); }
                SEAM();
            }
        } else if ((layer & 1) && ODD_ON && PAR != 0) {
            if (RUN(1)) { PH();
                { pg8::Gemm g{(const bf16_t*)(ws + HW_IN), H, DM, DM, DM, HYW / 256, T / 256, 1, 1, 0, 0, 0, 0}; pg8::Order S; S.init(g, F.G, F.bid);
                  pg8::EpiBf16 E{(bf16_t*)(ws + WS_PHY), T, 1, 0, 0, 1.0f}; pg8::gemm_phase(F.lds, g, S, E); }
                { pg8::Gemm g{(const bf16_t*)(ws + WS_MEMN), (const bf16_t*)(ws + W_K), DM, DM, DM, MROWS / 256, DM / 256, 1, 1, 0, 0, 0, 0}; pg8::Order S; S.init(g, F.G, F.bid);
                  pg8::EpiBf16 E{(bf16_t*)(ws + WS_MK), DM, 1, 0, 0, 1.0f}; pg8::gemm_phase(F.lds, g, S, E); }
                { pg8::Gemm g{(const bf16_t*)(ws + WS_MEMN), (const bf16_t*)(ws + W_V), DM, DM, DM, MROWS / 256, DM / 256, 1, 1, 0, 0, 0, 0}; pg8::Order S; S.init(g, F.G, (F.bid + F.G - 40) % F.G);
                  pg8::EpiBf16 E{(bf16_t*)(ws + WS_MV), DM, 1, 0, 0, 1.0f}; pg8::gemm_phase(F.lds, g, S, E); }
                REP(24) phase_hy_kern(F, e);
                SEAM();
            }
            if (RUN(3)) { PH(); phase_hy_fft(F, e); SEAM(); }
            if (RUN(4)) { PH(); REP(26) phase_hy_tout(F, e); SEAM(); }
            if (RUN(5)) { PH();
                pg8::Gemm g{H, (const bf16_t*)(ws + HW_OUT), DM, DM, DM, T / 256, DM / 256, 1, 1, 0, 0, 0, 0}; pg8::Order S; S.init(g, F.G, F.bid);
                pg8::EpiResAddPS E{F.x16, DM, (float*)(ws + WS_PS)}; pg8::gemm_phase(F.lds, g, S, E);
                { pg8::Gemm g{(const bf16_t*)(ws + WS_MK), (const bf16_t*)(ws + W_Q), DM, DM, XAD, 1, DM / 256, NSEQ * XAH, XAH, (long)NMEM * DM, XAD, 0, XAD}; pg8::Order S; S.init(g, F.G, F.bid);
                  pg8::EpiBf16G E{(bf16_t*)(ws + WS_WQK), DM, XAH, (long)XAH * NMEM * DM, (long)NMEM * DM, inp(I_NXA) + (size_t)layer * DM}; pg8::gemm_phase(F.lds, g, S, E); }
                SEAM();
            }
        }
        if (RUN(10)) { PH();
            pg8::Gemm g{F.x16, (const bf16_t*)(ws + WS_WQK), DM, DM, DM, SEQ / 256, (XAH * NMEM) / 256, NSEQ, 1, (long)SEQ * DM, 0, (long)XAH * NMEM * DM, 0}; pg8::Order S; S.init(g, F.G, F.bid);
            pg8::EpiSoftmax E{(bf16_t*)(ws + WS_P), XAH * NMEM, (long)SEQ * XAH * NMEM, 0.044194173824159216f * 1.4426950408889634f, (LAS float*)(F.lds + pg8::STAGE_BYTES), (const float*)(ws + WS_PS)}; pg8::gemm_phase(F.lds, g, S, E);
            if (2 * F.bid >= F.G) { pg8::Gemm g2{(const bf16_t*)(ws + W_O), (const bf16_t*)(ws + WS_MV), DM, DM, XAD, DM / 256, 1, NSEQ * XAH, XAH, 0, XAD, (long)NMEM * DM, XAD}; pg8::Order S2; S2.init(g2, F.G - F.G / 2, F.bid - F.G / 2);
                  pg8::EpiBf16 E2{(bf16_t*)(ws + WS_VWOT), XAH * NMEM, XAH, (long)DM * XAH * NMEM, NMEM, 1.0f}; pg8::gemm_phase(F.lds, g2, S2, E2); }
            SEAM();
        }
        if (RUN(14)) { PH();
            pg8::Gemm g{(const bf16_t*)(ws + WS_P), (const bf16_t*)(ws + WS_VWOT), XAH * NMEM, XAH * NMEM, XAH * NMEM, SEQ / 256, DM / 256, NSEQ, 1, (long)SEQ * XAH * NMEM, 0, (long)DM * XAH * NMEM, 0}; pg8::Order S; S.init(g, F.G, F.bid);
            pg8::EpiResAdd E{F.x16, DM, (long)SEQ * DM}; pg8::gemm_phase(F.lds, g, S, E);
            SEAM();
        }
        if (RUN(15)) { PH(); REP(15) phase_rms_x(F, inp(I_NFFN) + (size_t)layer * DM, false); SEAM(); }
        if (RUN(16)) { PH();
            pg8::Gemm g{H, (const bf16_t*)(ws + W_FIN), DM, DM, DM, T / 256, F2 / 256, 1, 1, 0, 0, 0, 0}; pg8::Order S; S.init(g, F.G, F.bid);
            pg8::EpiFfnGate E{(bf16_t*)(ws + WS_ACT), (bf16_t*)(ws + WS_SB), inp(I_FCW) + (size_t)layer * 3 * F2, inp(I_FCB) + (size_t)layer * F2}; pg8::gemm_phase(F.lds, g, S, E);
            SEAM();
        }
        if (RUN(17)) { PH(); phase_ffn_fix(F, layer); SEAM(); }
        if (RUN(21)) { PH();
            pg8::Gemm g{(const bf16_t*)(ws + WS_ACT), (const bf16_t*)(ws + W_FOUT), DFF, DFF, DFF, T / 256, DM / 256, 1, 1, 0, 0, 0, 0}; pg8::Order S; S.init(g, F.G, F.bid);
            pg8::EpiResAdd E{F.x16, DM, 0}; pg8::gemm_phase(F.lds, g, S, E);
            SEAM();
        }
        if (layer == 3 && RUN(22)) { PH(); phase_final_norm(F); }
    }
}
#undef RUN
#undef SEAM
#undef PH
#undef REP
template <int ONLY, int PAR> __device__ __forceinline__ void program(const Args& args) {
    extern __shared__ __attribute__((aligned(16))) unsigned char lds_raw[];
    Frame F;
    F.lds = (LAS unsigned char*)lds_raw;
    F.tid = threadIdx.x; F.lane = F.tid & 63; F.wave = __builtin_amdgcn_readfirstlane(F.tid >> 6);
    F.G = gridDim.x; F.bid = blockIdx.x;
    F.out = args.out; F.ws = args.ws; F.h = (bf16_t*)args.out; F.x16 = (bf16_t*)(args.ws + WS_H);
    unsigned char* ws = args.ws;
    volatile LAS unsigned* MISC = (volatile LAS unsigned*)(F.lds + LDS_CTL);
    if (F.tid < 64) MISC[F.tid] = 0u;
    __syncthreads();
    XcdBarrier bar; bar.bar = (unsigned*)(ws + WS_CTL) + 4096; bar.x = 0; bar.st = nullptr;
    if (ONLY < 0) bar = xcd_barrier_post((unsigned*)(ws + WS_CTL) + 4096, MISC + 8);
    if (ONLY >= 0) layer_body<ONLY, PAR, -1>(args, F, bar);
    else { layer_body<-1, 0, 0>(args, F, bar); layer_body<-1, 1, 1>(args, F, bar); layer_body<-1, 0, 2>(args, F, bar); layer_body<-1, 1, 3>(args, F, bar); }
}
template <int ONLY, int PAR> __global__ void __launch_bounds__(512, 2) trunk_step(Args args) { program<ONLY, PAR>(args); }
__global__ void __launch_bounds__(512, 2) trunk_fwd(Args args) { program<-1, -1>(args); }
typedef void (*StepFn)(Args);
template <int K> struct StepTab { static void fill(StepFn (*t)[2]) { t[K][0] = trunk_step<K, 0>; t[K][1] = trunk_step<K, (K <= 5) ? 1 : 0>; StepTab<K - 1>::fill(t); } };
template <> struct StepTab<-1> { static void fill(StepFn (*)[2]) {} };

static const int kSteps[2][23] = {
    {0, 1, 2, 3, 4, 5, 6, 7, 8, 9, 10, 12, 14, 15, 16, 17, 21, 22, -1, -1, -1, -1, -1},
    {0, 1, 3, 4, 5, 9, 10, 12, 14, 15, 16, 17, 21, 22, -1, -1, -1, -1, -1, -1, -1, -1, -1}};
static StepFn g_steps[23][2];
extern "C" void kernel_launch(void* const* d_in, const int* in_sizes, int n_in, void* d_out, int out_size, void* d_ws, size_t ws_size, hipStream_t stream) {
    static int grid = 0;
    if (grid == 0) {
        if (n_in != 40 || out_size != T * DM || ws_size < WS_END) { fprintf(stderr, "kernel_launch: unexpected shapes: n_in %d out %d ws %zu (need %zu)\n", n_in, out_size, ws_size, (size_t)WS_END); grid = -1; return; }
        int dev = 0, cus = 0;
        if (hipGetDevice(&dev) != hipSuccess || hipDeviceGetAttribute(&cus, hipDeviceAttributeMultiprocessorCount, dev) != hipSuccess) { grid = -1; return; }
        if (hipFuncSetAttribute((const void*)trunk_fwd, hipFuncAttributeMaxDynamicSharedMemorySize, LDS_BYTES) != hipSuccess) { fprintf(stderr, "kernel_launch: hipFuncSetAttribute failed\n"); grid = -1; return; }
#if MK_FUSED != 1
        StepTab<22>::fill(g_steps);
        for (int k = 0; k < 23; ++k) for (int p = 0; p < 2; ++p)
            if (hipFuncSetAttribute((const void*)g_steps[k][p], hipFuncAttributeMaxDynamicSharedMemorySize, LDS_BYTES) != hipSuccess) { fprintf(stderr, "kernel_launch: hipFuncSetAttribute failed (step %d)\n", k); grid = -1; return; }
#endif
        (void)hipGetLastError();
        grid = cus;
    }
    if (grid < 0) return;
    (void)hipMemsetAsync((char*)d_ws + WS_CTL, 0, CTL_BYTES, stream);
    Args a{};
    for (int i = 0; i < 40; ++i) a.in[i] = (const float*)d_in[i];
    a.out = (float*)d_out; a.ws = (unsigned char*)d_ws;
#if MK_FUSED == 1
    { static const int cuts[] = { MK_CUTS };
      const int ncut = (int)(sizeof(cuts) / sizeof(cuts[0]));
      for (int ci = 0; ci + 1 < ncut; ++ci) {
          if (ci > 0) (void)hipMemsetAsync((char*)d_ws + WS_CTL, 0, CTL_BYTES, stream);
          a.l_lo = 0; a.l_hi = 4; a.s_lo = cuts[ci]; a.s_hi = cuts[ci + 1]; a.fused = 1; a.pad = 0;
          hipLaunchKernelGGL(trunk_fwd, dim3(grid), dim3(512), LDS_BYTES, stream, a); } }
#else
    for (int layer = 0; layer < 4; ++layer)
        for (int si = 0; si < 23; ++si) {
            const int k = kSteps[layer & 1][si]; if (k < 0) continue; if (k == 22 && layer != 3) continue;
            a.l_lo = layer; a.l_hi = layer + 1; a.s_lo = layer * SPL + k; a.s_hi = a.s_lo + 1; a.fused = 0; a.pad = 0;
#if MK_FUSED == 2
            if (((MK_FSET >> k) & 1u) && (layer & 1) == MK_FPAR) { (void)hipMemsetAsync((char*)d_ws + WS_CTL, 0, CTL_BYTES, stream); a.l_lo = 0; a.l_hi = 4; hipLaunchKernelGGL(trunk_fwd, dim3(grid), dim3(512), LDS_BYTES, stream, a); continue; }
#endif
            hipLaunchKernelGGL(g_steps[k][layer & 1], dim3(grid), dim3(512), LDS_BYTES, stream, a);
        }
#endif
    const hipError_t le = hipPeekAtLastError();
    if (le != hipSuccess) fprintf(stderr, "kernel_launch: launch failed: %s\n", hipGetErrorName(le));
}
```

```cpp
#include <hip/hip_runtime.h>
#include <cstdio>
#include <cstdint>
#ifndef MK_FUSED
#define MK_FUSED 1
#endif
#ifndef MK_FPAR
#define MK_FPAR 0
#endif
#ifndef MK_FSET
#define MK_FSET 0x8u
#endif
#ifndef MK_CUTS
#define MK_CUTS 0, 128
#endif

#define GAS __attribute__((address_space(1)))
#define LAS __attribute__((address_space(3)))
typedef unsigned short bf16_t;
typedef short bf16x8 __attribute__((ext_vector_type(8)));
typedef short s16x4 __attribute__((ext_vector_type(4)));
typedef float f32x4 __attribute__((ext_vector_type(4)));
typedef float f32x2 __attribute__((ext_vector_type(2)));
typedef float f32x16 __attribute__((ext_vector_type(16)));
typedef unsigned u32x4 __attribute__((ext_vector_type(4)));
typedef unsigned u32x2 __attribute__((ext_vector_type(2)));

constexpr int DM = 2048, SEQ = 8192, NSEQ = 5, T = NSEQ * SEQ, NMEM = 256, MROWS = NSEQ * NMEM;
constexpr int XAH = 4, XAD = 512;
constexpr int SSH = 32, SSP = 64, SSG = 4, SSN = 128, SSQ = 128, NCH = SEQ / SSQ;
constexpr int AH = 16, AKV = 4, AD = 128;
constexpr int PW = 8192, PC_Z = 0, PC_Q = 2048, PC_X = 4096, PC_K = 7168, PC_V = 7680;
constexpr int DFF = 5632, F2 = 11264, HYW = 6144;
constexpr int FCH = 20480, FCHP = 81;
constexpr float EPS = 1e-6f;
constexpr int FFTN = 16384;

constexpr size_t MiB = 1u << 20;
constexpr size_t WS_CTL = 0, CTL_BYTES = 1 * MiB;
constexpr size_t WS_TW = 1 * MiB;
constexpr size_t WS_H3 = 2 * MiB;
constexpr size_t WS_MEMN = 4 * MiB, WS_MK = 9 * MiB, WS_MV = 14 * MiB;
constexpr size_t WS_DT = 19 * MiB;
constexpr size_t WS_TOT = 29 * MiB;
constexpr size_t WS_W = 32 * MiB;
constexpr size_t W_IN = WS_W, W_DT = WS_W + 32 * MiB, W_OUT = WS_W + 33 * MiB;
constexpr size_t HW_IN = WS_W, HW_OUT = WS_W + 24 * MiB;
constexpr size_t W_Q = WS_W + 49 * MiB, W_K = WS_W + 57 * MiB, W_V = WS_W + 65 * MiB, W_O = WS_W + 73 * MiB, W_FIN = WS_W + 81 * MiB, W_FOUT = WS_W + 125 * MiB;
constexpr size_t WS_H = 184 * MiB;
constexpr size_t WS_BIG = 344 * MiB;
constexpr size_t WS_PROJ = WS_BIG, WS_BC = WS_BIG + 640 * MiB, WS_STF = WS_BIG + 720 * MiB, WS_STB = WS_BIG + 880 * MiB;
constexpr size_t WS_SC = WS_BIG + 160 * MiB, WS_P = WS_BIG + 320 * MiB;
constexpr size_t WS_PS = WS_BIG + 700 * MiB;
constexpr size_t WS_WQK = WS_BIG + 640 * MiB, WS_VWOT = WS_BIG + 660 * MiB;
constexpr size_t WS_ACT = WS_BIG, WS_SB = WS_BIG + 440 * MiB;
constexpr size_t WS_PHY = WS_BIG, WS_UT = WS_BIG + 480 * MiB, WS_KERN = WS_BIG + 640 * MiB, WS_KS = WS_BIG + 768 * MiB;
constexpr size_t WS_END = WS_BIG + 1040 * MiB;
static_assert(W_FOUT + (size_t)DM * DFF * 2 <= WS_H, "weights region");
static_assert(WS_ACT + (size_t)T * DFF * 2 <= WS_SB && WS_SB + (size_t)(T / 64) * 4 * F2 * 2 <= WS_END && WS_KERN + (size_t)DM * FFTN * 4 <= WS_END, "big region");

constexpr int LDS_BYTES = 163840, LDS_CTL = 161792;

__device__ __forceinline__ float bf2f(unsigned b) { return __uint_as_float(b << 16); }
__device__ __forceinline__ float bflo(unsigned w) { return __uint_as_float(w << 16); }
__device__ __forceinline__ float bfhi(unsigned w) { return __uint_as_float(w & 0xffff0000u); }
__device__ __forceinline__ unsigned cvt_pk_bf16(float lo, float hi) { unsigned r; asm volatile("v_cvt_pk_bf16_f32 %0, %1, %2" : "=v"(r) : "v"(lo), "v"(hi)); return r; }
typedef __bf16 bf16x2_t __attribute__((ext_vector_type(2)));
__device__ __forceinline__ unsigned cvt_pk_c(float lo, float hi) { f32x2 v; v.x = lo; v.y = hi; bf16x2_t r = __builtin_convertvector(v, bf16x2_t); return __builtin_bit_cast(unsigned, r); }
__device__ __forceinline__ unsigned short f2bf(float f) { return (unsigned short)(cvt_pk_bf16(f, 0.f) & 0xffffu); }
__device__ __forceinline__ float wave_sum(float v) {
#pragma unroll
    for (int o = 1; o < 64; o <<= 1) v += __shfl_xor(v, o);
    return v;
}
__device__ __forceinline__ float wave_max(float v) {
#pragma unroll
    for (int o = 1; o < 64; o <<= 1) v = fmaxf(v, __shfl_xor(v, o));
    return v;
}
__device__ __forceinline__ float silu_f(float x) { return x * __builtin_amdgcn_rcpf(1.f + __builtin_amdgcn_exp2f(x * -1.4426950408889634f)); }
__device__ __forceinline__ void unpack8(const u32x4 w, float (&f)[8]) {
    f[0] = bflo(w.x); f[1] = bfhi(w.x); f[2] = bflo(w.y); f[3] = bfhi(w.y); f[4] = bflo(w.z); f[5] = bfhi(w.z); f[6] = bflo(w.w); f[7] = bfhi(w.w);
}
__device__ __forceinline__ u32x4 pack8(const float (&f)[8]) {
    u32x4 w; w.x = cvt_pk_bf16(f[0], f[1]); w.y = cvt_pk_bf16(f[2], f[3]); w.z = cvt_pk_bf16(f[4], f[5]); w.w = cvt_pk_bf16(f[6], f[7]); return w;
}
#define LDS_WAIT() asm volatile("s_waitcnt lgkmcnt(0)" ::: "memory")
#define LDS_BARRIER() do { asm volatile("s_waitcnt lgkmcnt(0)" ::: "memory"); __builtin_amdgcn_s_barrier(); asm volatile("" ::: "memory"); } while (0)
#define VM_WAIT() asm volatile("s_waitcnt vmcnt(0)" ::: "memory")
namespace pg8 {
constexpr int BM = 256, BK = 64, HALF = 128, HTB = HALF * BK * 2, STAGE_BYTES = 8 * HTB, NXCD = 8, WGM = 8;
__host__ __device__ __forceinline__ int lds_byte(int r, int c) { const int st = (r >> 4) * 2 + (c >> 5), rr = r & 15, cc = c & 31, ob = rr * 64 + cc * 2; return st * 1024 + (ob ^ (((ob >> 9) & 1) << 5)); }
__host__ __device__ __forceinline__ void stage_rc(int b, int& R, int& C) { const int st = b / 1024, sb = b % 1024, swz = sb ^ (((sb >> 9) & 1) << 5); R = (st >> 1) * 16 + swz / 64; C = (st & 1) * 32 + (swz % 64) / 2; }
__host__ __device__ __forceinline__ int perm32(int rho) { const int n = rho >> 4, i = rho & 15; return 8 * (i >> 2) + 4 * n + (i & 3); }

struct Unit { int pm, pn, z; };
struct Gemm { const bf16_t* A; const bf16_t* Bt; int lda, ldb, K, nM, nN, nZ, zdiv; long aZhi, aZlo, bZhi, bZlo; };
__device__ __forceinline__ const char* a_ptr(const Gemm& g, const Unit& u) { return (const char*)g.A + ((size_t)(u.z / g.zdiv) * g.aZhi + (size_t)(u.z % g.zdiv) * g.aZlo + (size_t)u.pm * BM * g.lda) * 2; }
__device__ __forceinline__ const char* b_ptr(const Gemm& g, const Unit& u) { return (const char*)g.Bt + ((size_t)(u.z / g.zdiv) * g.bZhi + (size_t)(u.z % g.zdiv) * g.bZlo + (size_t)u.pn * BM * g.ldb) * 2; }

struct Order {
    int nM, nN, per, nwg, G, c;
    __device__ __forceinline__ void init(const Gemm& g, int G_, int c_) { nM = g.nM; nN = g.nN; per = nM * nN; nwg = per * g.nZ; G = G_; c = c_; }
    __device__ __forceinline__ bool next(int i, Unit& u) const {
        const long Lid = (long)i * G + c; if (Lid >= nwg) return false;
        u.z = (int)(Lid / per); int wgid = (int)(Lid % per);
        { const int q = per / NXCD, r = per % NXCD, xcd = wgid % NXCD, off = wgid / NXCD; wgid = (xcd < r ? xcd * (q + 1) : r * (q + 1) + (xcd - r) * q) + off; }
        const int nig = WGM * nN, gid = wgid / nig, fm = gid * WGM, gsz = (nM - fm) < WGM ? (nM - fm) : WGM;
        u.pm = fm + ((wgid % nig) % gsz); u.pn = (wgid % nig) / gsz; return true;
    }
};

struct EpiBf16 {
    static constexpr bool PERM = true; static constexpr bool PERMA = false;
    bf16_t* O; int ldc, zdiv; long cZhi, cZlo; float scale;
    __device__ __forceinline__ void operator()(const f32x4 (&acc)[2][2][4][2], const Unit& u, int wr, int wc, int fr, int fq) const {
        bf16_t* base = O + (size_t)(u.z / zdiv) * cZhi + (size_t)(u.z % zdiv) * cZlo;
        const int row0 = u.pm * BM + wr * 64 + fr, col0 = u.pn * BM + wc * 32 + 8 * fq;
#pragma unroll
        for (int ai = 0; ai < 2; ++ai)
#pragma unroll
            for (int m = 0; m < 4; ++m) { bf16_t* rowp = base + (size_t)(row0 + ai * HALF + m * 16) * ldc + col0;
#pragma unroll
                for (int bj = 0; bj < 2; ++bj) { const f32x4 v0 = acc[ai][bj][m][0] * scale, v1 = acc[ai][bj][m][1] * scale;
                    u32x4 w; w.x = cvt_pk_bf16(v0[0], v0[1]); w.y = cvt_pk_bf16(v0[2], v0[3]); w.z = cvt_pk_bf16(v1[0], v1[1]); w.w = cvt_pk_bf16(v1[2], v1[3]);
                    *(u32x4*)(rowp + bj * HALF) = w; } }
    }
};
struct EpiF32 {
    static constexpr bool PERM = false; static constexpr bool PERMA = false;
    float* C; int ldc, zdiv; long cZhi, cZlo; float scale;
    __device__ __forceinline__ void operator()(const f32x4 (&acc)[2][2][4][2], const Unit& u, int wr, int wc, int fr, int fq) const {
        float* base = C + (size_t)(u.z / zdiv) * cZhi + (size_t)(u.z % zdiv) * cZlo;
        const int row0 = u.pm * BM + wr * 64 + fr, col0 = u.pn * BM + wc * 32 + 4 * fq;
#pragma unroll
        for (int ai = 0; ai < 2; ++ai)
#pragma unroll
            for (int m = 0; m < 4; ++m) { float* rowp = base + (size_t)(row0 + ai * HALF + m * 16) * ldc + col0;
#pragma unroll
                for (int bj = 0; bj < 2; ++bj)
#pragma unroll
                    for (int n = 0; n < 2; ++n) *(f32x4*)(rowp + bj * HALF + n * 16) = acc[ai][bj][m][n] * scale; }
    }
};
struct EpiResAdd {
    static constexpr bool PERM = true; static constexpr bool PERMA = false;
    bf16_t* X; int ldc; long cZ;
    __device__ __forceinline__ void operator()(const f32x4 (&acc)[2][2][4][2], const Unit& u, int wr, int wc, int fr, int fq) const {
        const int row0 = u.pm * BM + wr * 64 + fr, col0 = u.pn * BM + wc * 32 + 8 * fq;
#pragma unroll
        for (int ai = 0; ai < 2; ++ai) {
            u32x4 old[4][2];
#pragma unroll
            for (int m = 0; m < 4; ++m)
#pragma unroll
                for (int bj = 0; bj < 2; ++bj) old[m][bj] = *(const u32x4*)(X + (size_t)u.z * cZ + (size_t)(row0 + ai * HALF + m * 16) * ldc + col0 + bj * HALF);
#pragma unroll
            for (int m = 0; m < 4; ++m)
#pragma unroll
                for (int bj = 0; bj < 2; ++bj) { float v[8]; unpack8(old[m][bj], v);
                    const f32x4 a0 = acc[ai][bj][m][0], a1 = acc[ai][bj][m][1];
                    u32x4 w; w.x = cvt_pk_c(v[0] + a0[0], v[1] + a0[1]); w.y = cvt_pk_c(v[2] + a0[2], v[3] + a0[3]); w.z = cvt_pk_c(v[4] + a1[0], v[5] + a1[1]); w.w = cvt_pk_c(v[6] + a1[2], v[7] + a1[3]);
                    *(u32x4*)(X + (size_t)u.z * cZ + (size_t)(row0 + ai * HALF + m * 16) * ldc + col0 + bj * HALF) = w; }
            asm volatile("" ::: "memory"); }
    }
};
struct EpiResAddPS {
    static constexpr bool PERM = true; static constexpr bool PERMA = false;
    bf16_t* X; int ldc; float* PS;
    __device__ __forceinline__ void operator()(const f32x4 (&acc)[2][2][4][2], const Unit& u, int wr, int wc, int fr, int fq) const {
        const int row0 = u.pm * BM + wr * 64 + fr, col0 = u.pn * BM + wc * 32 + 8 * fq;
#pragma unroll
        for (int ai = 0; ai < 2; ++ai) {
            u32x4 old[4][2];
#pragma unroll
            for (int m = 0; m < 4; ++m)
#pragma unroll
                for (int bj = 0; bj < 2; ++bj) old[m][bj] = *(const u32x4*)(X + (size_t)(row0 + ai * HALF + m * 16) * ldc + col0 + bj * HALF);
#pragma unroll
            for (int m = 0; m < 4; ++m) { float ss = 0.f;
#pragma unroll
                for (int bj = 0; bj < 2; ++bj) { float v[8]; unpack8(old[m][bj], v);
                    const f32x4 a0 = acc[ai][bj][m][0], a1 = acc[ai][bj][m][1];
                    v[0] += a0[0]; v[1] += a0[1]; v[2] += a0[2]; v[3] += a0[3]; v[4] += a1[0]; v[5] += a1[1]; v[6] += a1[2]; v[7] += a1[3];
                    ss += ((v[0] * v[0] + v[1] * v[1]) + (v[2] * v[2] + v[3] * v[3])) + ((v[4] * v[4] + v[5] * v[5]) + (v[6] * v[6] + v[7] * v[7]));
                    u32x4 w; w.x = cvt_pk_c(v[0], v[1]); w.y = cvt_pk_c(v[2], v[3]); w.z = cvt_pk_c(v[4], v[5]); w.w = cvt_pk_c(v[6], v[7]);
                    *(u32x4*)(X + (size_t)(row0 + ai * HALF + m * 16) * ldc + col0 + bj * HALF) = w; }
                ss += __shfl_xor(ss, 16); ss += __shfl_xor(ss, 32);
                if (fq == 0) PS[(size_t)(row0 + ai * HALF + m * 16) * 32 + u.pn * 4 + wc] = ss; }
            asm volatile("" ::: "memory"); }
    }
};
struct EpiBf16G {
    static constexpr bool PERM = true; static constexpr bool PERMA = false;
    bf16_t* O; int ldc, zdiv; long cZhi, cZlo; const float* cg;
    __device__ __forceinline__ void operator()(const f32x4 (&acc)[2][2][4][2], const Unit& u, int wr, int wc, int fr, int fq) const {
        bf16_t* base = O + (size_t)(u.z / zdiv) * cZhi + (size_t)(u.z % zdiv) * cZlo;
        const int row0 = u.pm * BM + wr * 64 + fr, col0 = u.pn * BM + wc * 32 + 8 * fq;
        f32x4 gn[2][2];
#pragma unroll
        for (int bj = 0; bj < 2; ++bj) { gn[bj][0] = *(const f32x4*)(cg + col0 + bj * HALF); gn[bj][1] = *(const f32x4*)(cg + col0 + bj * HALF + 4); }
#pragma unroll
        for (int ai = 0; ai < 2; ++ai)
#pragma unroll
            for (int m = 0; m < 4; ++m) { bf16_t* rowp = base + (size_t)(row0 + ai * HALF + m * 16) * ldc + col0;
#pragma unroll
                for (int bj = 0; bj < 2; ++bj) { const f32x4 v0 = acc[ai][bj][m][0] * gn[bj][0], v1 = acc[ai][bj][m][1] * gn[bj][1];
                    u32x4 w; w.x = cvt_pk_c(v0[0], v0[1]); w.y = cvt_pk_c(v0[2], v0[3]); w.z = cvt_pk_c(v1[0], v1[1]); w.w = cvt_pk_c(v1[2], v1[3]);
                    *(u32x4*)(rowp + bj * HALF) = w; } }
    }
};
struct EpiDt {
    static constexpr bool PERM = false; static constexpr bool PERMA = false;
    float* DT; const float* bias;
    __device__ __forceinline__ void operator()(const f32x4 (&acc)[2][2][4][2], const Unit& u, int wr, int wc, int fr, int fq) const {
        if (wc >= 2 || u.pn != 0) return;
        const int row0 = u.pm * BM + wr * 64 + fr, col0 = wc * 32 + 4 * fq;
#pragma unroll
        for (int ai = 0; ai < 2; ++ai)
#pragma unroll
            for (int m = 0; m < 4; ++m) { float* rowp = DT + (size_t)(row0 + ai * HALF + m * 16) * 64 + col0;
#pragma unroll
                for (int n = 0; n < 2; ++n) { const f32x4 bv = *(const f32x4*)(bias + col0 + n * 16); f32x4 v = acc[ai][0][m][n] + bv;
#pragma unroll
                    for (int j = 0; j < 4; ++j) v[j] = v[j] > 20.f ? v[j] : log1pf(__expf(v[j]));
                    *(f32x4*)(rowp + n * 16) = v; } }
    }
};

struct EpiFfnGate {
    static constexpr bool PERM = true; static constexpr bool PERMA = true;
    bf16_t* ACT; bf16_t* SB; const float* cw; const float* cb;
    __device__ __forceinline__ void operator()(const f32x4 (&acc)[2][2][4][2], const Unit& u, int wr, int wc, int fr, int fq) const {
        const int lane = fr + 16 * fq, src_prev = (lane & 48) | ((fr + 15) & 15), src_next = (lane & 48) | ((fr + 1) & 15);
        f32x4 wgs[2][3], wus[2][3], bgs[2], bus[2];
#pragma unroll
        for (int n = 0; n < 2; ++n) { const int f = u.pn * 128 + wc * 32 + 8 * fq + 4 * n;
#pragma unroll
            for (int k = 0; k < 3; ++k) { wgs[n][k] = *(const f32x4*)(cw + k * F2 + f); wus[n][k] = *(const f32x4*)(cw + k * F2 + DFF + f); }
            bgs[n] = *(const f32x4*)(cb + f); bus[n] = *(const f32x4*)(cb + DFF + f); }
        const int f0 = u.pn * 128 + wc * 32 + 8 * fq;
#pragma unroll
        for (int ai = 0; ai < 2; ++ai) {
            f32x4 gpl[2], upl[2], gnl[2], unl[2];
#pragma unroll
            for (int n = 0; n < 2; ++n)
#pragma unroll
                for (int j = 0; j < 4; ++j) { gpl[n][j] = __shfl(acc[ai][0][3][n][j], src_prev); upl[n][j] = __shfl(acc[ai][1][3][n][j], src_prev);
                                              gnl[n][j] = __shfl(acc[ai][0][0][n][j], src_next); unl[n][j] = __shfl(acc[ai][1][0][n][j], src_next); }
#pragma unroll
            for (int m = 0; m < 4; ++m) {
                const int lr = 4 * fr + m, row = u.pm * BM + ai * HALF + wr * 64 + lr;
                float o[8];
#pragma unroll
                for (int n = 0; n < 2; ++n) {
                    const f32x4 g0 = acc[ai][0][m][n], u0 = acc[ai][1][m][n];
                    const f32x4 gp = m > 0 ? acc[ai][0][m > 0 ? m - 1 : 0][n] : gpl[n], up = m > 0 ? acc[ai][1][m > 0 ? m - 1 : 0][n] : upl[n];
                    const f32x4 gn = m < 3 ? acc[ai][0][m < 3 ? m + 1 : 3][n] : gnl[n], un = m < 3 ? acc[ai][1][m < 3 ? m + 1 : 3][n] : unl[n];
                    const f32x4 G = bgs[n] + wgs[n][0] * gp + wgs[n][1] * g0 + wgs[n][2] * gn;
                    const f32x4 U = bus[n] + wus[n][0] * up + wus[n][1] * u0 + wus[n][2] * un;
#pragma unroll
                    for (int j = 0; j < 4; ++j) o[4 * n + j] = silu_f(G[j]) * U[j]; }
                if (lr >= 1 && lr <= 62) { u32x4 w; w.x = cvt_pk_c(o[0], o[1]); w.y = cvt_pk_c(o[2], o[3]); w.z = cvt_pk_c(o[4], o[5]); w.w = cvt_pk_c(o[6], o[7]); *(u32x4*)(ACT + (size_t)row * DFF + f0) = w; }
                if (lr <= 1 || lr >= 62) {
                    const int slot = lr <= 1 ? lr : lr - 60; bf16_t* sb = SB + ((size_t)(row >> 6) * 4 + slot) * F2 + f0;
                    const f32x4 ga = acc[ai][0][m][0], gb = acc[ai][0][m][1], ua = acc[ai][1][m][0], ub = acc[ai][1][m][1];
                    u32x4 w; w.x = cvt_pk_c(ga[0], ga[1]); w.y = cvt_pk_c(ga[2], ga[3]); w.z = cvt_pk_c(gb[0], gb[1]); w.w = cvt_pk_c(gb[2], gb[3]); *(u32x4*)sb = w;
                    w.x = cvt_pk_c(ua[0], ua[1]); w.y = cvt_pk_c(ua[2], ua[3]); w.z = cvt_pk_c(ub[0], ub[1]); w.w = cvt_pk_c(ub[2], ub[3]); *(u32x4*)(sb + DFF) = w; }
            }
        }
    }
};

struct EpiSoftmax {
    static constexpr bool PERM = true; static constexpr bool PERMA = false;
    bf16_t* P; int ldc; long cZ; float c; LAS float* xch; const float* PS;
    __device__ __forceinline__ void operator()(f32x4 (&acc)[2][2][4][2], const Unit& u, int wr, int wc, int fr, int fq) const {
        float mw[2][4], cr[2][4];
#pragma unroll
        for (int ai = 0; ai < 2; ++ai)
#pragma unroll
            for (int m = 0; m < 4; ++m) { const float* pp = PS + (size_t)(u.z * SEQ + u.pm * BM + ai * HALF + wr * 64 + m * 16 + fr) * 32 + fq * 8;
                const f32x4 a = *(const f32x4*)pp, b = *(const f32x4*)(pp + 4); float t = ((a.x + a.y) + (a.z + a.w)) + ((b.x + b.y) + (b.z + b.w));
                t += __shfl_xor(t, 16); t += __shfl_xor(t, 32); cr[ai][m] = c * (1.0f / sqrtf(t * (1.f / DM) + EPS)); }
#pragma unroll
        for (int ai = 0; ai < 2; ++ai)
#pragma unroll
            for (int m = 0; m < 4; ++m) {
                float v = -3.0e38f;
#pragma unroll
                for (int bj = 0; bj < 2; ++bj)
#pragma unroll
                    for (int n = 0; n < 2; ++n) { const f32x4 a = acc[ai][bj][m][n]; v = fmaxf(v, fmaxf(fmaxf(a[0], a[1]), fmaxf(a[2], a[3]))); }
                v = fmaxf(v, __shfl_xor(v, 16)); v = fmaxf(v, __shfl_xor(v, 32));
                mw[ai][m] = v;
                float s = 0.f;
#pragma unroll
                for (int bj = 0; bj < 2; ++bj)
#pragma unroll
                    for (int n = 0; n < 2; ++n) { f32x4 a = acc[ai][bj][m][n];
#pragma unroll
                        for (int j = 0; j < 4; ++j) { a[j] = __builtin_amdgcn_exp2f((a[j] - v) * cr[ai][m]); s += a[j]; }
                        acc[ai][bj][m][n] = a; }
                s += __shfl_xor(s, 16); s += __shfl_xor(s, 32);
                if (fq == 0) { f32x2 t; t.x = v; t.y = s; *(LAS f32x2*)(xch + ((wr * 128 + ai * 64 + m * 16 + fr) * 4 + wc) * 2) = t; }
            }
        asm volatile("s_waitcnt lgkmcnt(0)" ::: "memory"); __builtin_amdgcn_s_barrier(); asm volatile("" ::: "memory");
#pragma unroll
        for (int ai = 0; ai < 2; ++ai)
#pragma unroll
            for (int m = 0; m < 4; ++m) {
                const LAS f32x4* q = (const LAS f32x4*)(xch + (wr * 128 + ai * 64 + m * 16 + fr) * 8); const f32x4 q0 = q[0], q1 = q[1];
                const float M = fmaxf(fmaxf(q0.x, q0.z), fmaxf(q1.x, q1.z));
                const float cc = cr[ai][m];
                const float S = (q0.y * __builtin_amdgcn_exp2f((q0.x - M) * cc) + q0.w * __builtin_amdgcn_exp2f((q0.z - M) * cc)) + (q1.y * __builtin_amdgcn_exp2f((q1.x - M) * cc) + q1.w * __builtin_amdgcn_exp2f((q1.z - M) * cc));
                const float f = __builtin_amdgcn_exp2f((mw[ai][m] - M) * cc) / S;
                bf16_t* rowp = P + (size_t)u.z * cZ + (size_t)(u.pm * BM + ai * HALF + wr * 64 + m * 16 + fr) * ldc + u.pn * BM + wc * 32 + 8 * fq;
#pragma unroll
                for (int bj = 0; bj < 2; ++bj) { const f32x4 v0 = acc[ai][bj][m][0] * f, v1 = acc[ai][bj][m][1] * f;
                    u32x4 w; w.x = cvt_pk_c(v0[0], v0[1]); w.y = cvt_pk_c(v0[2], v0[3]); w.z = cvt_pk_c(v1[0], v1[1]); w.w = cvt_pk_c(v1[2], v1[3]);
                    *(u32x4*)(rowp + bj * HALF) = w; }
            }
    }
};

template <class Epi>
__device__ __forceinline__ void gemm_phase(LAS unsigned char* lds, const Gemm g, const Order& S, const Epi& E) {
    int tid_ = threadIdx.x; asm volatile("" : "+v"(tid_));
    const int tid = tid_, wid = __builtin_amdgcn_readfirstlane(tid >> 6), lane = tid & 63, wr = wid >> 2, wc = wid & 3, fr = lane & 15, fq = lane >> 4;
    const int K = g.K, nt = K / BK;
    unsigned voffA[2], voffB[2];
#pragma unroll
    for (int i = 0; i < 2; ++i) { int R, C; stage_rc(tid * 16 + i * 8192, R, C); const int Rb = Epi::PERM ? ((R & ~31) + perm32(R & 31)) : R;
        const int Ra = Epi::PERMA ? ((R & ~63) + 4 * (R & 15) + ((R >> 4) & 3)) : R;
        voffA[i] = (unsigned)(Ra * g.lda + C) * 2u; voffB[i] = (unsigned)(Rb * g.ldb + C) * 2u; }
    const size_t kstep = (size_t)(BK * 2);
    const size_t hsA = (size_t)HALF * g.lda * 2, hsB = (size_t)HALF * g.ldb * 2;
    const unsigned ldsw = (unsigned)wid * 1024u;
    const int aoff = lds_byte(wr * 64 + fr, fq * 8), boff = lds_byte(wc * 32 + fr, fq * 8);
#define PG8_SA(b, h) (((b) * 2 + (h)) * HTB)
#define PG8_SB(b, h) ((4 + (b) * 2 + (h)) * HTB)
#define PG8_STAGE(bufoff, gbase, voff) do { _Pragma("unroll") for (int _i = 0; _i < 2; ++_i) \
        __builtin_amdgcn_global_load_lds((const unsigned*)((const char*)(gbase) + (voff)[_i]), (LAS unsigned*)(lds + (bufoff) + ldsw + _i * 8192), 16, 0, 0); } while (0)
#define PG8_LDA(dst, b, h) do { _Pragma("unroll") for (int m = 0; m < 4; ++m) _Pragma("unroll") for (int k = 0; k < 2; ++k) dst[m][k] = *(const LAS bf16x8*)(lds + PG8_SA(b, h) + aoff + m * 2048 + k * 1024); } while (0)
#define PG8_LDB(dst, b, h) do { _Pragma("unroll") for (int n = 0; n < 2; ++n) _Pragma("unroll") for (int k = 0; k < 2; ++k) dst[n][k] = *(const LAS bf16x8*)(lds + PG8_SB(b, h) + boff + n * 2048 + k * 1024); } while (0)
#define PG8_MMA(ai, bj, At, Bt) do { __builtin_amdgcn_s_setprio(1); _Pragma("unroll") for (int m = 0; m < 4; ++m) _Pragma("unroll") for (int n = 0; n < 2; ++n) _Pragma("unroll") for (int k = 0; k < 2; ++k) \
        acc[ai][bj][m][n] = __builtin_amdgcn_mfma_f32_16x16x32_bf16(Bt[n][k], At[m][k], acc[ai][bj][m][n], 0, 0, 0); __builtin_amdgcn_s_setprio(0); } while (0)
#define PG8_WAIT_V(n) asm volatile("s_waitcnt vmcnt(" #n ")" ::: "memory")
#define PG8_WAIT_L(n) asm volatile("s_waitcnt lgkmcnt(" #n ")" ::: "memory")
#define PG8_BAR __builtin_amdgcn_s_barrier()
#define PG8_SCHED __builtin_amdgcn_sched_barrier(0)
    Unit cur, nxt; int ui = 0;
    if (!S.next(0, cur)) return;
    f32x4 acc[2][2][4][2];
#pragma unroll
    for (int a = 0; a < 2; ++a)
#pragma unroll
        for (int b = 0; b < 2; ++b)
#pragma unroll
            for (int m = 0; m < 4; ++m)
#pragma unroll
                for (int n = 0; n < 2; ++n) acc[a][b][m][n] = (f32x4){0.f, 0.f, 0.f, 0.f};
    bf16x8 At[4][2], B0[2][2], B1[2][2];
    const char* cA = a_ptr(g, cur); const char* cB = b_ptr(g, cur);
    PG8_STAGE(PG8_SB(0, 0), cB, voffB); PG8_STAGE(PG8_SA(0, 0), cA, voffA); PG8_STAGE(PG8_SB(0, 1), cB + hsB, voffB); PG8_STAGE(PG8_SA(0, 1), cA + hsA, voffA);
    if (wr == 1) PG8_BAR;
    PG8_WAIT_V(4); PG8_BAR;
    PG8_STAGE(PG8_SB(1, 0), cB + kstep, voffB); PG8_STAGE(PG8_SA(1, 0), cA + kstep, voffA); PG8_STAGE(PG8_SB(1, 1), cB + hsB + kstep, voffB);
    PG8_WAIT_V(6); PG8_BAR;
    for (;;) {
        const bool has_next = S.next(ui + 1, nxt);
        const char* nA = has_next ? a_ptr(g, nxt) : cA; const char* nB = has_next ? b_ptr(g, nxt) : cB;
        for (int t = 0; t < nt; t += 2) {
            const bool last = (t == nt - 2);
            const char* a1 = cA + (size_t)(t + 1) * kstep;
            const char* a2 = last ? nA : cA + (size_t)(t + 2) * kstep; const char* b2 = last ? nB : cB + (size_t)(t + 2) * kstep;
            const char* a3 = a2 + kstep; const char* b3 = b2 + kstep;
            PG8_LDB(B0, 0, 0); PG8_SCHED; PG8_LDA(At, 0, 0); PG8_STAGE(PG8_SA(1, 1), a1 + hsA, voffA);
            PG8_WAIT_L(8); PG8_BAR; PG8_WAIT_L(0); PG8_MMA(0, 0, At, B0); PG8_BAR; PG8_SCHED;
            PG8_LDB(B1, 0, 1); PG8_STAGE(PG8_SB(0, 0), b2, voffB);
            PG8_BAR; PG8_WAIT_L(0); PG8_MMA(0, 1, At, B1); PG8_BAR;
            PG8_LDA(At, 0, 1); PG8_STAGE(PG8_SA(0, 0), a2, voffA);
            PG8_BAR; PG8_WAIT_L(0); PG8_MMA(1, 0, At, B0); PG8_BAR; PG8_SCHED;
            PG8_STAGE(PG8_SB(0, 1), b2 + hsB, voffB);
            PG8_WAIT_V(6); PG8_BAR; PG8_MMA(1, 1, At, B1); PG8_BAR;
            PG8_LDB(B0, 1, 0); PG8_SCHED; PG8_LDA(At, 1, 0); PG8_STAGE(PG8_SA(0, 1), a2 + hsA, voffA);
            PG8_WAIT_L(8); PG8_BAR; PG8_WAIT_L(0); PG8_MMA(0, 0, At, B0); PG8_BAR; PG8_SCHED;
            PG8_LDB(B1, 1, 1); PG8_STAGE(PG8_SB(1, 0), b3, voffB);
            PG8_BAR; PG8_WAIT_L(0); PG8_MMA(0, 1, At, B1); PG8_BAR;
            PG8_LDA(At, 1, 1); PG8_STAGE(PG8_SA(1, 0), a3, voffA);
            PG8_BAR; PG8_WAIT_L(0); PG8_MMA(1, 0, At, B0); PG8_BAR; PG8_SCHED;
            PG8_STAGE(PG8_SB(1, 1), b3 + hsB, voffB);
            PG8_WAIT_V(6); PG8_BAR; PG8_MMA(1, 1, At, B1); PG8_BAR;
        }
        E(acc, cur, wr, wc, fr, fq);
        if (!has_next) break;
#pragma unroll
        for (int a = 0; a < 2; ++a)
#pragma unroll
            for (int b = 0; b < 2; ++b)
#pragma unroll
                for (int m = 0; m < 4; ++m)
#pragma unroll
                    for (int n = 0; n < 2; ++n) acc[a][b][m][n] = (f32x4){0.f, 0.f, 0.f, 0.f};
        cur = nxt; cA = nA; cB = nB; ++ui;
    }
    PG8_WAIT_V(0);
    if (wr == 0) PG8_BAR;
    PG8_BAR;
#undef PG8_SA
#undef PG8_SB
#undef PG8_STAGE
#undef PG8_LDA
#undef PG8_LDB
#undef PG8_MMA
#undef PG8_WAIT_V
#undef PG8_WAIT_L
#undef PG8_BAR
#undef PG8_SCHED
}
}
#define XB_TMO      128
#define XB_XCNT(j)  (256  + 64 * (j))
#define XB_XSUB(j)  (1280 + 64 * (j))
#define XB_XGEN(j)  (2304 + 64 * (j))
#define XB_TOP      3328
#define XB_TOPGEN   3392
#define XCD_BAR_WORDS 3456
#define XB_SPIN_CAP (1u << 20)

__device__ __forceinline__ unsigned xb_ld(unsigned* p)              { return __hip_atomic_load(p, __ATOMIC_RELAXED, __HIP_MEMORY_SCOPE_AGENT); }
__device__ __forceinline__ unsigned xb_add(unsigned* p, unsigned v) { return __hip_atomic_fetch_add(p, v, __ATOMIC_RELAXED, __HIP_MEMORY_SCOPE_AGENT); }
__device__ __forceinline__ unsigned xb_xcc_id() { return (unsigned)__builtin_amdgcn_s_getreg((3 << 11) | 20) & 0xFu; }
#define XB_SPIN(cond, bar) do { unsigned _sp = 0; while (cond) { __builtin_amdgcn_s_sleep(1); \
    if ((++_sp & 255u) == 0u) { if (xb_ld(&(bar)[XB_TMO])) break; if (_sp > XB_SPIN_CAP) { atomicAdd(&(bar)[XB_TMO], 1u); break; } } } } while (0)

struct XcdBarrier { unsigned* bar; unsigned x; volatile LAS unsigned* st; };

__device__ __forceinline__ XcdBarrier xcd_barrier_post(unsigned* bar, volatile LAS unsigned* st) {
    XcdBarrier b; b.bar = bar; b.x = xb_xcc_id(); b.st = st;
    if (threadIdx.x == 0) (void)xb_add(&bar[XB_XCNT(b.x)], 1u);
    return b;
}
__device__ __forceinline__ void xcd_barrier_complete(unsigned* bar, unsigned x, unsigned& nloc, unsigned& nx) {
    const unsigned G = gridDim.x * gridDim.y * gridDim.z;
    unsigned sum, cnt, mine, sp = 0u;
    for (;;) {
        sum = 0u; cnt = 0u; mine = 0u;
#pragma unroll
        for (unsigned j = 0; j < 16; ++j) { const unsigned c = xb_ld(&bar[XB_XCNT(j)]); sum += c; cnt += (c > 0u) ? 1u : 0u; mine = (j == x) ? c : mine; }
        if (sum == G) break;
        __builtin_amdgcn_s_sleep(1);
        if ((++sp & 255u) == 0u) { if (xb_ld(&bar[XB_TMO])) break; if (sp > XB_SPIN_CAP) { atomicAdd(&bar[XB_TMO], 1u); break; } }
    }
    nloc = mine > 0u ? mine : 1u; nx = cnt > 0u ? cnt : 1u;
}
__device__ __forceinline__ void xcd_barrier(const XcdBarrier& b) {
    asm volatile("s_waitcnt vmcnt(0)" ::: "memory");
    __syncthreads();
    if (threadIdx.x == 0) {
        unsigned* bar = b.bar;
        __builtin_amdgcn_s_waitcnt(0);
        unsigned nloc = b.st[0], nx = b.st[1];
        if (nloc == 0u) { xcd_barrier_complete(bar, b.x, nloc, nx); b.st[0] = nloc; b.st[1] = nx; }
        const unsigned old = xb_add(&bar[XB_XSUB(b.x)], 1u);
        const unsigned gen = old / nloc;
        if (old + 1u == (gen + 1u) * nloc) {
            __builtin_amdgcn_fence(__ATOMIC_RELEASE, "agent");
            asm volatile("s_waitcnt vmcnt(0)" ::: "memory");
            const unsigned og = xb_add(&bar[XB_TOP], 1u);
            const unsigned tg = og / nx;
            if (og + 1u == (tg + 1u) * nx) xb_add(&bar[XB_TOPGEN], 1u);
            else XB_SPIN(xb_ld(&bar[XB_TOPGEN]) == tg, bar);
            __builtin_amdgcn_fence(__ATOMIC_ACQUIRE, "agent");
            xb_add(&bar[XB_XGEN(b.x)], 1u);
            asm volatile("s_waitcnt vmcnt(0)" ::: "memory");
        } else {
            XB_SPIN(xb_ld(&bar[XB_XGEN(b.x)]) == gen, bar);
            __builtin_amdgcn_fence(__ATOMIC_ACQUIRE, "agent");
            asm volatile("s_waitcnt vmcnt(0)" ::: "memory");
        }
    }
    __syncthreads();
}

struct Args { const float* in[40]; float* out; unsigned char* ws; int l_lo, l_hi, s_lo, s_hi, fused, pad; };
struct Frame {
    LAS unsigned char* lds;
    int tid, lane, wave, G, bid;
    float* out; unsigned char* ws;
    bf16_t* h;
    bf16_t* x16;
};
enum { I_XP = 0, I_XS, I_MP, I_MS, I_NMIX, I_NXA, I_NMEM, I_NFFN, I_WQ, I_WK, I_WV, I_WO, I_FIN, I_FCW, I_FCB, I_FOUT, I_MIN, I_MOUT, I_SCW, I_SCB, I_ALOG, I_DTB, I_SD, I_SNORM,
       I_QN, I_KN, I_HIN, I_HCW, I_HCB, I_FW1, I_FB1, I_FW2, I_FB2, I_FW3, I_FB3, I_FFREQ, I_FWO, I_HSKIP, I_HOUT, I_FNORM };

__device__ __forceinline__ const float* inp(int i) {
    unsigned off = (unsigned)i * 8u; asm volatile("" : "+s"(off));
    const char __attribute__((address_space(4)))* ka = (const char __attribute__((address_space(4)))*)__builtin_amdgcn_kernarg_segment_ptr();
    return *(const float* const __attribute__((address_space(4)))*)(ka + off);
}
__device__ __forceinline__ void tr_item(const float* W, int K, int Nsrc, int c0, bf16_t* WT, int r0, int nblk, LAS float* scr, int item, int lane) {
    const int kb = item / nblk, nb = item % nblk, k0 = 64 * kb, n0 = 32 * nb;
#pragma unroll 8
    for (int i = 0; i < 32; ++i) { const int kk = 2 * i + (lane >> 5); scr[kk * 33 + (lane & 31)] = W[(size_t)(k0 + kk) * Nsrc + c0 + n0 + (lane & 31)]; }
    LDS_WAIT(); asm volatile("" ::: "memory");
    const int c = lane & 7;
#pragma unroll
    for (int j = 0; j < 4; ++j) { const int n = (lane >> 3) + 8 * j; const LAS float* s = scr + (8 * c) * 33 + n;
        u32x4 o; o.x = cvt_pk_bf16(s[0 * 33], s[1 * 33]); o.y = cvt_pk_bf16(s[2 * 33], s[3 * 33]); o.z = cvt_pk_bf16(s[4 * 33], s[5 * 33]); o.w = cvt_pk_bf16(s[6 * 33], s[7 * 33]);
        *(u32x4*)(WT + (size_t)(r0 + n0 + n) * K + k0 + 8 * c) = o; }
    LDS_WAIT(); asm volatile("" ::: "memory");
}
__device__ __forceinline__ void tr_seg(const float* W, int K, int Nsrc, int c0, int ncols, bf16_t* WT, int r0, LAS float* scr, int gw, int NGW, int lane) {
    const int nblk = ncols / 32, nit = (K / 64) * nblk;
    for (int it = gw; it < nit; it += NGW) tr_item(W, K, Nsrc, c0, WT, r0, nblk, scr, it, lane);
}
__device__ __forceinline__ void rms_row(const float* xrow, const float* gain, bf16_t* orow, float* copy, int lane) {
    const f32x4* xr = (const f32x4*)xrow + lane; const f32x4* gr = (const f32x4*)gain + lane;
    f32x4 v[8]; float s = 0.f;
#pragma unroll
    for (int j = 0; j < 8; ++j) { v[j] = xr[64 * j]; s += (v[j].x * v[j].x + v[j].y * v[j].y) + (v[j].z * v[j].z + v[j].w * v[j].w); }
    if (copy) {
#pragma unroll
        for (int j = 0; j < 8; ++j) ((f32x4*)copy + lane)[64 * j] = v[j];
    }
    const float rstd = 1.0f / sqrtf(wave_sum(s) * (1.f / DM) + EPS);
    u32x2* o8 = (u32x2*)orow + lane;
#pragma unroll
    for (int j = 0; j < 8; ++j) { const f32x4 g = gr[64 * j]; u32x2 w; w.x = cvt_pk_bf16(v[j].x * rstd * g.x, v[j].y * rstd * g.y); w.y = cvt_pk_bf16(v[j].z * rstd * g.z, v[j].w * rstd * g.w); o8[64 * j] = w; }
}
__device__ __forceinline__ void phase_rms_x(Frame& F, const float* gain, bool from_inputs) {
    bf16_t* H = F.h; bf16_t* X = F.x16;
    const int gw = F.bid * 8 + F.wave, NGW = F.G * 8, lane = F.lane;
    f32x4 gn[4][2];
#pragma unroll
    for (int j = 0; j < 4; ++j) { gn[j][0] = *(const f32x4*)(gain + j * 512 + lane * 8); gn[j][1] = *(const f32x4*)(gain + j * 512 + lane * 8 + 4); }
    if (from_inputs) {
        for (int m = gw; m < T; m += NGW) {
            float v[4][8]; float s = 0.f;
            const float* src = (m < 4 * SEQ ? inp(I_XP) + (size_t)m * DM : inp(I_XS) + (size_t)(m - 4 * SEQ) * DM);
#pragma unroll
            for (int j = 0; j < 4; ++j) { const f32x4 a = *(const f32x4*)(src + j * 512 + lane * 8), b = *(const f32x4*)(src + j * 512 + lane * 8 + 4);
                v[j][0] = a.x; v[j][1] = a.y; v[j][2] = a.z; v[j][3] = a.w; v[j][4] = b.x; v[j][5] = b.y; v[j][6] = b.z; v[j][7] = b.w;
                *(u32x4*)(X + (size_t)m * DM + j * 512 + lane * 8) = pack8(v[j]); }
#pragma unroll
            for (int j = 0; j < 4; ++j)
#pragma unroll
                for (int i = 0; i < 8; ++i) s += v[j][i] * v[j][i];
            const float rstd = 1.0f / sqrtf(wave_sum(s) * (1.f / DM) + EPS);
#pragma unroll
            for (int j = 0; j < 4; ++j) { const f32x4 g0 = gn[j][0], g1 = gn[j][1];
                float o[8]; o[0] = v[j][0] * rstd * g0.x; o[1] = v[j][1] * rstd * g0.y; o[2] = v[j][2] * rstd * g0.z; o[3] = v[j][3] * rstd * g0.w;
                o[4] = v[j][4] * rstd * g1.x; o[5] = v[j][5] * rstd * g1.y; o[6] = v[j][6] * rstd * g1.z; o[7] = v[j][7] * rstd * g1.w;
                *(u32x4*)(H + (size_t)m * DM + j * 512 + lane * 8) = pack8(o); }
        }
    } else {
        for (int m = gw; m < T; m += 2 * NGW) {
            const int m1 = m + NGW; const bool has1 = m1 < T; const int mb = has1 ? m1 : m;
            u32x4 ra[4], rb[4];
#pragma unroll
            for (int j = 0; j < 4; ++j) { ra[j] = *(const u32x4*)(X + (size_t)m * DM + j * 512 + lane * 8); rb[j] = *(const u32x4*)(X + (size_t)mb * DM + j * 512 + lane * 8); }
#pragma unroll
            for (int q = 0; q < 2; ++q) {
                if (q == 1 && !has1) break;
                float v[4][8]; float s = 0.f;
#pragma unroll
                for (int j = 0; j < 4; ++j) unpack8(q ? rb[j] : ra[j], v[j]);
#pragma unroll
                for (int j = 0; j < 4; ++j)
#pragma unroll
                    for (int i = 0; i < 8; ++i) s += v[j][i] * v[j][i];
                const float rstd = 1.0f / sqrtf(wave_sum(s) * (1.f / DM) + EPS);
                const int mo = q ? m1 : m;
#pragma unroll
                for (int j = 0; j < 4; ++j) { const f32x4 g0 = gn[j][0], g1 = gn[j][1];
                    float o[8]; o[0] = v[j][0] * rstd * g0.x; o[1] = v[j][1] * rstd * g0.y; o[2] = v[j][2] * rstd * g0.z; o[3] = v[j][3] * rstd * g0.w;
                    o[4] = v[j][4] * rstd * g1.x; o[5] = v[j][5] * rstd * g1.y; o[6] = v[j][6] * rstd * g1.z; o[7] = v[j][7] * rstd * g1.w;
                    *(u32x4*)(H + (size_t)mo * DM + j * 512 + lane * 8) = pack8(o); }
            }
        }
    }
}
__device__ __forceinline__ void phase_final_norm(Frame& F) {
    const int gw = F.bid * 8 + F.wave, NGW = F.G * 8, lane = F.lane; const float* gain = inp(I_FNORM); const bf16_t* X = F.x16;
    f32x4 gn[4][2];
#pragma unroll
    for (int j = 0; j < 4; ++j) { gn[j][0] = *(const f32x4*)(gain + j * 512 + lane * 8); gn[j][1] = *(const f32x4*)(gain + j * 512 + lane * 8 + 4); }
    for (int m = gw; m < T; m += 2 * NGW) {
        const int m1 = m + NGW; const bool has1 = m1 < T; const int mb = has1 ? m1 : m;
        u32x4 ra[4], rb[4];
#pragma unroll
        for (int j = 0; j < 4; ++j) { ra[j] = *(const u32x4*)(X + (size_t)m * DM + j * 512 + lane * 8); rb[j] = *(const u32x4*)(X + (size_t)mb * DM + j * 512 + lane * 8); }
#pragma unroll
        for (int q = 0; q < 2; ++q) {
            if (q == 1 && !has1) break;
            float v[4][8]; float s = 0.f; const int mo = q ? m1 : m;
#pragma unroll
            for (int j = 0; j < 4; ++j) unpack8(q ? rb[j] : ra[j], v[j]);
#pragma unroll
            for (int j = 0; j < 4; ++j)
#pragma unroll
                for (int i = 0; i < 8; ++i) s += v[j][i] * v[j][i];
            const float rstd = 1.0f / sqrtf(wave_sum(s) * (1.f / DM) + EPS);
#pragma unroll
            for (int j = 0; j < 4; ++j) { const f32x4 g0 = gn[j][0], g1 = gn[j][1];
                f32x4 o0, o1; o0.x = v[j][0] * rstd * g0.x; o0.y = v[j][1] * rstd * g0.y; o0.z = v[j][2] * rstd * g0.z; o0.w = v[j][3] * rstd * g0.w;
                o1.x = v[j][4] * rstd * g1.x; o1.y = v[j][5] * rstd * g1.y; o1.z = v[j][6] * rstd * g1.z; o1.w = v[j][7] * rstd * g1.w;
                *(f32x4*)(F.out + (size_t)mo * DM + j * 512 + lane * 8) = o0; *(f32x4*)(F.out + (size_t)mo * DM + j * 512 + lane * 8 + 4) = o1; }
        }
    }
}

__device__ __forceinline__ void phase_prep(Frame& F, int layer) {
    LAS float* scr = (LAS float*)(F.lds + F.wave * 8448);
    const int gw = F.bid * 8 + F.wave, NGW = F.G * 8, lane = F.lane;
    unsigned char* ws = F.ws;
    const int e = layer >> 1;
    if (!(layer & 1)) {
        const float* win = inp(I_MIN) + (size_t)e * DM * 8256;
        bf16_t* WI = (bf16_t*)(ws + W_IN);
        tr_seg(win, DM, 8256, 0, 2048, WI, PC_Z, scr, gw, NGW, lane);
        tr_seg(win, DM, 8256, 5184, 2048, WI, PC_Q, scr, gw, NGW, lane);
        tr_seg(win, DM, 8256, 2048, 3072, WI, PC_X, scr, gw, NGW, lane);
        tr_seg(win, DM, 8256, 7232, 512, WI, PC_K, scr, gw, NGW, lane);
        tr_seg(win, DM, 8256, 7744, 512, WI, PC_V, scr, gw, NGW, lane);
        tr_seg(win, DM, 8256, 5120, 64, (bf16_t*)(ws + W_DT), 0, scr, gw, NGW, lane);
        { u32x4* z = (u32x4*)(ws + W_DT + (size_t)64 * DM * 2); const int n16 = 192 * DM * 2 / 16;
          for (int i = F.bid * 512 + F.tid; i < n16; i += F.G * 512) z[i] = (u32x4){0u, 0u, 0u, 0u}; }
        tr_seg(inp(I_MOUT) + (size_t)e * 4096 * DM, 4096, DM, 0, DM, (bf16_t*)(ws + W_OUT), 0, scr, gw, NGW, lane);
    } else {
        tr_seg(inp(I_HIN) + (size_t)e * DM * HYW, DM, HYW, 0, HYW, (bf16_t*)(ws + HW_IN), 0, scr, gw, NGW, lane);
        tr_seg(inp(I_HOUT) + (size_t)e * DM * DM, DM, DM, 0, DM, (bf16_t*)(ws + HW_OUT), 0, scr, gw, NGW, lane);
    }
    { const float* wq = inp(I_WQ) + (size_t)layer * DM * DM; bf16_t* o = (bf16_t*)(ws + W_Q);
      for (int i = F.bid * 512 + F.tid; i < DM * DM / 8; i += F.G * 512) { const f32x4 a = *(const f32x4*)(wq + (size_t)i * 8), b = *(const f32x4*)(wq + (size_t)i * 8 + 4);
          u32x4 w; w.x = cvt_pk_bf16(a.x, a.y); w.y = cvt_pk_bf16(a.z, a.w); w.z = cvt_pk_bf16(b.x, b.y); w.w = cvt_pk_bf16(b.z, b.w); *(u32x4*)(o + (size_t)i * 8) = w; } }
    tr_seg(inp(I_WK) + (size_t)layer * DM * DM, DM, DM, 0, DM, (bf16_t*)(ws + W_K), 0, scr, gw, NGW, lane);
    tr_seg(inp(I_WV) + (size_t)layer * DM * DM, DM, DM, 0, DM, (bf16_t*)(ws + W_V), 0, scr, gw, NGW, lane);
    tr_seg(inp(I_WO) + (size_t)layer * DM * DM, DM, DM, 0, DM, (bf16_t*)(ws + W_O), 0, scr, gw, NGW, lane);
    { const float* fin = inp(I_FIN) + (size_t)layer * DM * F2;
      for (int it = gw; it < 88 * 128; it += NGW) { const int sg = it >> 7, li = it & 127, j = sg >> 1, half = sg & 1;
          tr_item(fin, DM, F2, half * DFF + 128 * j, (bf16_t*)(ws + W_FIN), 128 * sg, 4, scr, li, lane); } }
    tr_seg(inp(I_FOUT) + (size_t)layer * DFF * DM, DFF, DM, 0, DM, (bf16_t*)(ws + W_FOUT), 0, scr, gw, NGW, lane);
    phase_rms_x(F, inp(I_NMIX) + (size_t)layer * DM, layer == 0);
    for (int m = gw; m < MROWS; m += NGW) {
        const float* src = m < 4 * NMEM ? inp(I_MP) + (size_t)m * DM : inp(I_MS) + (size_t)(m - 4 * NMEM) * DM;
        rms_row(src, inp(I_NMEM) + (size_t)layer * DM, (bf16_t*)(ws + WS_MEMN) + (size_t)m * DM, nullptr, lane);
    }
    if (layer & 1) {
        f32x2* tw = (f32x2*)(ws + WS_TW);
        for (int i = F.bid * 512 + F.tid; i < 4096; i += F.G * 512) { float s, c; sincospif(-(float)i * (1.0f / 8192.0f), &s, &c); { f32x2 tv; tv.x = c; tv.y = s; tw[i] = tv; } }
        const float* w1 = inp(I_FW1) + (size_t)e * 33 * 64; const float* b1 = inp(I_FB1) + e * 64;
        const float* w2 = inp(I_FW2) + (size_t)e * 64 * 64; const float* b2 = inp(I_FB2) + e * 64;
        const float* w3 = inp(I_FW3) + (size_t)e * 64 * 64; const float* b3 = inp(I_FB3) + e * 64;
        const float fr = inp(I_FFREQ)[e * 64 + lane];
        float* h3 = (float*)(ws + WS_H3);
        for (int t = gw; t < SEQ; t += NGW) {
            float z = 0.f;
            { const float wt = 6.283185307179586f * (float)t / (float)SEQ;
              if (lane == 0) z = (float)t / (float)(SEQ - 1);
              else if (lane <= 16) { const float f = 1e-4f + (float)(lane - 1) * ((15.0f - 1e-4f) / 15.0f); z = cosf(wt * f); }
              else if (lane <= 32) { const float f = 1e-4f + (float)(lane - 17) * ((15.0f - 1e-4f) / 15.0f); z = -sinf(wt * f); } }
            float a = b1[lane];
            for (int i = 0; i < 33; ++i) a += __shfl(z, i) * w1[i * 64 + lane];
            float h = sinf(fr * a);
            a = b2[lane];
            for (int i = 0; i < 64; ++i) a += __shfl(h, i) * w2[i * 64 + lane];
            h = sinf(fr * a);
            a = b3[lane];
            for (int i = 0; i < 64; ++i) a += __shfl(h, i) * w3[i * 64 + lane];
            h = sinf(fr * a);
            h3[(size_t)t * 64 + lane] = h;
        }
    }
}
__device__ __forceinline__ void phase_ssd_conv(Frame& F, int e) {
    const bf16_t* P = (const bf16_t*)(F.ws + WS_PROJ); bf16_t* XS = F.h; bf16_t* BC = (bf16_t*)(F.ws + WS_BC);
    const float* cw = inp(I_SCW) + (size_t)e * 5 * 3072; const float* cb = inp(I_SCB) + (size_t)e * 3072;
    const int nitem = (T / 16) * 384;
    for (int it = F.bid * 512 + F.tid; it < nitem; it += F.G * 512) {
        const int strip = it / 384, oc = it % 384, ch = oc * 8, m0 = strip * 16, t0 = m0 % SEQ;
        float w[5][8], bias[8];
#pragma unroll
        for (int k = 0; k < 5; ++k) { const f32x4 a = *(const f32x4*)(cw + k * 3072 + ch), b = *(const f32x4*)(cw + k * 3072 + ch + 4);
            w[k][0] = a.x; w[k][1] = a.y; w[k][2] = a.z; w[k][3] = a.w; w[k][4] = b.x; w[k][5] = b.y; w[k][6] = b.z; w[k][7] = b.w; }
        { const f32x4 a = *(const f32x4*)(cb + ch), b = *(const f32x4*)(cb + ch + 4); bias[0] = a.x; bias[1] = a.y; bias[2] = a.z; bias[3] = a.w; bias[4] = b.x; bias[5] = b.y; bias[6] = b.z; bias[7] = b.w; }
        u32x4 raw[20];
#pragma unroll
        for (int k = 0; k < 20; ++k) { const int tt = t0 + k - 2, tc = tt < 0 ? 0 : (tt >= SEQ ? SEQ - 1 : tt);
            raw[k] = *(const u32x4*)(P + (size_t)(m0 - t0 + tc) * PW + PC_X + ch); }
        if (t0 == 0) { raw[0] = (u32x4){0u, 0u, 0u, 0u}; raw[1] = (u32x4){0u, 0u, 0u, 0u}; }
        if (t0 + 16 == SEQ) { raw[18] = (u32x4){0u, 0u, 0u, 0u}; raw[19] = (u32x4){0u, 0u, 0u, 0u}; }
        float win[5][8];
#pragma unroll
        for (int k = 0; k < 4; ++k) unpack8(raw[k], win[k + 1]);
#pragma unroll
        for (int r = 0; r < 16; ++r) {
#pragma unroll
            for (int k = 0; k < 4; ++k)
#pragma unroll
                for (int j = 0; j < 8; ++j) win[k][j] = win[k + 1][j];
            unpack8(raw[r + 4], win[4]);
            float o[8];
#pragma unroll
            for (int j = 0; j < 8; ++j) { float a = bias[j];
#pragma unroll
                for (int k = 0; k < 5; ++k) a += win[k][j] * w[k][j];
                o[j] = silu_f(a); }
            const u32x4 ov = pack8(o);
            if (ch < 2048) *(u32x4*)(XS + (size_t)(m0 + r) * DM + ch) = ov;
            else *(u32x4*)(BC + (size_t)(m0 + r) * 1024 + (ch - 2048)) = ov;
        }
    }
}
__device__ __forceinline__ void phase_qk_rope(Frame& F, int e) {
    bf16_t* P = (bf16_t*)(F.ws + WS_PROJ);
    const int gw = F.bid * 8 + F.wave, NGW = F.G * 8, lane = F.lane;
    const float gq0 = inp(I_QN)[e * 128 + 2 * lane], gq1 = inp(I_QN)[e * 128 + 2 * lane + 1];
    const float gk0 = inp(I_KN)[e * 128 + 2 * lane], gk1 = inp(I_KN)[e * 128 + 2 * lane + 1];
    const float invf = exp2f(-13.287712379549449f * (float)(lane & 31) * (1.0f / 32.0f));
    for (int m = gw; m < T; m += NGW) {
        const int t = m % SEQ; const float pos = (lane < 32) ? (float)(t >> 6) : (float)(t & 63);
        float sn, cs; sincosf(pos * invf, &sn, &cs);
        unsigned* row = (unsigned*)(P + (size_t)m * PW);
        unsigned wv[20];
#pragma unroll
        for (int hd = 0; hd < 20; ++hd) { const int col = (hd < 16) ? (PC_Q + hd * 128) : (PC_K + (hd - 16) * 128); wv[hd] = row[(col >> 1) + lane]; }
#pragma unroll
        for (int hd = 0; hd < 20; ++hd) {
            const int col = (hd < 16) ? (PC_Q + hd * 128) : (PC_K + (hd - 16) * 128);
            float x0 = bflo(wv[hd]), x1 = bfhi(wv[hd]);
            const float ss = wave_sum(x0 * x0 + x1 * x1);
            const float rstd = __builtin_amdgcn_rsqf(ss * (1.f / 128.f) + EPS);
            x0 *= rstd * (hd < 16 ? gq0 : gk0); x1 *= rstd * (hd < 16 ? gq1 : gk1);
            row[(col >> 1) + lane] = cvt_pk_bf16(x0 * cs - x1 * sn, x0 * sn + x1 * cs);
        }
    }
}
__device__ __forceinline__ void phase_ssd_gate_norm(Frame& F, int e) {
    bf16_t* P = (bf16_t*)(F.ws + WS_PROJ);
    const int gw = F.bid * 8 + F.wave, NGW = F.G * 8, lane = F.lane; const float* gain = inp(I_SNORM) + (size_t)e * DM;
    f32x4 gn[4][2];
#pragma unroll
    for (int j = 0; j < 4; ++j) { gn[j][0] = *(const f32x4*)(gain + j * 512 + lane * 8); gn[j][1] = *(const f32x4*)(gain + j * 512 + lane * 8 + 4); }
    for (int m = gw; m < T; m += 2 * NGW) {
        const int m1 = m + NGW; const bool has1 = m1 < T; const int mb = has1 ? m1 : m;
        u32x4 ya[4], za[4], yb[4], zb[4];
#pragma unroll
        for (int j = 0; j < 4; ++j) { const int c = j * 512 + lane * 8;
            ya[j] = *(const u32x4*)(P + (size_t)m * PW + PC_X + c); za[j] = *(const u32x4*)(P + (size_t)m * PW + PC_Z + c);
            yb[j] = *(const u32x4*)(P + (size_t)mb * PW + PC_X + c); zb[j] = *(const u32x4*)(P + (size_t)mb * PW + PC_Z + c); }
#pragma unroll
        for (int q = 0; q < 2; ++q) {
            if (q == 1 && !has1) break;
            bf16_t* row = P + (size_t)(q ? m1 : m) * PW; float v[4][8]; float s = 0.f;
#pragma unroll
            for (int j = 0; j < 4; ++j) { float y[8], z[8];
                unpack8(q ? yb[j] : ya[j], y); unpack8(q ? zb[j] : za[j], z);
#pragma unroll
                for (int i = 0; i < 8; ++i) { v[j][i] = y[i] * silu_f(z[i]); s += v[j][i] * v[j][i]; } }
            const float rstd = 1.0f / sqrtf(wave_sum(s) * (1.f / DM) + EPS);
#pragma unroll
            for (int j = 0; j < 4; ++j) { const int c = j * 512 + lane * 8; const f32x4 g0 = gn[j][0], g1 = gn[j][1];
                float o[8]; o[0] = v[j][0] * rstd * g0.x; o[1] = v[j][1] * rstd * g0.y; o[2] = v[j][2] * rstd * g0.z; o[3] = v[j][3] * rstd * g0.w;
                o[4] = v[j][4] * rstd * g1.x; o[5] = v[j][5] * rstd * g1.y; o[6] = v[j][6] * rstd * g1.z; o[7] = v[j][7] * rstd * g1.w;
                *(u32x4*)(row + PC_Z + c) = pack8(o); }
        }
    }
}

constexpr int TP = 136;
__device__ __forceinline__ bf16x8 frag16(const LAS unsigned char* tile, int row, int k0, int lane) { return *(const LAS bf16x8*)(tile + row * (TP * 2) + (k0 + 8 * (lane >> 4)) * 2); }
constexpr int SC_CSF = 0, SC_EB = 128, SC_DTF = 256, SC_DTB = 384, SC_RSF = 512, SC_RSB = 640, SC_EBT = 768, SC_WORDS = 772;
__device__ __forceinline__ void ssd_scans(Frame& F, LAS float* sc, const float* dt, int m0, int h, float a_f, float a_b) {
    const int tid = F.tid;
    if (tid < 128) sc[SC_DTF + tid] = dt[(size_t)(m0 + tid) * 64 + h];
    else if (tid < 256) sc[SC_DTB + tid - 128] = dt[(size_t)(m0 + tid - 128) * 64 + 32 + h];
    __syncthreads();
    if (F.wave < 2) {
        const int lane = F.lane; const bool fw = (F.wave == 0);
        const float a0 = sc[(fw ? SC_DTF : SC_DTB) + 2 * lane] * (fw ? a_f : a_b), a1 = sc[(fw ? SC_DTF : SC_DTB) + 2 * lane + 1] * (fw ? a_f : a_b);
        float p = a0 + a1;
#pragma unroll
        for (int o = 1; o < 64; o <<= 1) { const float tt = __shfl_up(p, o); if (lane >= o) p += tt; }
        const float ex = p - (a0 + a1);
        if (fw) { sc[SC_CSF + 2 * lane] = ex + a0; sc[SC_CSF + 2 * lane + 1] = p; }
        else { sc[SC_EB + 2 * lane] = ex; sc[SC_EB + 2 * lane + 1] = ex + a0; if (lane == 63) sc[SC_EBT] = p; }
    }
    __syncthreads();
}
__device__ __forceinline__ void ssd_scans_r(Frame& F, LAS float* sc, float dtv, float a_f, float a_b) {
    const int tid = F.tid;
    if (tid < 128) sc[SC_DTF + tid] = dtv;
    else if (tid < 256) sc[SC_DTB + tid - 128] = dtv;
    LDS_BARRIER();
    if (F.wave < 2) {
        const int lane = F.lane; const bool fw = (F.wave == 0);
        const float a0 = sc[(fw ? SC_DTF : SC_DTB) + 2 * lane] * (fw ? a_f : a_b), a1 = sc[(fw ? SC_DTF : SC_DTB) + 2 * lane + 1] * (fw ? a_f : a_b);
        float p = a0 + a1;
#pragma unroll
        for (int o = 1; o < 64; o <<= 1) { const float tt = __shfl_up(p, o); if (lane >= o) p += tt; }
        const float ex = p - (a0 + a1);
        if (fw) { sc[SC_CSF + 2 * lane] = ex + a0; sc[SC_CSF + 2 * lane + 1] = p; }
        else { sc[SC_EB + 2 * lane] = ex; sc[SC_EB + 2 * lane + 1] = ex + a0; if (lane == 63) sc[SC_EBT] = p; }
    }
    LDS_BARRIER();
}
__device__ __forceinline__ void phase_ssd_states(Frame& F, int e) {
    LAS unsigned char* BT = F.lds; LAS unsigned char* XF = F.lds + 34816; LAS unsigned char* XB = F.lds + 52224; LAS float* sc = (LAS float*)(F.lds + 69632);
    const bf16_t* XS = F.h; const bf16_t* BC = (const bf16_t*)(F.ws + WS_BC); const float* dt = (const float*)(F.ws + WS_DT);
    bf16_t* STF = (bf16_t*)(F.ws + WS_STF); bf16_t* STB = (bf16_t*)(F.ws + WS_STB); float* TOT = (float*)(F.ws + WS_TOT);
    const int tid = F.tid, lane = F.lane, wave = F.wave;
    for (int u = F.bid; u < NSEQ * NCH * SSG; u += F.G) {
        const int g = u % SSG, c = (u / SSG) % NCH, b = u / (SSG * NCH), m0 = b * SEQ + c * SSQ;
        { const int s = tid & 127, og = tid >> 7;
#pragma unroll
          for (int i = 0; i < 4; ++i) { const int n0 = (og * 4 + i) * 8; const u32x4 v = *(const u32x4*)(BC + (size_t)(m0 + s) * 1024 + g * 128 + n0);
              const unsigned ws_[4] = {v.x, v.y, v.z, v.w};
#pragma unroll
              for (int j = 0; j < 8; ++j) *(LAS bf16_t*)(BT + ((n0 + j) * TP + s) * 2) = (bf16_t)((j & 1) ? (ws_[j >> 1] >> 16) : (ws_[j >> 1] & 0xffffu)); } }
        const int ps_ = tid & 127, pog = tid >> 7;
        const float* dtp = dt + (size_t)(m0 + ps_) * 64 + (tid < 128 ? 0 : 32);
        const bf16_t* xp = XS + (size_t)(m0 + ps_) * DM + pog * 16;
        float dtn = dtp[g * 8]; u32x4 xn0 = *(const u32x4*)(xp + g * 512), xn1 = *(const u32x4*)(xp + g * 512 + 8);
        for (int h8 = 0; h8 < 8; ++h8) {
            const int h = g * 8 + h8;
            const float a_f = -__expf(inp(I_ALOG)[e * 64 + h]), a_b = -__expf(inp(I_ALOG)[e * 64 + 32 + h]);
            const float dtv = dtn; const u32x4 xv0 = xn0, xv1 = xn1;
            if (h8 < 7) { dtn = dtp[h + 1]; xn0 = *(const u32x4*)(xp + (h + 1) * 64); xn1 = *(const u32x4*)(xp + (h + 1) * 64 + 8); }
            ssd_scans_r(F, sc, dtv, a_f, a_b);
            { const int s = ps_, og = pog; const float csl = sc[SC_CSF + 127];
              const float wf = sc[SC_DTF + s] * __expf(csl - sc[SC_CSF + s]), wb = sc[SC_DTB + s] * __expf(sc[SC_EB + s]);
#pragma unroll
              for (int i = 0; i < 2; ++i) { const int p0 = (og * 2 + i) * 8; float v[8]; unpack8(i ? xv1 : xv0, v);
#pragma unroll
                  for (int j = 0; j < 8; ++j) { *(LAS bf16_t*)(XF + ((p0 + j) * TP + s) * 2) = f2bf(v[j] * wf); *(LAS bf16_t*)(XB + ((p0 + j) * TP + s) * 2) = f2bf(v[j] * wb); } } }
            LDS_BARRIER();
            { const LAS unsigned char* X = (wave < 4) ? XF : XB; const int nb = (wave & 3) * 32;
              f32x4 acc[4][2];
#pragma unroll
              for (int pt = 0; pt < 4; ++pt)
#pragma unroll
                  for (int nt = 0; nt < 2; ++nt) acc[pt][nt] = (f32x4){0.f, 0.f, 0.f, 0.f};
#pragma unroll
              for (int k0 = 0; k0 < 128; k0 += 32) { bf16x8 a[2], bb[4];
#pragma unroll
                  for (int nt = 0; nt < 2; ++nt) a[nt] = frag16(BT, nb + nt * 16 + (lane & 15), k0, lane);
#pragma unroll
                  for (int pt = 0; pt < 4; ++pt) bb[pt] = frag16(X, pt * 16 + (lane & 15), k0, lane);
#pragma unroll
                  for (int pt = 0; pt < 4; ++pt)
#pragma unroll
                      for (int nt = 0; nt < 2; ++nt) acc[pt][nt] = __builtin_amdgcn_mfma_f32_16x16x32_bf16(a[nt], bb[pt], acc[pt][nt], 0, 0, 0); }
              bf16_t* ST = ((wave < 4) ? STF : STB) + (size_t)((b * NCH + c) * SSH + h) * (SSP * SSN);
#pragma unroll
              for (int pt = 0; pt < 4; ++pt)
#pragma unroll
                  for (int nt = 0; nt < 2; ++nt) { const int p = pt * 16 + (lane & 15), n = nb + nt * 16 + (lane >> 4) * 4;
                      u32x2 w; w.x = cvt_pk_c(acc[pt][nt][0], acc[pt][nt][1]); w.y = cvt_pk_c(acc[pt][nt][2], acc[pt][nt][3]);
                      *(u32x2*)(ST + p * SSN + n) = w; } }
            if (tid == 0) { TOT[((b * NCH + c) * SSH + h) * 2] = sc[SC_CSF + 127]; TOT[((b * NCH + c) * SSH + h) * 2 + 1] = sc[SC_EBT]; }
            LDS_BARRIER();
        }
    }
}
__device__ __forceinline__ void phase_ssd_scan(Frame& F) {
    bf16_t* STF = (bf16_t*)(F.ws + WS_STF); bf16_t* STB = (bf16_t*)(F.ws + WS_STB); const float* TOT = (const float*)(F.ws + WS_TOT);
    const int nitem = NSEQ * SSH * 2 * 1024;
    for (int it = F.bid * 512 + F.tid; it < nitem; it += F.G * 512) {
        const int o8 = it & 1023, dir = (it >> 10) & 1, h = (it >> 11) % SSH, b = it / (2048 * SSH);
        bf16_t* base = (dir ? STB : STF) + (size_t)o8 * 8;
        float carry[8];
#pragma unroll
        for (int j = 0; j < 8; ++j) carry[j] = 0.f;
        for (int cc0 = 0; cc0 < NCH; cc0 += 8) {
            u32x4 sv[8]; float tv[8];
#pragma unroll
            for (int k = 0; k < 8; ++k) { const int c = dir ? (NCH - 1 - cc0 - k) : (cc0 + k); const size_t idx = (size_t)((b * NCH + c) * SSH + h);
                sv[k] = *(const u32x4*)(base + idx * (SSP * SSN)); tv[k] = TOT[idx * 2 + dir]; }
#pragma unroll
            for (int k = 0; k < 8; ++k) { const int c = dir ? (NCH - 1 - cc0 - k) : (cc0 + k); const size_t idx = (size_t)((b * NCH + c) * SSH + h);
                float s[8]; unpack8(sv[k], s);
                *(u32x4*)(base + idx * (SSP * SSN)) = pack8(carry);
                const float dec = __expf(tv[k]);
#pragma unroll
                for (int j = 0; j < 8; ++j) carry[j] = carry[j] * dec + s[j]; }
        }
    }
}
__device__ __forceinline__ void phase_ssd_out(Frame& F, int e) {
    LAS unsigned char* CM = F.lds; LAS unsigned char* BM = F.lds + 34816; LAS unsigned char* SF = F.lds + 69632; LAS unsigned char* SB = F.lds + 87040;
    LAS unsigned char* XT = F.lds + 104448; LAS unsigned char* WM = BM; LAS float* sc = (LAS float*)(F.lds + 121856);
    const bf16_t* XS = F.h; const bf16_t* BC = (const bf16_t*)(F.ws + WS_BC); const float* dt = (const float*)(F.ws + WS_DT);
    const bf16_t* STF = (const bf16_t*)(F.ws + WS_STF); const bf16_t* STB = (const bf16_t*)(F.ws + WS_STB); bf16_t* P = (bf16_t*)(F.ws + WS_PROJ);
    const int tid = F.tid, lane = F.lane, wave = F.wave;
    for (int u = F.bid; u < NSEQ * NCH * SSG; u += F.G) {
        const int g = u % SSG, c = (u / SSG) % NCH, b = u / (SSG * NCH), m0 = b * SEQ + c * SSQ;
        { const int r = tid >> 2, q = tid & 3;
#pragma unroll
          for (int i = 0; i < 4; ++i) { const int o = q * 4 + i;
              *(LAS u32x4*)(CM + r * (TP * 2) + o * 16) = *(const u32x4*)(BC + (size_t)(m0 + r) * 1024 + 512 + g * 128 + o * 8);
              *(LAS u32x4*)(BM + r * (TP * 2) + o * 16) = *(const u32x4*)(BC + (size_t)(m0 + r) * 1024 + g * 128 + o * 8); } }
        LDS_BARRIER();
        const int lb = (wave >> 1) * 32, sb = (wave & 1) * 64;
        f32x4 cb[2][4];
#pragma unroll
        for (int lt = 0; lt < 2; ++lt)
#pragma unroll
            for (int st = 0; st < 4; ++st) cb[lt][st] = (f32x4){0.f, 0.f, 0.f, 0.f};
#pragma unroll
        for (int k0 = 0; k0 < 128; k0 += 32) { bf16x8 a[4], bb[2];
#pragma unroll
            for (int st = 0; st < 4; ++st) a[st] = frag16(BM, sb + st * 16 + (lane & 15), k0, lane);
#pragma unroll
            for (int lt = 0; lt < 2; ++lt) bb[lt] = frag16(CM, lb + lt * 16 + (lane & 15), k0, lane);
#pragma unroll
            for (int lt = 0; lt < 2; ++lt)
#pragma unroll
                for (int st = 0; st < 4; ++st) cb[lt][st] = __builtin_amdgcn_mfma_f32_16x16x32_bf16(a[st], bb[lt], cb[lt][st], 0, 0, 0); }
        const int ps_ = tid & 127, pog = tid >> 7;
        const float* dtp = dt + (size_t)(m0 + ps_) * 64 + (tid < 128 ? 0 : 32);
        const bf16_t* xp = XS + (size_t)(m0 + ps_) * DM + pog * 16;
        const size_t sb0 = (size_t)((b * NCH + c) * SSH) * (SSP * SSN) + (size_t)tid * 8;
        float dtn = dtp[g * 8]; u32x4 xn0 = *(const u32x4*)(xp + g * 512), xn1 = *(const u32x4*)(xp + g * 512 + 8);
        u32x4 fn0 = *(const u32x4*)(STF + sb0 + (size_t)(g * 8) * 8192), fn1 = *(const u32x4*)(STF + sb0 + (size_t)(g * 8) * 8192 + 4096);
        u32x4 bn0 = *(const u32x4*)(STB + sb0 + (size_t)(g * 8) * 8192), bn1 = *(const u32x4*)(STB + sb0 + (size_t)(g * 8) * 8192 + 4096);
        for (int h8 = 0; h8 < 8; ++h8) {
            const int h = g * 8 + h8;
            const float a_f = -__expf(inp(I_ALOG)[e * 64 + h]), a_b = -__expf(inp(I_ALOG)[e * 64 + 32 + h]), dsk = inp(I_SD)[e * 32 + h];
            const float dtv = dtn;
            {
#pragma unroll
              for (int i = 0; i < 2; ++i) { const int idx = tid + 512 * i, p = idx >> 4, o = idx & 15;
                  *(LAS u32x4*)(SF + p * (TP * 2) + o * 16) = i ? fn1 : fn0; *(LAS u32x4*)(SB + p * (TP * 2) + o * 16) = i ? bn1 : bn0; }
#pragma unroll
              for (int i = 0; i < 2; ++i) { const int p0 = (pog * 2 + i) * 8; const u32x4 v = i ? xn1 : xn0;
                  const unsigned ws_[4] = {v.x, v.y, v.z, v.w};
#pragma unroll
                  for (int j = 0; j < 8; ++j) *(LAS bf16_t*)(XT + ((p0 + j) * TP + ps_) * 2) = (bf16_t)((j & 1) ? (ws_[j >> 1] >> 16) : (ws_[j >> 1] & 0xffffu)); } }
            if (h8 < 7) { dtn = dtp[h + 1]; xn0 = *(const u32x4*)(xp + (h + 1) * 64); xn1 = *(const u32x4*)(xp + (h + 1) * 64 + 8);
                fn0 = *(const u32x4*)(STF + sb0 + (size_t)(h + 1) * 8192); fn1 = *(const u32x4*)(STF + sb0 + (size_t)(h + 1) * 8192 + 4096);
                bn0 = *(const u32x4*)(STB + sb0 + (size_t)(h + 1) * 8192); bn1 = *(const u32x4*)(STB + sb0 + (size_t)(h + 1) * 8192 + 4096); }
            ssd_scans_r(F, sc, dtv, a_f, a_b);
            if (tid < 128) { sc[SC_RSF + tid] = __expf(sc[SC_CSF + tid]); sc[SC_RSB + tid] = __expf(sc[SC_EBT] - sc[SC_EB + tid]); }
#pragma unroll
            for (int lt = 0; lt < 2; ++lt) { const int l = lb + lt * 16 + (lane & 15); const float csl = sc[SC_CSF + l], ebl = sc[SC_EB + l];
#pragma unroll
                for (int st = 0; st < 4; ++st) { const int s0 = sb + st * 16 + (lane >> 4) * 4; float w[4];
                    const int dtile = ((sb >> 4) + st) - ((lb >> 4) + lt);
                    if (dtile < 0) { const f32x4 cs4 = *(const LAS f32x4*)(sc + SC_CSF + s0), d4 = *(const LAS f32x4*)(sc + SC_DTF + s0);
#pragma unroll
                        for (int j = 0; j < 4; ++j) w[j] = cb[lt][st][j] * (__expf(csl - cs4[j]) * d4[j]); }
                    else if (dtile > 0) { const f32x4 eb4 = *(const LAS f32x4*)(sc + SC_EB + s0), d4 = *(const LAS f32x4*)(sc + SC_DTB + s0);
#pragma unroll
                        for (int j = 0; j < 4; ++j) w[j] = cb[lt][st][j] * (__expf(eb4[j] - ebl) * d4[j]); }
                    else { const f32x4 cs4 = *(const LAS f32x4*)(sc + SC_CSF + s0), df4 = *(const LAS f32x4*)(sc + SC_DTF + s0), eb4 = *(const LAS f32x4*)(sc + SC_EB + s0), db4 = *(const LAS f32x4*)(sc + SC_DTB + s0);
#pragma unroll
                        for (int j = 0; j < 4; ++j) { const int s = s0 + j; float mk = 0.f;
                            if (s <= l) mk += __expf(csl - cs4[j]) * df4[j];
                            if (s >= l) mk += __expf(eb4[j] - ebl) * db4[j];
                            w[j] = cb[lt][st][j] * mk + (s == l ? dsk : 0.f); } }
                    u32x2 pk; pk.x = cvt_pk_c(w[0], w[1]); pk.y = cvt_pk_c(w[2], w[3]);
                    *(LAS u32x2*)(WM + (l * TP + s0) * 2) = pk; } }
            LDS_BARRIER();
            { f32x4 aD[4], aF[4], aB[4];
#pragma unroll
              for (int pt = 0; pt < 4; ++pt) { aD[pt] = (f32x4){0.f, 0.f, 0.f, 0.f}; aF[pt] = aD[pt]; aB[pt] = aD[pt]; }
              const int l = wave * 16 + (lane & 15);
#pragma unroll
              for (int k0 = 0; k0 < 128; k0 += 32) { const bf16x8 wv = frag16(WM, l, k0, lane), cv = frag16(CM, l, k0, lane);
#pragma unroll
                  for (int pt = 0; pt < 4; ++pt) { const int pr = pt * 16 + (lane & 15);
                      aD[pt] = __builtin_amdgcn_mfma_f32_16x16x32_bf16(frag16(XT, pr, k0, lane), wv, aD[pt], 0, 0, 0);
                      aF[pt] = __builtin_amdgcn_mfma_f32_16x16x32_bf16(frag16(SF, pr, k0, lane), cv, aF[pt], 0, 0, 0);
                      aB[pt] = __builtin_amdgcn_mfma_f32_16x16x32_bf16(frag16(SB, pr, k0, lane), cv, aB[pt], 0, 0, 0); } }
              const float rsf = sc[SC_RSF + l], rsb = sc[SC_RSB + l];
              bf16_t* yrow = P + (size_t)(m0 + l) * PW + PC_X + h * 64;
#pragma unroll
              for (int pt = 0; pt < 4; ++pt) { const f32x4 y = aD[pt] + aF[pt] * rsf + aB[pt] * rsb; const int p = pt * 16 + (lane >> 4) * 4;
                  u32x2 pk; pk.x = cvt_pk_c(y[0], y[1]); pk.y = cvt_pk_c(y[2], y[3]); *(u32x2*)(yrow + p) = pk; } }
            LDS_BARRIER();
        }
    }
}
namespace att {
constexpr int D = 128, NW = 8, QBLK = 32, KVBLK = 64;
constexpr float SCALE = 0.088388347648318440f;
constexpr float THR = 8.f;
constexpr int LDQ = PW, LDK = PW, LDO = PW;
constexpr size_t SHM_V = KVBLK * D * 2, SHM_K = KVBLK * D * 2, SHM_ATTN = 3 * SHM_V + 2 * SHM_K + NW * 64 * 4;
#define KSWZ(row, colB) ((row) * 256 + ((colB) ^ (((row) & 7) << 4)))
#define SBAR() __builtin_amdgcn_sched_barrier(0)
__device__ __forceinline__ int crow(int r, int hi) { return (r & 3) + 8 * (r >> 2) + 4 * hi; }
__device__ __forceinline__ void partialSM(f32x16& p0, f32x16& p1, float& m_reg, float& mn, float& alpha) {
  constexpr float C = SCALE * 1.4426950408889634f;
  float pmax = p0[0]; for (int r = 1; r < 16; ++r) pmax = fmaxf(pmax, p0[r]); for (int r = 0; r < 16; ++r) pmax = fmaxf(pmax, p1[r]);
  { auto rr = __builtin_amdgcn_permlane32_swap(__float_as_uint(pmax), __float_as_uint(pmax), false, false);
    pmax = fmaxf(__uint_as_float(rr[0]), __uint_as_float(rr[1])); }
  if (__builtin_expect(__all(pmax - m_reg <= THR / SCALE), 1)) { mn = m_reg; alpha = 1.f; }
  else { mn = fmaxf(m_reg, pmax); alpha = __builtin_amdgcn_exp2f((m_reg - mn) * C); m_reg = mn; }
  float mnC = -mn * C;
  for (int r = 0; r < 16; ++r) p0[r] = fmaf(p0[r], C, mnC); for (int r = 0; r < 16; ++r) p1[r] = fmaf(p1[r], C, mnC);
  for (int r = 0; r < 16; ++r) p0[r] = __builtin_amdgcn_exp2f(p0[r]);
}
__device__ __forceinline__ void finishSM(f32x16& p0, f32x16& p1, float alpha, float& l_reg, bf16x8& pa0, bf16x8& pa1, bf16x8& pa2, bf16x8& pa3) {
  for (int r = 0; r < 16; ++r) p1[r] = __builtin_amdgcn_exp2f(p1[r]);
  float ps = 0; for (int r = 0; r < 16; ++r) ps += p0[r]; for (int r = 0; r < 16; ++r) ps += p1[r];
  { auto rr = __builtin_amdgcn_permlane32_swap(__float_as_uint(ps), __float_as_uint(ps), false, false);
    ps = __uint_as_float(rr[0]) + __uint_as_float(rr[1]); }
  l_reg = l_reg * alpha + ps;
#define PK4(P, BASE, OUT) do { unsigned a0 = cvt_pk_bf16(P[BASE + 0], P[BASE + 1]), a1 = cvt_pk_bf16(P[BASE + 2], P[BASE + 3]);   \
    unsigned b0 = cvt_pk_bf16(P[BASE + 4], P[BASE + 5]), b1 = cvt_pk_bf16(P[BASE + 6], P[BASE + 7]);                              \
    auto r0 = __builtin_amdgcn_permlane32_swap(a0, b0, false, false); auto r1 = __builtin_amdgcn_permlane32_swap(a1, b1, false, false); \
    u32x4 w = {r0[0], r1[0], r0[1], r1[1]}; OUT = *reinterpret_cast<bf16x8*>(&w); } while (0)
  PK4(p0, 0, pa0); PK4(p0, 8, pa1); PK4(p1, 0, pa2); PK4(p1, 8, pa3);
#undef PK4
}
__device__ __forceinline__ void qkt(f32x16& p0, f32x16& p1, const bf16_t* Ks, const bf16x8* qr, int r32, int hi) {
  p0 = f32x16{}; p1 = f32x16{};
  for (int d0 = 0; d0 < 8; ++d0) { int cb = (d0 * 16 + hi * 8) * 2;
    bf16x8 b0 = *reinterpret_cast<const bf16x8*>((const char*)Ks + KSWZ(r32, cb));
    bf16x8 b1 = *reinterpret_cast<const bf16x8*>((const char*)Ks + KSWZ(32 + r32, cb));
    p0 = __builtin_amdgcn_mfma_f32_32x32x16_bf16(b0, qr[d0], p0, 0, 0, 0);
    p1 = __builtin_amdgcn_mfma_f32_32x32x16_bf16(b1, qr[d0], p1, 0, 0, 0); }
}
__device__ __forceinline__ int v_st(int k, int c) { const int kk = (k & ~0xC) | ((k & 4) << 1) | ((k & 8) >> 1); return ((kk >> 3) * 4 + (c >> 5)) * 512 + ((kk & 7) * 32 + (c & 31)) * 2; }
__device__ __forceinline__ int v_rd_base(int lane) { return ((lane & 3) << 3) | (((lane >> 2) & 3) << 6) | (((lane >> 4) & 1) << 5) | (((lane >> 5) & 1) << 8); }
constexpr int v_rd_off(int d0, int ks, int half) { return d0 * 512 + ks * 4096 + half * 2048; }
template <int OFF> __device__ __forceinline__ s16x4 tr_read(int vb) {
  s16x4 r; asm volatile("ds_read_b64_tr_b16 %0, %1 offset:%2" : "=&v"(r) : "v"(vb), "i"(OFF) : "memory"); return r;
}
struct VFrag { s16x4 l0, h0, l1, h1, l2, h2, l3, h3; };
template <int D0> __device__ __forceinline__ void v_reads(VFrag& f, int vb) {
  f.l0 = tr_read<v_rd_off(D0, 0, 0)>(vb); f.h0 = tr_read<v_rd_off(D0, 0, 1)>(vb); f.l1 = tr_read<v_rd_off(D0, 1, 0)>(vb); f.h1 = tr_read<v_rd_off(D0, 1, 1)>(vb);
  f.l2 = tr_read<v_rd_off(D0, 2, 0)>(vb); f.h2 = tr_read<v_rd_off(D0, 2, 1)>(vb); f.l3 = tr_read<v_rd_off(D0, 3, 0)>(vb); f.h3 = tr_read<v_rd_off(D0, 3, 1)>(vb);
}
__device__ __forceinline__ void pv_mma(f32x16& od, const VFrag& f, bf16x8 pa0, bf16x8 pa1, bf16x8 pa2, bf16x8 pa3) {
#define PK(L, H) (bf16x8){L[0], L[1], L[2], L[3], H[0], H[1], H[2], H[3]}
  od = __builtin_amdgcn_mfma_f32_32x32x16_bf16(pa0, PK(f.l0, f.h0), od, 0, 0, 0);
  od = __builtin_amdgcn_mfma_f32_32x32x16_bf16(pa1, PK(f.l1, f.h1), od, 0, 0, 0);
  od = __builtin_amdgcn_mfma_f32_32x32x16_bf16(pa2, PK(f.l2, f.h2), od, 0, 0, 0);
  od = __builtin_amdgcn_mfma_f32_32x32x16_bf16(pa3, PK(f.l3, f.h3), od, 0, 0, 0);
#undef PK
}
__device__ __forceinline__ void pv_d0(f32x16* o, int vb, bf16x8 pa0, bf16x8 pa1, bf16x8 pa2, bf16x8 pa3) {
  VFrag A, B;
  v_reads<0>(A, vb); v_reads<1>(B, vb);
  asm volatile("s_waitcnt lgkmcnt(8)" ::: "memory"); SBAR(); pv_mma(o[0], A, pa0, pa1, pa2, pa3); SBAR();
  v_reads<2>(A, vb);
  asm volatile("s_waitcnt lgkmcnt(8)" ::: "memory"); SBAR(); pv_mma(o[1], B, pa0, pa1, pa2, pa3); SBAR();
  v_reads<3>(B, vb);
  asm volatile("s_waitcnt lgkmcnt(8)" ::: "memory"); SBAR(); pv_mma(o[2], A, pa0, pa1, pa2, pa3);
  asm volatile("s_waitcnt lgkmcnt(0)" ::: "memory"); SBAR(); pv_mma(o[3], B, pa0, pa1, pa2, pa3);
}
__device__ __forceinline__ void attn_dense_body(const bf16_t* Qb, const bf16_t* Kh, const bf16_t* Vh,
                                                bf16_t* Ob, int seq, LAS unsigned char* ldsl) {
#if MK_FUSED
  int tid_ = threadIdx.x; asm volatile("" : "+v"(tid_)); const int tid = tid_ & 511;
#else
  const int tid = threadIdx.x;
#endif
  char* lds = (char*)ldsl;
  const int wid = tid >> 6, lane = tid & 63, r32 = lane & 31, hi = lane >> 5, widu = __builtin_amdgcn_readfirstlane(wid);
  bf16_t* V_lds = (bf16_t*)lds; bf16_t* K_lds = (bf16_t*)(lds + 3 * SHM_V);
  float* ws = (float*)(lds + 3 * SHM_V + 2 * SHM_K) + wid * 64; float* li_l = ws; float* al_l = ws + 32;
  float m_reg = -1e30f, l_reg = 0; f32x16 o[4] = {}; bf16x8 qr[8];
  const bf16_t* Qw = Qb + (long)(wid * QBLK + r32) * LDQ + hi * 8;
#pragma unroll
  for (int d0 = 0; d0 < 8; ++d0) qr[d0] = *reinterpret_cast<const bf16x8*>(Qw + d0 * 16);
  const int vb0 = (int)(uintptr_t)V_lds + v_rd_base(lane);
  unsigned kof[2], vof[2];
#pragma unroll
  for (int i = 0; i < 2; ++i) { const int sl = i * 512 + tid, row = sl >> 4, ch = (sl & 15) ^ (row & 7);
    kof[i] = (unsigned)(row * LDK + ch * 8) * 2u;
    const int kk = ((sl >> 7) << 3) | ((sl & 31) >> 2), k = (kk & ~0xC) | ((kk & 4) << 1) | ((kk & 8) >> 1), c = ((sl >> 5) & 3) * 32 + (sl & 3) * 8;
    vof[i] = (unsigned)(k * LDK + c) * 2u; }
  const unsigned ldsw = (unsigned)widu * 1024u;
#define ADMA(t, kb, voff) do { const char* kp_ = (const char*)(Kh + (long)(t) * KVBLK * LDK); const char* vp_ = (const char*)(Vh + (long)(t) * KVBLK * LDK); \
    _Pragma("unroll") for (int i_ = 0; i_ < 2; ++i_) { \
      __builtin_amdgcn_global_load_lds((const unsigned*)(kp_ + kof[i_]), (LAS unsigned*)(ldsl + 3 * SHM_V + (kb) * SHM_K + ldsw + i_ * 8192), 16, 0, 0); \
      __builtin_amdgcn_global_load_lds((const unsigned*)(vp_ + vof[i_]), (LAS unsigned*)(ldsl + (voff) + ldsw + i_ * 8192), 16, 0, 0); } } while (0)
#define AWAIT() asm volatile("s_waitcnt vmcnt(0)" ::: "memory")
#define RESC(a) do { if (__any((a) < 1.f)) { if (hi == 0) al_l[r32] = (a); asm volatile("s_waitcnt lgkmcnt(0)" ::: "memory"); \
    for (int d = 0; d < 4; ++d) for (int r = 0; r < 16; ++r) o[d][r] *= al_l[crow(r, hi)]; } } while (0)
  f32x16 pA0, pA1, pB0, pB1; float mnA, mnB, alA, alB; bf16x8 pa0, pa1, pa2, pa3; const int NT = seq / KVBLK;
  int va = 0, vb = (int)SHM_V, vc = 2 * (int)SHM_V;
  ADMA(0, 0, 0); AWAIT(); __syncthreads();
  ADMA(1, 1, (unsigned)SHM_V);
  qkt(pA0, pA1, K_lds, qr, r32, hi); partialSM(pA0, pA1, m_reg, mnA, alA);
  AWAIT();
  for (int t = 1; t + 1 < NT; t += 2) {
    __syncthreads();
    ADMA(t + 1, 0, (unsigned)vc);
    SBAR(); qkt(pB0, pB1, (bf16_t*)((char*)K_lds + SHM_K), qr, r32, hi);
    finishSM(pA0, pA1, alA, l_reg, pa0, pa1, pa2, pa3); SBAR();
    pv_d0(o, vb0 + va, pa0, pa1, pa2, pa3); partialSM(pB0, pB1, m_reg, mnB, alB);
    RESC(alB);
    AWAIT();
    { const int t_ = va; va = vb; vb = vc; vc = t_; }
    __syncthreads();
    if (t + 2 < NT) ADMA(t + 2, 1, (unsigned)vc);
    SBAR(); qkt(pA0, pA1, K_lds, qr, r32, hi);
    finishSM(pB0, pB1, alB, l_reg, pa0, pa1, pa2, pa3); SBAR();
    pv_d0(o, vb0 + va, pa0, pa1, pa2, pa3); partialSM(pA0, pA1, m_reg, mnA, alA);
    RESC(alA);
    AWAIT();
    { const int t_ = va; va = vb; vb = vc; vc = t_; }
  }
  __syncthreads();
  SBAR(); qkt(pB0, pB1, (bf16_t*)((char*)K_lds + SHM_K), qr, r32, hi);
  finishSM(pA0, pA1, alA, l_reg, pa0, pa1, pa2, pa3); SBAR();
  pv_d0(o, vb0 + va, pa0, pa1, pa2, pa3); partialSM(pB0, pB1, m_reg, mnB, alB);
  RESC(alB);
  finishSM(pB0, pB1, alB, l_reg, pa0, pa1, pa2, pa3); SBAR();
  pv_d0(o, vb0 + vb, pa0, pa1, pa2, pa3);
  if (hi == 0) li_l[r32] = l_reg; asm volatile("s_waitcnt lgkmcnt(0)" ::: "memory");
  float rli[16];
#pragma unroll
  for (int r = 0; r < 16; ++r) rli[r] = __builtin_amdgcn_rcpf(li_l[crow(r, hi)]);
  bf16_t* Ow = Ob + (long)(wid * QBLK) * LDO;
#pragma unroll
  for (int r = 0; r < 16; r += 2) {
    const int odd = lane & 1, orow = crow(r + odd, hi);
    for (int d0 = 0; d0 < 4; ++d0) { const float a = o[d0][r] * rli[r], b = o[d0][r + 1] * rli[r + 1];
      const float recv = __shfl_xor(odd ? a : b, 1);
      *(unsigned*)(Ow + (long)orow * LDO + d0 * 32 + (r32 & ~1)) = odd ? cvt_pk_c(recv, b) : cvt_pk_c(a, recv); } }
#undef ADMA
#undef AWAIT
#undef RESC
}
#undef KSWZ
#undef SBAR
}

__device__ __forceinline__ void phase_attention(Frame& F) {
    bf16_t* P = (bf16_t*)(F.ws + WS_PROJ);
    const int vcu = (F.G % 8 == 0) ? (F.bid % 8) * (F.G / 8) + F.bid / 8 : F.bid;
    for (int u = vcu; u < NSEQ * AH * (SEQ / 256); u += F.G) {
        const int qb = u % (SEQ / 256), h = (u / (SEQ / 256)) % AH, b = u / ((SEQ / 256) * AH), kvh = h / (AH / AKV);
        bf16_t* Qb = P + (size_t)(b * SEQ + qb * 256) * PW + PC_Q + h * AD;
        const bf16_t* Kh = P + (size_t)(b * SEQ) * PW + PC_K + kvh * AD; const bf16_t* Vh = P + (size_t)(b * SEQ) * PW + PC_V + kvh * AD;
        att::attn_dense_body(Qb, Kh, Vh, Qb, SEQ, F.lds);
        __syncthreads();
    }
}
__device__ __forceinline__ void phase_xa_softmax(Frame& F) {
    const float* SC = (const float*)(F.ws + WS_SC); bf16_t* Pm = (bf16_t*)(F.ws + WS_P);
    const int gw = F.bid * 8 + F.wave, NGW = F.G * 8, lane = F.lane;
    for (int m = gw; m < T; m += NGW) {
#pragma unroll
        for (int hh = 0; hh < XAH; ++hh) {
            const f32x4 s = *(const f32x4*)(SC + (size_t)m * 1024 + hh * 256 + lane * 4);
            const float mx = wave_max(fmaxf(fmaxf(s.x, s.y), fmaxf(s.z, s.w)));
            const float e0 = __expf(s.x - mx), e1 = __expf(s.y - mx), e2 = __expf(s.z - mx), e3 = __expf(s.w - mx);
            const float inv = 1.0f / wave_sum((e0 + e1) + (e2 + e3));
            u32x2 w; w.x = cvt_pk_bf16(e0 * inv, e1 * inv); w.y = cvt_pk_bf16(e2 * inv, e3 * inv);
            *(u32x2*)(Pm + (size_t)m * 1024 + hh * 256 + lane * 4) = w;
        }
    }
}
__device__ __forceinline__ void phase_ffn_fix(Frame& F, int layer) {
    const bf16_t* SB = (const bf16_t*)(F.ws + WS_SB); bf16_t* ACT = (bf16_t*)(F.ws + WS_ACT);
    const float* cw = inp(I_FCW) + (size_t)layer * 3 * F2; const float* cb = inp(I_FCB) + (size_t)layer * F2;
    const int nitem = (T / 64) * 2 * (DFF / 8);
    for (int it = F.bid * 512 + F.tid; it < nitem; it += F.G * 512) {
        const int oc = it % (DFF / 8), rest = it / (DFF / 8), which = rest & 1, blk = rest >> 1, f = oc * 8, bs = blk % (SEQ / 64);
        const bf16_t* pp = which ? SB + ((size_t)blk * 4 + 2) * F2 : SB + ((size_t)(blk - 1) * 4 + 3) * F2;
        const bf16_t* ps = which ? SB + ((size_t)blk * 4 + 3) * F2 : SB + ((size_t)blk * 4 + 0) * F2;
        const bf16_t* pn = which ? SB + ((size_t)(blk + 1) * 4 + 0) * F2 : SB + ((size_t)blk * 4 + 1) * F2;
        const bool hasp = which ? true : (bs != 0), hasn = which ? (bs != SEQ / 64 - 1) : true;
        float gp[8], gq[8], gn[8], up[8], uq[8], un[8];
        unpack8(*(const u32x4*)(ps + f), gq); unpack8(*(const u32x4*)(ps + DFF + f), uq);
        if (hasp) { unpack8(*(const u32x4*)(pp + f), gp); unpack8(*(const u32x4*)(pp + DFF + f), up); }
        else {
#pragma unroll
            for (int j = 0; j < 8; ++j) { gp[j] = 0.f; up[j] = 0.f; } }
        if (hasn) { unpack8(*(const u32x4*)(pn + f), gn); unpack8(*(const u32x4*)(pn + DFF + f), un); }
        else {
#pragma unroll
            for (int j = 0; j < 8; ++j) { gn[j] = 0.f; un[j] = 0.f; } }
        float o[8];
#pragma unroll
        for (int j = 0; j < 8; ++j) {
            const float G = cb[f + j] + cw[f + j] * gp[j] + cw[F2 + f + j] * gq[j] + cw[2 * F2 + f + j] * gn[j];
            const float U = cb[DFF + f + j] + cw[DFF + f + j] * up[j] + cw[F2 + DFF + f + j] * uq[j] + cw[2 * F2 + DFF + f + j] * un[j];
            o[j] = silu_f(G) * U; }
        *(u32x4*)(ACT + (size_t)(blk * 64 + (which ? 63 : 0)) * DFF + f) = pack8(o);
    }
}

__device__ __forceinline__ void phase_hy_kern(Frame& F, int e) {
    const float* h3 = (const float*)(F.ws + WS_H3); float* KERN = (float*)(F.ws + WS_KERN); const float* wo = inp(I_FWO) + (size_t)e * 64 * 4096;
    typedef float f32x16c __attribute__((ext_vector_type(16)));
    const f32x16c __attribute__((address_space(4)))* wo16 = (const f32x16c __attribute__((address_space(4)))*)(uintptr_t)wo;
    LAS f32x4* hl = (LAS f32x4*)F.lds;
    for (int u = F.bid; u < 16 * 32; u += F.G) {
        const int tb = u & 15, cbk = u >> 4, t = tb * 512 + F.tid;
#pragma unroll
        for (int j = 0; j < 16; ++j) hl[j * 512 + F.tid] = *(const f32x4*)(h3 + (size_t)t * 64 + j * 4);
        const float tl = (float)t / (float)(SEQ - 1);
#pragma unroll 1
        for (int cb16 = 0; cb16 < 8; ++cb16) {
            const int c2b = __builtin_amdgcn_readfirstlane(cbk * 128 + cb16 * 16);
            float a[16];
#pragma unroll
            for (int i = 0; i < 16; ++i) a[i] = 0.f;
#pragma unroll 1
            for (int j4 = 0; j4 < 16; ++j4) {
                const f32x4 h = hl[j4 * 512 + F.tid];
#pragma unroll
                for (int q = 0; q < 4; ++q) { const f32x16c w16 = wo16[((j4 * 4 + q) * 4096 + c2b) >> 4];
#pragma unroll
                    for (int i = 0; i < 16; ++i) a[i] += h[q] * w16[i]; }
            }
#pragma unroll
            for (int i = 0; i < 16; ++i) {
                const int c2 = c2b + i, ch = c2 & (DM - 1);
                const float delta = fabsf(-3.0701134573253944f + (float)ch * ((-15.350567286626972f + 3.0701134573253944f) / (float)(DM - 1)));
                const float val = a[i] * __expf(-tl * delta);
                if (c2 < DM) KERN[(size_t)ch * FFTN + t] = val;
                else { if (t >= 1) KERN[(size_t)ch * FFTN + FFTN - t] = val; else KERN[(size_t)ch * FFTN + SEQ] = 0.f; }
            }
        }
    }
}
__device__ __forceinline__ void phase_hy_tout(Frame& F, int e) {
    const bf16_t* PHT = (const bf16_t*)(F.ws + WS_PHY); const bf16_t* UT = (const bf16_t*)(F.ws + WS_UT); bf16_t* Y = F.h;
    const float* cw = inp(I_HCW) + (size_t)e * 3 * HYW; const float* cb = inp(I_HCB) + (size_t)e * HYW;
    LAS bf16_t* tile = (LAS bf16_t*)(F.lds + F.wave * (64 * 72 * 2));
    const int gw = F.bid * 8 + F.wave, NGW = F.G * 8, lane = F.lane;
    for (int it = gw; it < (T / 64) * (DM / 64); it += NGW) {
        const int cblk = it % (DM / 64), tblk = it / (DM / 64), m0 = tblk * 64, t0 = m0 % SEQ, b = m0 / SEQ, c0 = cblk * 64;
        u32x4 xw[8], yw[8]; unsigned xl[8], xh[8];
#pragma unroll
        for (int ps = 0; ps < 8; ++ps) { const int c = (lane >> 3) + 8 * ps, to = (lane & 7) * 8, ch = c0 + c, t = t0 + to;
            const bf16_t* xr = PHT + (size_t)ch * T + (size_t)b * SEQ + t;
            xw[ps] = *(const u32x4*)xr; yw[ps] = *(const u32x4*)(UT + ((size_t)(b * DM + ch)) * SEQ + t);
            xl[ps] = t > 0 ? (unsigned)xr[-1] : 0u; xh[ps] = t + 8 < SEQ ? (unsigned)xr[8] : 0u; }
#pragma unroll
        for (int ps = 0; ps < 8; ++ps) {
            const int c = (lane >> 3) + 8 * ps, to = (lane & 7) * 8, ch = c0 + c;
            float x[10], y[8];
            unpack8(xw[ps], *(float (*)[8])&x[1]); unpack8(yw[ps], y);
            x[0] = bf2f(xl[ps]); x[9] = bf2f(xh[ps]);
            const float w0 = cw[ch], w1 = cw[HYW + ch], w2 = cw[2 * HYW + ch], bb = cb[ch];
            float ov[8];
#pragma unroll
            for (int j = 0; j < 8; ++j) ov[j] = (bb + w0 * x[j] + w1 * x[j + 1] + w2 * x[j + 2]) * y[j];
            *(LAS u32x4*)(tile + c * 72 + to) = pack8(ov);
        }
        LDS_WAIT(); asm volatile("" ::: "memory");
        const int o = lane & 7, rs = lane >> 3;
        for (int ps = 0; ps < 8; ++ps) {
            const int r = rs + 8 * ps; unsigned short v[8];
#pragma unroll
            for (int j = 0; j < 8; ++j) v[j] = tile[(o * 8 + j) * 72 + r];
            u32x4 w; w.x = v[0] | ((unsigned)v[1] << 16); w.y = v[2] | ((unsigned)v[3] << 16); w.z = v[4] | ((unsigned)v[5] << 16); w.w = v[6] | ((unsigned)v[7] << 16);
            *(u32x4*)(Y + (size_t)(m0 + r) * DM + c0 + o * 8) = w;
        }
        LDS_WAIT(); asm volatile("" ::: "memory");
    }
}
__device__ __forceinline__ f32x2 mk2(float a, float b) { f32x2 r; r.x = a; r.y = b; return r; }
__device__ __forceinline__ void dft16(f32x2 (&x)[16]) {
  f32x2 a[4][4];
  { const f32x2 s0 = x[0] + x[8], s1 = x[0] - x[8], s2 = x[4] + x[12], t3 = x[4] - x[12]; const f32x2 s3 = mk2(t3.y, -t3.x);
    a[0][0] = s0 + s2; a[0][1] = s1 + s3; a[0][2] = s0 - s2; a[0][3] = s1 - s3; }
  { const f32x2 s0 = x[1] + x[9], s1 = x[1] - x[9], s2 = x[5] + x[13], t3 = x[5] - x[13]; const f32x2 s3 = mk2(t3.y, -t3.x);
    a[1][0] = s0 + s2; a[1][1] = s1 + s3; a[1][2] = s0 - s2; a[1][3] = s1 - s3; }
  { const f32x2 s0 = x[2] + x[10], s1 = x[2] - x[10], s2 = x[6] + x[14], t3 = x[6] - x[14]; const f32x2 s3 = mk2(t3.y, -t3.x);
    a[2][0] = s0 + s2; a[2][1] = s1 + s3; a[2][2] = s0 - s2; a[2][3] = s1 - s3; }
  { const f32x2 s0 = x[3] + x[11], s1 = x[3] - x[11], s2 = x[7] + x[15], t3 = x[7] - x[15]; const f32x2 s3 = mk2(t3.y, -t3.x);
    a[3][0] = s0 + s2; a[3][1] = s1 + s3; a[3][2] = s0 - s2; a[3][3] = s1 - s3; }
  a[1][1] = mk2(a[1][1].x * 0.9238795325112867f - a[1][1].y * -0.3826834323650898f, a[1][1].x * -0.3826834323650898f + a[1][1].y * 0.9238795325112867f);
  a[1][2] = mk2(a[1][2].x * 0.7071067811865476f - a[1][2].y * -0.7071067811865475f, a[1][2].x * -0.7071067811865475f + a[1][2].y * 0.7071067811865476f);
  a[1][3] = mk2(a[1][3].x * 0.38268343236508984f - a[1][3].y * -0.9238795325112867f, a[1][3].x * -0.9238795325112867f + a[1][3].y * 0.38268343236508984f);
  a[2][1] = mk2(a[2][1].x * 0.7071067811865476f - a[2][1].y * -0.7071067811865475f, a[2][1].x * -0.7071067811865475f + a[2][1].y * 0.7071067811865476f);
  a[2][2] = mk2(a[2][2].x * 6.123233995736766e-17f - a[2][2].y * -1.0f, a[2][2].x * -1.0f + a[2][2].y * 6.123233995736766e-17f);
  a[2][3] = mk2(a[2][3].x * -0.7071067811865475f - a[2][3].y * -0.7071067811865476f, a[2][3].x * -0.7071067811865476f + a[2][3].y * -0.7071067811865475f);
  a[3][1] = mk2(a[3][1].x * 0.38268343236508984f - a[3][1].y * -0.9238795325112867f, a[3][1].x * -0.9238795325112867f + a[3][1].y * 0.38268343236508984f);
  a[3][2] = mk2(a[3][2].x * -0.7071067811865475f - a[3][2].y * -0.7071067811865476f, a[3][2].x * -0.7071067811865476f + a[3][2].y * -0.7071067811865475f);
  a[3][3] = mk2(a[3][3].x * -0.9238795325112868f - a[3][3].y * 0.38268343236508967f, a[3][3].x * 0.38268343236508967f + a[3][3].y * -0.9238795325112868f);
  { const f32x2 s0 = a[0][0] + a[2][0], s1 = a[0][0] - a[2][0], s2 = a[1][0] + a[3][0], t3 = a[1][0] - a[3][0]; const f32x2 s3 = mk2(t3.y, -t3.x);
    x[0] = s0 + s2; x[4] = s1 + s3; x[8] = s0 - s2; x[12] = s1 - s3; }
  { const f32x2 s0 = a[0][1] + a[2][1], s1 = a[0][1] - a[2][1], s2 = a[1][1] + a[3][1], t3 = a[1][1] - a[3][1]; const f32x2 s3 = mk2(t3.y, -t3.x);
    x[1] = s0 + s2; x[5] = s1 + s3; x[9] = s0 - s2; x[13] = s1 - s3; }
  { const f32x2 s0 = a[0][2] + a[2][2], s1 = a[0][2] - a[2][2], s2 = a[1][2] + a[3][2], t3 = a[1][2] - a[3][2]; const f32x2 s3 = mk2(t3.y, -t3.x);
    x[2] = s0 + s2; x[6] = s1 + s3; x[10] = s0 - s2; x[14] = s1 - s3; }
  { const f32x2 s0 = a[0][3] + a[2][3], s1 = a[0][3] - a[2][3], s2 = a[1][3] + a[3][3], t3 = a[1][3] - a[3][3]; const f32x2 s3 = mk2(t3.y, -t3.x);
    x[3] = s0 + s2; x[7] = s1 + s3; x[11] = s0 - s2; x[15] = s1 - s3; }
}
constexpr int FFT_PAD_ELEMS = FFTN + FFTN / 16;
__device__ __forceinline__ int pidx(int i) { return i + (i >> 4); }
__device__ __forceinline__ f32x2 cmul(f32x2 a, f32x2 b) { return mk2(a.x * b.x - a.y * b.y, a.x * b.y + a.y * b.x); }
template <bool HALF_IN, int P>
__device__ __forceinline__ void fft_pass16(LAS f32x2* data, const f32x2* tw, f32x2 (&v)[32], int tid) {
    constexpr int sh = 4 * P, Ns = 1 << sh, pst = Ns + (Ns >> 4);
    { const LAS f32x2* rd = data + pidx(tid);
#pragma unroll
      for (int i = 0; i < 2; ++i)
#pragma unroll
          for (int r = 0; r < 16; ++r) { if (HALF_IN && P == 0 && r >= 8) v[16 * i + r] = mk2(0.f, 0.f); else v[16 * i + r] = rd[544 * i + 1088 * r]; } }
    LDS_BARRIER();
#pragma unroll
    for (int i = 0; i < 2; ++i) { const int j = tid + 512 * i, k = j & (Ns - 1);
        f32x2 (&x)[16] = *(f32x2 (*)[16])&v[16 * i];
        if (P > 0) {
            const f32x2 w1 = tw[k * (1024 >> sh)];
            const f32x2 w2 = cmul(w1, w1), w4 = cmul(w2, w2), w8 = cmul(w4, w4);
            x[1] = cmul(x[1], w1); x[2] = cmul(x[2], w2); x[4] = cmul(x[4], w4); x[8] = cmul(x[8], w8);
            { const f32x2 w3 = cmul(w2, w1); x[3] = cmul(x[3], w3); x[6] = cmul(x[6], cmul(w3, w3)); x[11] = cmul(x[11], cmul(w8, w3));
              const f32x2 w7 = cmul(w4, w3); x[7] = cmul(x[7], w7); x[14] = cmul(x[14], cmul(w7, w7)); x[15] = cmul(x[15], cmul(w8, w7)); x[12] = cmul(x[12], cmul(w8, w4)); }
            { const f32x2 w5 = cmul(w4, w1); x[5] = cmul(x[5], w5); x[10] = cmul(x[10], cmul(w5, w5)); x[13] = cmul(x[13], cmul(w8, w5)); x[9] = cmul(x[9], cmul(w8, w1)); }
        }
        dft16(x);
        LAS f32x2* wr = data + pidx(((j >> sh) << (sh + 4)) + k);
#pragma unroll
        for (int r = 0; r < 16; ++r) wr[r * pst] = x[r];
        __builtin_amdgcn_sched_barrier(0); }
    LDS_BARRIER();
}
template <bool HALF_IN>
__device__ __forceinline__ void fft16k(LAS f32x2* data, const f32x2* tw, f32x2 (&v)[32], int tid) {
    fft_pass16<HALF_IN, 0>(data, tw, v, tid); fft_pass16<HALF_IN, 1>(data, tw, v, tid); fft_pass16<HALF_IN, 2>(data, tw, v, tid);
    { const LAS f32x2* rd = data + pidx(tid);
#pragma unroll
      for (int i = 0; i < 8; ++i)
#pragma unroll
          for (int r = 0; r < 4; ++r) v[4 * i + r] = rd[544 * i + 4352 * r]; }
    LDS_BARRIER();
#pragma unroll
    for (int i = 0; i < 8; ++i) { const int j = tid + 512 * i;
        const f32x2 w1 = tw[j], w2 = cmul(w1, w1), w3 = cmul(w2, w1);
        const f32x2 x0 = v[4 * i], x1 = cmul(v[4 * i + 1], w1), x2 = cmul(v[4 * i + 2], w2), x3 = cmul(v[4 * i + 3], w3);
        const f32x2 a = x0 + x2, bq = x0 - x2, c = x1 + x3, d0 = x1 - x3; const f32x2 d = mk2(d0.y, -d0.x);
        v[4 * i] = a + c; v[4 * i + 1] = bq + d; v[4 * i + 2] = a - c; v[4 * i + 3] = bq - d; }
}
__device__ __forceinline__ void phase_hy_fft(Frame& F, int e) {
    LAS f32x2* data = (LAS f32x2*)F.lds; LAS float* red = (LAS float*)(F.lds + FFT_PAD_ELEMS * 8);
    const float* KERN = (const float*)(F.ws + WS_KERN); bf16_t* UT = (bf16_t*)(F.ws + WS_UT); const f32x2* tw = (const f32x2*)(F.ws + WS_TW);
    const bf16_t* PHT = (const bf16_t*)(F.ws + WS_PHY); const float* hcw = inp(I_HCW) + (size_t)e * 3 * HYW; const float* hcb = inp(I_HCB) + (size_t)e * HYW;
    const int tid = F.tid & 511, lane = F.lane, wave = F.wave; const unsigned utid = (unsigned)tid;
    const int pt = pidx(tid), pt8 = 8 * tid + (tid >> 1);
    for (int ch = F.bid; ch < DM; ch += F.G) {
        float asum = 0.f;
        for (int i = 0; i < 32; ++i) { const float val = (KERN + (size_t)ch * FFTN + 512 * i)[utid]; data[pt + 544 * i] = mk2(val, 0.f); asum += fabsf(val); }
        asum = wave_sum(asum);
        if (lane == 0) red[wave] = asum;
        LDS_BARRIER();
        float tot = 0.f;
#pragma unroll
        for (int w = 0; w < 8; ++w) tot += red[w];
        const float kscale = 1.0f / (tot * (float)FFTN), skip = inp(I_HSKIP)[e * DM + ch] * (1.0f / (float)FFTN);
        f32x2 v[32];
        f32x2* ks = (f32x2*)(F.ws + WS_KS) + (size_t)F.bid * FFTN;
        fft16k<false>(data, tw, v, tid);
#pragma unroll
        for (int q = 0; q < 32; ++q) (ks + q * 512)[utid] = mk2(v[q].x * kscale + skip, v[q].y * kscale);
        LDS_BARRIER();
        for (int pi = 0; pi < 3; ++pi) {
            const int b0 = 2 * pi, b1 = 2 * pi + 1;
            bf16_t* u0 = UT + ((size_t)(b0 * DM + ch)) * SEQ; bf16_t* u1 = UT + ((size_t)((b1 < NSEQ ? b1 : b0) * DM + ch)) * SEQ;
            {
              const float a0 = hcw[2048 + ch], a1 = hcw[HYW + 2048 + ch], a2 = hcw[2 * HYW + 2048 + ch], ab = hcb[2048 + ch];
              const float c0 = hcw[4096 + ch], c1 = hcw[HYW + 4096 + ch], c2 = hcw[2 * HYW + 4096 + ch], cbv = hcb[4096 + ch];
              const bf16_t* r1 = PHT + (size_t)(2048 + ch) * T; const bf16_t* rv = PHT + (size_t)(4096 + ch) * T;
#pragma unroll
              for (int i = 0; i < 2; ++i) { const unsigned t8 = (utid + 512u * i) * 8u; float pr[2][8];
#pragma unroll
                  for (int q = 0; q < 2; ++q) { const int bq = q ? b1 : b0;
                      if (bq < NSEQ) { const bf16_t* p1 = r1 + (size_t)bq * SEQ + t8; const bf16_t* pv = rv + (size_t)bq * SEQ + t8; float x[10], w[10];
                          unpack8(*(const u32x4*)p1, *(float (*)[8])&x[1]); unpack8(*(const u32x4*)pv, *(float (*)[8])&w[1]);
                          x[0] = t8 > 0u ? bf2f(p1[-1]) : 0.f; x[9] = t8 + 8u < (unsigned)SEQ ? bf2f(p1[8]) : 0.f;
                          w[0] = t8 > 0u ? bf2f(pv[-1]) : 0.f; w[9] = t8 + 8u < (unsigned)SEQ ? bf2f(pv[8]) : 0.f;
#pragma unroll
                          for (int j = 0; j < 8; ++j) pr[q][j] = (ab + a0 * x[j] + a1 * x[j + 1] + a2 * x[j + 2]) * (cbv + c0 * w[j] + c1 * w[j + 1] + c2 * w[j + 2]); }
                      else {
#pragma unroll
                          for (int j = 0; j < 8; ++j) pr[q][j] = 0.f; } }
#pragma unroll
                  for (int j = 0; j < 8; ++j) data[pt8 + 4352 * i + j] = mk2(pr[0][j], pr[1][j]); } }
            LDS_BARRIER();
            fft16k<true>(data, tw, v, tid);
            LDS_BARRIER();
#pragma unroll
            for (int i = 0; i < 8; ++i)
#pragma unroll
                for (int r = 0; r < 4; ++r) { const f32x2 a = v[4 * i + r], k = (ks + (4 * i + r) * 512)[utid];
                    data[pt + 544 * i + 4352 * r] = mk2(a.x * k.x - a.y * k.y, -(a.x * k.y + a.y * k.x)); }
            LDS_BARRIER();
            fft16k<false>(data, tw, v, tid);
#pragma unroll
            for (int i = 0; i < 8; ++i)
#pragma unroll
                for (int r = 0; r < 2; ++r) { (u0 + 512 * i + 4096 * r)[utid] = f2bf(v[4 * i + r].x); if (b1 < NSEQ) (u1 + 512 * i + 4096 * r)[utid] = f2bf(-v[4 * i + r].y); }
            LDS_BARRIER();
        }
    }
}
constexpr int SPL = 32;
#ifndef EVEN_ON
#define EVEN_ON 1
#endif
#ifndef ODD_ON
#define ODD_ON 1
#endif
#ifndef STEPMASK
#define STEPMASK 0xffffffffu
#endif
#define RUN(k) ((ONLY >= 0) ? ((k) == ONLY) : ((((STEPMASK >> (k)) & 1u) != 0u) && (layer * SPL + (k)) >= args.s_lo && (layer * SPL + (k)) < args.s_hi))
#define PH() do { int t_ = threadIdx.x; asm volatile("" : "+v"(t_)); F.tid = t_; F.lane = t_ & 63; F.wave = __builtin_amdgcn_readfirstlane(t_ >> 6); } while (0)
#ifndef MK_DUP
#define MK_DUP 0u
#endif
#define REP(k) for (int rep_ = 0; rep_ < (((MK_DUP >> (k)) & 1u) ? 2 : 1); ++rep_)
#define SEAM() do { if (ONLY < 0) xcd_barrier(bar); } while (0)
template <int ONLY, int PAR, int LAYER> __device__ __forceinline__ void layer_body(const Args& args, Frame& F, const XcdBarrier& bar) {
    unsigned char* ws = args.ws;
    bf16_t* H = F.h;
    const int layer = (LAYER >= 0) ? LAYER : args.l_lo;
    {
        const int e = layer >> 1;
        if (RUN(0)) { PH(); REP(0) phase_prep(F, layer); SEAM(); }
        if (!(layer & 1) && EVEN_ON && PAR != 1) {
            bf16_t* PR = (bf16_t*)(ws + WS_PROJ);
            if (RUN(1)) { PH();
                { pg8::Gemm g{H, (const bf16_t*)(ws + W_IN), DM, DM, DM, T / 256, PW / 256, 1, 1, 0, 0, 0, 0}; pg8::Order S; S.init(g, F.G, F.bid);
                  pg8::EpiBf16 E{PR, PW, 1, 0, 0, 1.0f}; pg8::gemm_phase(F.lds, g, S, E); }
                { pg8::Gemm g{H, (const bf16_t*)(ws + W_DT), DM, DM, DM, T / 256, 1, 1, 1, 0, 0, 0, 0}; pg8::Order S; S.init(g, F.G, F.bid);
                  pg8::EpiDt E{(float*)(ws + WS_DT), inp(I_DTB) + e * 64}; pg8::gemm_phase(F.lds, g, S, E); }
                { pg8::Gemm g{(const bf16_t*)(ws + WS_MEMN), (const bf16_t*)(ws + W_K), DM, DM, DM, MROWS / 256, DM / 256, 1, 1, 0, 0, 0, 0}; pg8::Order S; S.init(g, F.G, (F.bid + F.G - 160) % F.G);
                  pg8::EpiBf16 E{(bf16_t*)(ws + WS_MK), DM, 1, 0, 0, 1.0f}; pg8::gemm_phase(F.lds, g, S, E); }
                { pg8::Gemm g{(const bf16_t*)(ws + WS_MEMN), (const bf16_t*)(ws + W_V), DM, DM, DM, MROWS / 256, DM / 256, 1, 1, 0, 0, 0, 0}; pg8::Order S; S.init(g, F.G, (F.bid + F.G - 200) % F.G);
                  pg8::EpiBf16 E{(bf16_t*)(ws + WS_MV), DM, 1, 0, 0, 1.0f}; pg8::gemm_phase(F.lds, g, S, E); }
                SEAM();
            }
            if (RUN(2)) { PH(); REP(2) phase_ssd_conv(F, e); phase_qk_rope(F, e); SEAM(); }
            if (RUN(3)) { PH(); REP(3) phase_ssd_states(F, e); SEAM(); }
            if (RUN(4)) { PH(); phase_ssd_scan(F); SEAM(); }
            if (RUN(5)) { PH(); REP(5) phase_ssd_out(F, e); SEAM(); }
            if (RUN(6)) { PH(); phase_attention(F); SEAM(); }
            if (RUN(7)) { PH(); phase_ssd_gate_norm(F, e); SEAM(); }
            if (RUN(8)) { PH();
                pg8::Gemm g{PR, (const bf16_t*)(ws + W_OUT), PW, 4096, 4096, T / 256, DM / 256, 1, 1, 0, 0, 0, 0}; pg8::Order S; S.init(g, F.G, F.bid);
                pg8::EpiResAddPS E{F.x16, DM, (float*)(ws + WS_PS)}; pg8::gemm_phase(F.lds, g, S, E);
                { pg8::Gemm g{(const bf16_t*)(ws + WS_MK), (const bf16_t*)(ws + W_Q), DM, DM, XAD, 1, DM / 256, NSEQ * XAH, XAH, (long)NMEM * DM, XAD, 0, XAD}; pg8::Order S; S.init(g, F.G, F.bid);
                  pg8::EpiBf16G E{(bf16_t*)(ws + WS_WQK), DM, XAH, (long)XAH * NMEM * DM, (long)NMEM * DM, inp(I_NXA) + (size_t)layer * DM}; pg8::gemm_phase(F.lds, g, S, E); }
                SEAM();
            }
        } else if ((layer & 1) && ODD_ON && PAR != 0) {
            if (RUN(1)) { PH();
                { pg8::Gemm g{(const bf16_t*)(ws + HW_IN), H, DM, DM, DM, HYW / 256, T / 256, 1, 1, 0, 0, 0, 0}; pg8::Order S; S.init(g, F.G, F.bid);
                  pg8::EpiBf16 E{(bf16_t*)(ws + WS_PHY), T, 1, 0, 0, 1.0f}; pg8::gemm_phase(F.lds, g, S, E); }
                { pg8::Gemm g{(const bf16_t*)(ws + WS_MEMN), (const bf16_t*)(ws + W_K), DM, DM, DM, MROWS / 256, DM / 256, 1, 1, 0, 0, 0, 0}; pg8::Order S; S.init(g, F.G, F.bid);
                  pg8::EpiBf16 E{(bf16_t*)(ws + WS_MK), DM, 1, 0, 0, 1.0f}; pg8::gemm_phase(F.lds, g, S, E); }
                { pg8::Gemm g{(const bf16_t*)(ws + WS_MEMN), (const bf16_t*)(ws + W_V), DM, DM, DM, MROWS / 256, DM / 256, 1, 1, 0, 0, 0, 0}; pg8::Order S; S.init(g, F.G, (F.bid + F.G - 40) % F.G);
                  pg8::EpiBf16 E{(bf16_t*)(ws + WS_MV), DM, 1, 0, 0, 1.0f}; pg8::gemm_phase(F.lds, g, S, E); }
                REP(24) phase_hy_kern(F, e);
                SEAM();
            }
            if (RUN(3)) { PH(); phase_hy_fft(F, e); SEAM(); }
            if (RUN(4)) { PH(); REP(26) phase_hy_tout(F, e); SEAM(); }
            if (RUN(5)) { PH();
                pg8::Gemm g{H, (const bf16_t*)(ws + HW_OUT), DM, DM, DM, T / 256, DM / 256, 1, 1, 0, 0, 0, 0}; pg8::Order S; S.init(g, F.G, F.bid);
                pg8::EpiResAddPS E{F.x16, DM, (float*)(ws + WS_PS)}; pg8::gemm_phase(F.lds, g, S, E);
                { pg8::Gemm g{(const bf16_t*)(ws + WS_MK), (const bf16_t*)(ws + W_Q), DM, DM, XAD, 1, DM / 256, NSEQ * XAH, XAH, (long)NMEM * DM, XAD, 0, XAD}; pg8::Order S; S.init(g, F.G, F.bid);
                  pg8::EpiBf16G E{(bf16_t*)(ws + WS_WQK), DM, XAH, (long)XAH * NMEM * DM, (long)NMEM * DM, inp(I_NXA) + (size_t)layer * DM}; pg8::gemm_phase(F.lds, g, S, E); }
                SEAM();
            }
        }
        if (RUN(10)) { PH();
            pg8::Gemm g{F.x16, (const bf16_t*)(ws + WS_WQK), DM, DM, DM, SEQ / 256, (XAH * NMEM) / 256, NSEQ, 1, (long)SEQ * DM, 0, (long)XAH * NMEM * DM, 0}; pg8::Order S; S.init(g, F.G, F.bid);
            pg8::EpiSoftmax E{(bf16_t*)(ws + WS_P), XAH * NMEM, (long)SEQ * XAH * NMEM, 0.044194173824159216f * 1.4426950408889634f, (LAS float*)(F.lds + pg8::STAGE_BYTES), (const float*)(ws + WS_PS)}; pg8::gemm_phase(F.lds, g, S, E);
            if (2 * F.bid >= F.G) { pg8::Gemm g2{(const bf16_t*)(ws + W_O), (const bf16_t*)(ws + WS_MV), DM, DM, XAD, DM / 256, 1, NSEQ * XAH, XAH, 0, XAD, (long)NMEM * DM, XAD}; pg8::Order S2; S2.init(g2, F.G - F.G / 2, F.bid - F.G / 2);
                  pg8::EpiBf16 E2{(bf16_t*)(ws + WS_VWOT), XAH * NMEM, XAH, (long)DM * XAH * NMEM, NMEM, 1.0f}; pg8::gemm_phase(F.lds, g2, S2, E2); }
            SEAM();
        }
        if (RUN(14)) { PH();
            pg8::Gemm g{(const bf16_t*)(ws + WS_P), (const bf16_t*)(ws + WS_VWOT), XAH * NMEM, XAH * NMEM, XAH * NMEM, SEQ / 256, DM / 256, NSEQ, 1, (long)SEQ * XAH * NMEM, 0, (long)DM * XAH * NMEM, 0}; pg8::Order S; S.init(g, F.G, F.bid);
            pg8::EpiResAdd E{F.x16, DM, (long)SEQ * DM}; pg8::gemm_phase(F.lds, g, S, E);
            SEAM();
        }
        if (RUN(15)) { PH(); REP(15) phase_rms_x(F, inp(I_NFFN) + (size_t)layer * DM, false); SEAM(); }
        if (RUN(16)) { PH();
            pg8::Gemm g{H, (const bf16_t*)(ws + W_FIN), DM, DM, DM, T / 256, F2 / 256, 1, 1, 0, 0, 0, 0}; pg8::Order S; S.init(g, F.G, F.bid);
            pg8::EpiFfnGate E{(bf16_t*)(ws + WS_ACT), (bf16_t*)(ws + WS_SB), inp(I_FCW) + (size_t)layer * 3 * F2, inp(I_FCB) + (size_t)layer * F2}; pg8::gemm_phase(F.lds, g, S, E);
            SEAM();
        }
        if (RUN(17)) { PH(); phase_ffn_fix(F, layer); SEAM(); }
        if (RUN(21)) { PH();
            pg8::Gemm g{(const bf16_t*)(ws + WS_ACT), (const bf16_t*)(ws + W_FOUT), DFF, DFF, DFF, T / 256, DM / 256, 1, 1, 0, 0, 0, 0}; pg8::Order S; S.init(g, F.G, F.bid);
            pg8::EpiResAdd E{F.x16, DM, 0}; pg8::gemm_phase(F.lds, g, S, E);
            SEAM();
        }
        if (layer == 3 && RUN(22)) { PH(); phase_final_norm(F); }
    }
}
#undef RUN
#undef SEAM
#undef PH
#undef REP
template <int ONLY, int PAR> __device__ __forceinline__ void program(const Args& args) {
    extern __shared__ __attribute__((aligned(16))) unsigned char lds_raw[];
    Frame F;
    F.lds = (LAS unsigned char*)lds_raw;
    F.tid = threadIdx.x; F.lane = F.tid & 63; F.wave = __builtin_amdgcn_readfirstlane(F.tid >> 6);
    F.G = gridDim.x; F.bid = blockIdx.x;
    F.out = args.out; F.ws = args.ws; F.h = (bf16_t*)args.out; F.x16 = (bf16_t*)(args.ws + WS_H);
    unsigned char* ws = args.ws;
    volatile LAS unsigned* MISC = (volatile LAS unsigned*)(F.lds + LDS_CTL);
    if (F.tid < 64) MISC[F.tid] = 0u;
    __syncthreads();
    XcdBarrier bar; bar.bar = (unsigned*)(ws + WS_CTL) + 4096; bar.x = 0; bar.st = nullptr;
    if (ONLY < 0) bar = xcd_barrier_post((unsigned*)(ws + WS_CTL) + 4096, MISC + 8);
    if (ONLY >= 0) layer_body<ONLY, PAR, -1>(args, F, bar);
    else { layer_body<-1, 0, 0>(args, F, bar); layer_body<-1, 1, 1>(args, F, bar); layer_body<-1, 0, 2>(args, F, bar); layer_body<-1, 1, 3>(args, F, bar); }
}
template <int ONLY, int PAR> __global__ void __launch_bounds__(512, 2) trunk_step(Args args) { program<ONLY, PAR>(args); }
__global__ void __launch_bounds__(512, 2) trunk_fwd(Args args) { program<-1, -1>(args); }
typedef void (*StepFn)(Args);
template <int K> struct StepTab { static void fill(StepFn (*t)[2]) { t[K][0] = trunk_step<K, 0>; t[K][1] = trunk_step<K, (K <= 5) ? 1 : 0>; StepTab<K - 1>::fill(t); } };
template <> struct StepTab<-1> { static void fill(StepFn (*)[2]) {} };

static const int kSteps[2][23] = {
    {0, 1, 2, 3, 4, 5, 6, 7, 8, 9, 10, 12, 14, 15, 16, 17, 21, 22, -1, -1, -1, -1, -1},
    {0, 1, 3, 4, 5, 9, 10, 12, 14, 15, 16, 17, 21, 22, -1, -1, -1, -1, -1, -1, -1, -1, -1}};
static StepFn g_steps[23][2];
extern "C" void kernel_launch(void* const* d_in, const int* in_sizes, int n_in, void* d_out, int out_size, void* d_ws, size_t ws_size, hipStream_t stream) {
    static int grid = 0;
    if (grid == 0) {
        if (n_in != 40 || out_size != T * DM || ws_size < WS_END) { fprintf(stderr, "kernel_launch: unexpected shapes: n_in %d out %d ws %zu (need %zu)\n", n_in, out_size, ws_size, (size_t)WS_END); grid = -1; return; }
        int dev = 0, cus = 0;
        if (hipGetDevice(&dev) != hipSuccess || hipDeviceGetAttribute(&cus, hipDeviceAttributeMultiprocessorCount, dev) != hipSuccess) { grid = -1; return; }
        if (hipFuncSetAttribute((const void*)trunk_fwd, hipFuncAttributeMaxDynamicSharedMemorySize, LDS_BYTES) != hipSuccess) { fprintf(stderr, "kernel_launch: hipFuncSetAttribute failed\n"); grid = -1; return; }
#if MK_FUSED != 1
        StepTab<22>::fill(g_steps);
        for (int k = 0; k < 23; ++k) for (int p = 0; p < 2; ++p)
            if (hipFuncSetAttribute((const void*)g_steps[k][p], hipFuncAttributeMaxDynamicSharedMemorySize, LDS_BYTES) != hipSuccess) { fprintf(stderr, "kernel_launch: hipFuncSetAttribute failed (step %d)\n", k); grid = -1; return; }
#endif
        (void)hipGetLastError();
        grid = cus;
    }
    if (grid < 0) return;
    (void)hipMemsetAsync((char*)d_ws + WS_CTL, 0, CTL_BYTES, stream);
    Args a{};
    for (int i = 0; i < 40; ++i) a.in[i] = (const float*)d_in[i];
    a.out = (float*)d_out; a.ws = (unsigned char*)d_ws;
#if MK_FUSED == 1
    { static const int cuts[] = { MK_CUTS };
      const int ncut = (int)(sizeof(cuts) / sizeof(cuts[0]));
      for (int ci = 0; ci + 1 < ncut; ++ci) {
          if (ci > 0) (void)hipMemsetAsync((char*)d_ws + WS_CTL, 0, CTL_BYTES, stream);
          a.l_lo = 0; a.l_hi = 4; a.s_lo = cuts[ci]; a.s_hi = cuts[ci + 1]; a.fused = 1; a.pad = 0;
          hipLaunchKernelGGL(trunk_fwd, dim3(grid), dim3(512), LDS_BYTES, stream, a); } }
#else
    for (int layer = 0; layer < 4; ++layer)
        for (int si = 0; si < 23; ++si) {
            const int k = kSteps[layer & 1][si]; if (k < 0) continue; if (k == 22 && layer != 3) continue;
            a.l_lo = layer; a.l_hi = layer + 1; a.s_lo = layer * SPL + k; a.s_hi = a.s_lo + 1; a.fused = 0; a.pad = 0;
#if MK_FUSED == 2
            if (((MK_FSET >> k) & 1u) && (layer & 1) == MK_FPAR) { (void)hipMemsetAsync((char*)d_ws + WS_CTL, 0, CTL_BYTES, stream); a.l_lo = 0; a.l_hi = 4; hipLaunchKernelGGL(trunk_fwd, dim3(grid), dim3(512), LDS_BYTES, stream, a); continue; }
#endif
            hipLaunchKernelGGL(g_steps[k][layer & 1], dim3(grid), dim3(512), LDS_BYTES, stream, a);
        }
#endif
    const hipError_t le = hipPeekAtLastError();
    if (le != hipSuccess) fprintf(stderr, "kernel_launch: launch failed: %s\n", hipGetErrorName(le));
}
```

```cpp
#include <hip/hip_runtime.h>
#include <cstdio>
#include <cstdint>
#ifndef MK_FUSED
#define MK_FUSED 1
#endif
#ifndef MK_FPAR
#define MK_FPAR 0
#endif
#ifndef MK_FSET
#define MK_FSET 0x8u
#endif
#ifndef MK_CUTS
#define MK_CUTS 0, 128
#endif

#define GAS __attribute__((address_space(1)))
#define LAS __attribute__((address_space(3)))
typedef unsigned short bf16_t;
typedef short bf16x8 __attribute__((ext_vector_type(8)));
typedef short s16x4 __attribute__((ext_vector_type(4)));
typedef float f32x4 __attribute__((ext_vector_type(4)));
typedef float f32x2 __attribute__((ext_vector_type(2)));
typedef float f32x16 __attribute__((ext_vector_type(16)));
typedef unsigned u32x4 __attribute__((ext_vector_type(4)));
typedef unsigned u32x2 __attribute__((ext_vector_type(2)));

constexpr int DM = 2048, SEQ = 8192, NSEQ = 5, T = NSEQ * SEQ, NMEM = 256, MROWS = NSEQ * NMEM;
constexpr int XAH = 4, XAD = 512;
constexpr int SSH = 32, SSP = 64, SSG = 4, SSN = 128, SSQ = 128, NCH = SEQ / SSQ;
constexpr int AH = 16, AKV = 4, AD = 128;
constexpr int PW = 8192, PC_Z = 0, PC_Q = 2048, PC_X = 4096, PC_K = 7168, PC_V = 7680;
constexpr int DFF = 5632, F2 = 11264, HYW = 6144;
constexpr int FCH = 20480, FCHP = 81;
constexpr float EPS = 1e-6f;
constexpr int FFTN = 16384;

constexpr size_t MiB = 1u << 20;
constexpr size_t WS_CTL = 0, CTL_BYTES = 1 * MiB;
constexpr size_t WS_TW = 1 * MiB;
constexpr size_t WS_H3 = 2 * MiB;
constexpr size_t WS_MEMN = 4 * MiB, WS_MK = 9 * MiB, WS_MV = 14 * MiB;
constexpr size_t WS_DT = 19 * MiB;
constexpr size_t WS_TOT = 29 * MiB;
constexpr size_t WS_W = 32 * MiB;
constexpr size_t W_IN = WS_W, W_DT = WS_W + 32 * MiB, W_OUT = WS_W + 33 * MiB;
constexpr size_t HW_IN = WS_W, HW_OUT = WS_W + 24 * MiB;
constexpr size_t W_Q = WS_W + 49 * MiB, W_K = WS_W + 57 * MiB, W_V = WS_W + 65 * MiB, W_O = WS_W + 73 * MiB, W_FIN = WS_W + 81 * MiB, W_FOUT = WS_W + 125 * MiB;
constexpr size_t WS_H = 184 * MiB;
constexpr size_t WS_BIG = 344 * MiB;
constexpr size_t WS_PROJ = WS_BIG, WS_BC = WS_BIG + 640 * MiB, WS_STF = WS_BIG + 720 * MiB, WS_STB = WS_BIG + 880 * MiB;
constexpr size_t WS_SC = WS_BIG + 160 * MiB, WS_P = WS_BIG + 320 * MiB;
constexpr size_t WS_PS = WS_BIG + 700 * MiB;
constexpr size_t WS_WQK = WS_BIG + 640 * MiB, WS_VWOT = WS_BIG + 660 * MiB;
constexpr size_t WS_ACT = WS_BIG, WS_SB = WS_BIG + 440 * MiB;
constexpr size_t WS_PHY = WS_BIG, WS_UT = WS_BIG + 480 * MiB, WS_KERN = WS_BIG + 640 * MiB, WS_KS = WS_BIG + 768 * MiB;
constexpr size_t WS_END = WS_BIG + 1040 * MiB;
static_assert(W_FOUT + (size_t)DM * DFF * 2 <= WS_H, "weights region");
static_assert(WS_ACT + (size_t)T * DFF * 2 <= WS_SB && WS_SB + (size_t)(T / 64) * 4 * F2 * 2 <= WS_END && WS_KERN + (size_t)DM * FFTN * 4 <= WS_END, "big region");

constexpr int LDS_BYTES = 163840, LDS_CTL = 161792;

__device__ __forceinline__ float bf2f(unsigned b) { return __uint_as_float(b << 16); }
__device__ __forceinline__ float bflo(unsigned w) { return __uint_as_float(w << 16); }
__device__ __forceinline__ float bfhi(unsigned w) { return __uint_as_float(w & 0xffff0000u); }
__device__ __forceinline__ unsigned cvt_pk_bf16(float lo, float hi) { unsigned r; asm volatile("v_cvt_pk_bf16_f32 %0, %1, %2" : "=v"(r) : "v"(lo), "v"(hi)); return r; }
typedef __bf16 bf16x2_t __attribute__((ext_vector_type(2)));
__device__ __forceinline__ unsigned cvt_pk_c(float lo, float hi) { f32x2 v; v.x = lo; v.y = hi; bf16x2_t r = __builtin_convertvector(v, bf16x2_t); return __builtin_bit_cast(unsigned, r); }
__device__ __forceinline__ unsigned short f2bf(float f) { return (unsigned short)(cvt_pk_bf16(f, 0.f) & 0xffffu); }
__device__ __forceinline__ float wave_sum(float v) {
#pragma unroll
    for (int o = 1; o < 64; o <<= 1) v += __shfl_xor(v, o);
    return v;
}
__device__ __forceinline__ float wave_max(float v) {
#pragma unroll
    for (int o = 1; o < 64; o <<= 1) v = fmaxf(v, __shfl_xor(v, o));
    return v;
}
__device__ __forceinline__ float silu_f(float x) { return x * __builtin_amdgcn_rcpf(1.f + __builtin_amdgcn_exp2f(x * -1.4426950408889634f)); }
__device__ __forceinline__ void unpack8(const u32x4 w, float (&f)[8]) {
    f[0] = bflo(w.x); f[1] = bfhi(w.x); f[2] = bflo(w.y); f[3] = bfhi(w.y); f[4] = bflo(w.z); f[5] = bfhi(w.z); f[6] = bflo(w.w); f[7] = bfhi(w.w);
}
__device__ __forceinline__ u32x4 pack8(const float (&f)[8]) {
    u32x4 w; w.x = cvt_pk_bf16(f[0], f[1]); w.y = cvt_pk_bf16(f[2], f[3]); w.z = cvt_pk_bf16(f[4], f[5]); w.w = cvt_pk_bf16(f[6], f[7]); return w;
}
#define LDS_WAIT() asm volatile("s_waitcnt lgkmcnt(0)" ::: "memory")
#define LDS_BARRIER() do { asm volatile("s_waitcnt lgkmcnt(0)" ::: "memory"); __builtin_amdgcn_s_barrier(); asm volatile("" ::: "memory"); } while (0)
#define VM_WAIT() asm volatile("s_waitcnt vmcnt(0)" ::: "memory")
namespace pg8 {
constexpr int BM = 256, BK = 64, HALF = 128, HTB = HALF * BK * 2, STAGE_BYTES = 8 * HTB, NXCD = 8, WGM = 8;
__host__ __device__ __forceinline__ int lds_byte(int r, int c) { const int st = (r >> 4) * 2 + (c >> 5), rr = r & 15, cc = c & 31, ob = rr * 64 + cc * 2; return st * 1024 + (ob ^ (((ob >> 9) & 1) << 5)); }
__host__ __device__ __forceinline__ void stage_rc(int b, int& R, int& C) { const int st = b / 1024, sb = b % 1024, swz = sb ^ (((sb >> 9) & 1) << 5); R = (st >> 1) * 16 + swz / 64; C = (st & 1) * 32 + (swz % 64) / 2; }
__host__ __device__ __forceinline__ int perm32(int rho) { const int n = rho >> 4, i = rho & 15; return 8 * (i >> 2) + 4 * n + (i & 3); }

struct Unit { int pm, pn, z; };
struct Gemm { const bf16_t* A; const bf16_t* Bt; int lda, ldb, K, nM, nN, nZ, zdiv; long aZhi, aZlo, bZhi, bZlo; };
__device__ __forceinline__ const char* a_ptr(const Gemm& g, const Unit& u) { return (const char*)g.A + ((size_t)(u.z / g.zdiv) * g.aZhi + (size_t)(u.z % g.zdiv) * g.aZlo + (size_t)u.pm * BM * g.lda) * 2; }
__device__ __forceinline__ const char* b_ptr(const Gemm& g, const Unit& u) { return (const char*)g.Bt + ((size_t)(u.z / g.zdiv) * g.bZhi + (size_t)(u.z % g.zdiv) * g.bZlo + (size_t)u.pn * BM * g.ldb) * 2; }

struct Order {
    int nM, nN, per, nwg, G, c;
    __device__ __forceinline__ void init(const Gemm& g, int G_, int c_) { nM = g.nM; nN = g.nN; per = nM * nN; nwg = per * g.nZ; G = G_; c = c_; }
    __device__ __forceinline__ bool next(int i, Unit& u) const {
        const long Lid = (long)i * G + c; if (Lid >= nwg) return false;
        u.z = (int)(Lid / per); int wgid = (int)(Lid % per);
        { const int q = per / NXCD, r = per % NXCD, xcd = wgid % NXCD, off = wgid / NXCD; wgid = (xcd < r ? xcd * (q + 1) : r * (q + 1) + (xcd - r) * q) + off; }
        const int nig = WGM * nN, gid = wgid / nig, fm = gid * WGM, gsz = (nM - fm) < WGM ? (nM - fm) : WGM;
        u.pm = fm + ((wgid % nig) % gsz); u.pn = (wgid % nig) / gsz; return true;
    }
};

struct EpiBf16 {
    static constexpr bool PERM = true; static constexpr bool PERMA = false;
    bf16_t* O; int ldc, zdiv; long cZhi, cZlo; float scale;
    __device__ __forceinline__ void operator()(const f32x4 (&acc)[2][2][4][2], const Unit& u, int wr, int wc, int fr, int fq) const {
        bf16_t* base = O + (size_t)(u.z / zdiv) * cZhi + (size_t)(u.z % zdiv) * cZlo;
        const int row0 = u.pm * BM + wr * 64 + fr, col0 = u.pn * BM + wc * 32 + 8 * fq;
#pragma unroll
        for (int ai = 0; ai < 2; ++ai)
#pragma unroll
            for (int m = 0; m < 4; ++m) { bf16_t* rowp = base + (size_t)(row0 + ai * HALF + m * 16) * ldc + col0;
#pragma unroll
                for (int bj = 0; bj < 2; ++bj) { const f32x4 v0 = acc[ai][bj][m][0] * scale, v1 = acc[ai][bj][m][1] * scale;
                    u32x4 w; w.x = cvt_pk_bf16(v0[0], v0[1]); w.y = cvt_pk_bf16(v0[2], v0[3]); w.z = cvt_pk_bf16(v1[0], v1[1]); w.w = cvt_pk_bf16(v1[2], v1[3]);
                    *(u32x4*)(rowp + bj * HALF) = w; } }
    }
};
struct EpiF32 {
    static constexpr bool PERM = false; static constexpr bool PERMA = false;
    float* C; int ldc, zdiv; long cZhi, cZlo; float scale;
    __device__ __forceinline__ void operator()(const f32x4 (&acc)[2][2][4][2], const Unit& u, int wr, int wc, int fr, int fq) const {
        float* base = C + (size_t)(u.z / zdiv) * cZhi + (size_t)(u.z % zdiv) * cZlo;
        const int row0 = u.pm * BM + wr * 64 + fr, col0 = u.pn * BM + wc * 32 + 4 * fq;
#pragma unroll
        for (int ai = 0; ai < 2; ++ai)
#pragma unroll
            for (int m = 0; m < 4; ++m) { float* rowp = base + (size_t)(row0 + ai * HALF + m * 16) * ldc + col0;
#pragma unroll
                for (int bj = 0; bj < 2; ++bj)
#pragma unroll
                    for (int n = 0; n < 2; ++n) *(f32x4*)(rowp + bj * HALF + n * 16) = acc[ai][bj][m][n] * scale; }
    }
};
struct EpiResAdd {
    static constexpr bool PERM = true; static constexpr bool PERMA = false;
    bf16_t* X; int ldc; long cZ;
    __device__ __forceinline__ void operator()(const f32x4 (&acc)[2][2][4][2], const Unit& u, int wr, int wc, int fr, int fq) const {
        const int row0 = u.pm * BM + wr * 64 + fr, col0 = u.pn * BM + wc * 32 + 8 * fq;
#pragma unroll
        for (int ai = 0; ai < 2; ++ai) {
            u32x4 old[4][2];
#pragma unroll
            for (int m = 0; m < 4; ++m)
#pragma unroll
                for (int bj = 0; bj < 2; ++bj) old[m][bj] = *(const u32x4*)(X + (size_t)u.z * cZ + (size_t)(row0 + ai * HALF + m * 16) * ldc + col0 + bj * HALF);
#pragma unroll
            for (int m = 0; m < 4; ++m)
#pragma unroll
                for (int bj = 0; bj < 2; ++bj) { float v[8]; unpack8(old[m][bj], v);
                    const f32x4 a0 = acc[ai][bj][m][0], a1 = acc[ai][bj][m][1];
                    u32x4 w; w.x = cvt_pk_c(v[0] + a0[0], v[1] + a0[1]); w.y = cvt_pk_c(v[2] + a0[2], v[3] + a0[3]); w.z = cvt_pk_c(v[4] + a1[0], v[5] + a1[1]); w.w = cvt_pk_c(v[6] + a1[2], v[7] + a1[3]);
                    *(u32x4*)(X + (size_t)u.z * cZ + (size_t)(row0 + ai * HALF + m * 16) * ldc + col0 + bj * HALF) = w; }
            asm volatile("" ::: "memory"); }
    }
};
struct EpiResAddPS {
    static constexpr bool PERM = true; static constexpr bool PERMA = false;
    bf16_t* X; int ldc; float* PS;
    __device__ __forceinline__ void operator()(const f32x4 (&acc)[2][2][4][2], const Unit& u, int wr, int wc, int fr, int fq) const {
        const int row0 = u.pm * BM + wr * 64 + fr, col0 = u.pn * BM + wc * 32 + 8 * fq;
#pragma unroll
        for (int ai = 0; ai < 2; ++ai) {
            u32x4 old[4][2];
#pragma unroll
            for (int m = 0; m < 4; ++m)
#pragma unroll
                for (int bj = 0; bj < 2; ++bj) old[m][bj] = *(const u32x4*)(X + (size_t)(row0 + ai * HALF + m * 16) * ldc + col0 + bj * HALF);
#pragma unroll
            for (int m = 0; m < 4; ++m) { float ss = 0.f;
#pragma unroll
                for (int bj = 0; bj < 2; ++bj) { float v[8]; unpack8(old[m][bj], v);
                    const f32x4 a0 = acc[ai][bj][m][0], a1 = acc[ai][bj][m][1];
                    v[0] += a0[0]; v[1] += a0[1]; v[2] += a0[2]; v[3] += a0[3]; v[4] += a1[0]; v[5] += a1[1]; v[6] += a1[2]; v[7] += a1[3];
                    ss += ((v[0] * v[0] + v[1] * v[1]) + (v[2] * v[2] + v[3] * v[3])) + ((v[4] * v[4] + v[5] * v[5]) + (v[6] * v[6] + v[7] * v[7]));
                    u32x4 w; w.x = cvt_pk_c(v[0], v[1]); w.y = cvt_pk_c(v[2], v[3]); w.z = cvt_pk_c(v[4], v[5]); w.w = cvt_pk_c(v[6], v[7]);
                    *(u32x4*)(X + (size_t)(row0 + ai * HALF + m * 16) * ldc + col0 + bj * HALF) = w; }
                ss += __shfl_xor(ss, 16); ss += __shfl_xor(ss, 32);
                if (fq == 0) PS[(size_t)(row0 + ai * HALF + m * 16) * 32 + u.pn * 4 + wc] = ss; }
            asm volatile("" ::: "memory"); }
    }
};
struct EpiBf16G {
    static constexpr bool PERM = true; static constexpr bool PERMA = false;
    bf16_t* O; int ldc, zdiv; long cZhi, cZlo; const float* cg;
    __device__ __forceinline__ void operator()(const f32x4 (&acc)[2][2][4][2], const Unit& u, int wr, int wc, int fr, int fq) const {
        bf16_t* base = O + (size_t)(u.z / zdiv) * cZhi + (size_t)(u.z % zdiv) * cZlo;
        const int row0 = u.pm * BM + wr * 64 + fr, col0 = u.pn * BM + wc * 32 + 8 * fq;
        f32x4 gn[2][2];
#pragma unroll
        for (int bj = 0; bj < 2; ++bj) { gn[bj][0] = *(const f32x4*)(cg + col0 + bj * HALF); gn[bj][1] = *(const f32x4*)(cg + col0 + bj * HALF + 4); }
#pragma unroll
        for (int ai = 0; ai < 2; ++ai)
#pragma unroll
            for (int m = 0; m < 4; ++m) { bf16_t* rowp = base + (size_t)(row0 + ai * HALF + m * 16) * ldc + col0;
#pragma unroll
                for (int bj = 0; bj < 2; ++bj) { const f32x4 v0 = acc[ai][bj][m][0] * gn[bj][0], v1 = acc[ai][bj][m][1] * gn[bj][1];
                    u32x4 w; w.x = cvt_pk_c(v0[0], v0[1]); w.y = cvt_pk_c(v0[2], v0[3]); w.z = cvt_pk_c(v1[0], v1[1]); w.w = cvt_pk_c(v1[2], v1[3]);
                    *(u32x4*)(rowp + bj * HALF) = w; } }
    }
};
struct EpiDt {
    static constexpr bool PERM = false; static constexpr bool PERMA = false;
    float* DT; const float* bias;
    __device__ __forceinline__ void operator()(const f32x4 (&acc)[2][2][4][2], const Unit& u, int wr, int wc, int fr, int fq) const {
        if (wc >= 2 || u.pn != 0) return;
        const int row0 = u.pm * BM + wr * 64 + fr, col0 = wc * 32 + 4 * fq;
#pragma unroll
        for (int ai = 0; ai < 2; ++ai)
#pragma unroll
            for (int m = 0; m < 4; ++m) { float* rowp = DT + (size_t)(row0 + ai * HALF + m * 16) * 64 + col0;
#pragma unroll
                for (int n = 0; n < 2; ++n) { const f32x4 bv = *(const f32x4*)(bias + col0 + n * 16); f32x4 v = acc[ai][0][m][n] + bv;
#pragma unroll
                    for (int j = 0; j < 4; ++j) v[j] = v[j] > 20.f ? v[j] : log1pf(__expf(v[j]));
                    *(f32x4*)(rowp + n * 16) = v; } }
    }
};

struct EpiFfnGate {
    static constexpr bool PERM = true; static constexpr bool PERMA = true;
    bf16_t* ACT; bf16_t* SB; const float* cw; const float* cb;
    __device__ __forceinline__ void operator()(const f32x4 (&acc)[2][2][4][2], const Unit& u, int wr, int wc, int fr, int fq) const {
        const int lane = fr + 16 * fq, src_prev = (lane & 48) | ((fr + 15) & 15), src_next = (lane & 48) | ((fr + 1) & 15);
        f32x4 wgs[2][3], wus[2][3], bgs[2], bus[2];
#pragma unroll
        for (int n = 0; n < 2; ++n) { const int f = u.pn * 128 + wc * 32 + 8 * fq + 4 * n;
#pragma unroll
            for (int k = 0; k < 3; ++k) { wgs[n][k] = *(const f32x4*)(cw + k * F2 + f); wus[n][k] = *(const f32x4*)(cw + k * F2 + DFF + f); }
            bgs[n] = *(const f32x4*)(cb + f); bus[n] = *(const f32x4*)(cb + DFF + f); }
        const int f0 = u.pn * 128 + wc * 32 + 8 * fq;
#pragma unroll
        for (int ai = 0; ai < 2; ++ai) {
            f32x4 gpl[2], upl[2], gnl[2], unl[2];
#pragma unroll
            for (int n = 0; n < 2; ++n)
#pragma unroll
                for (int j = 0; j < 4; ++j) { gpl[n][j] = __shfl(acc[ai][0][3][n][j], src_prev); upl[n][j] = __shfl(acc[ai][1][3][n][j], src_prev);
                                              gnl[n][j] = __shfl(acc[ai][0][0][n][j], src_next); unl[n][j] = __shfl(acc[ai][1][0][n][j], src_next); }
#pragma unroll
            for (int m = 0; m < 4; ++m) {
                const int lr = 4 * fr + m, row = u.pm * BM + ai * HALF + wr * 64 + lr;
                float o[8];
#pragma unroll
                for (int n = 0; n < 2; ++n) {
                    const f32x4 g0 = acc[ai][0][m][n], u0 = acc[ai][1][m][n];
                    const f32x4 gp = m > 0 ? acc[ai][0][m > 0 ? m - 1 : 0][n] : gpl[n], up = m > 0 ? acc[ai][1][m > 0 ? m - 1 : 0][n] : upl[n];
                    const f32x4 gn = m < 3 ? acc[ai][0][m < 3 ? m + 1 : 3][n] : gnl[n], un = m < 3 ? acc[ai][1][m < 3 ? m + 1 : 3][n] : unl[n];
                    const f32x4 G = bgs[n] + wgs[n][0] * gp + wgs[n][1] * g0 + wgs[n][2] * gn;
                    const f32x4 U = bus[n] + wus[n][0] * up + wus[n][1] * u0 + wus[n][2] * un;
#pragma unroll
                    for (int j = 0; j < 4; ++j) o[4 * n + j] = silu_f(G[j]) * U[j]; }
                if (lr >= 1 && lr <= 62) { u32x4 w; w.x = cvt_pk_c(o[0], o[1]); w.y = cvt_pk_c(o[2], o[3]); w.z = cvt_pk_c(o[4], o[5]); w.w = cvt_pk_c(o[6], o[7]); *(u32x4*)(ACT + (size_t)row * DFF + f0) = w; }
                if (lr <= 1 || lr >= 62) {
                    const int slot = lr <= 1 ? lr : lr - 60; bf16_t* sb = SB + ((size_t)(row >> 6) * 4 + slot) * F2 + f0;
                    const f32x4 ga = acc[ai][0][m][0], gb = acc[ai][0][m][1], ua = acc[ai][1][m][0], ub = acc[ai][1][m][1];
                    u32x4 w; w.x = cvt_pk_c(ga[0], ga[1]); w.y = cvt_pk_c(ga[2], ga[3]); w.z = cvt_pk_c(gb[0], gb[1]); w.w = cvt_pk_c(gb[2], gb[3]); *(u32x4*)sb = w;
                    w.x = cvt_pk_c(ua[0], ua[1]); w.y = cvt_pk_c(ua[2], ua[3]); w.z = cvt_pk_c(ub[0], ub[1]); w.w = cvt_pk_c(ub[2], ub[3]); *(u32x4*)(sb + DFF) = w; }
            }
        }
    }
};

struct EpiSoftmax {
    static constexpr bool PERM = true; static constexpr bool PERMA = false;
    bf16_t* P; int ldc; long cZ; float c; LAS float* xch; const float* PS;
    __device__ __forceinline__ void operator()(f32x4 (&acc)[2][2][4][2], const Unit& u, int wr, int wc, int fr, int fq) const {
        float mw[2][4], cr[2][4];
#pragma unroll
        for (int ai = 0; ai < 2; ++ai)
#pragma unroll
            for (int m = 0; m < 4; ++m) { const float* pp = PS + (size_t)(u.z * SEQ + u.pm * BM + ai * HALF + wr * 64 + m * 16 + fr) * 32 + fq * 8;
                const f32x4 a = *(const f32x4*)pp, b = *(const f32x4*)(pp + 4); float t = ((a.x + a.y) + (a.z + a.w)) + ((b.x + b.y) + (b.z + b.w));
                t += __shfl_xor(t, 16); t += __shfl_xor(t, 32); cr[ai][m] = c * (1.0f / sqrtf(t * (1.f / DM) + EPS)); }
#pragma unroll
        for (int ai = 0; ai < 2; ++ai)
#pragma unroll
            for (int m = 0; m < 4; ++m) {
                float v = -3.0e38f;
#pragma unroll
                for (int bj = 0; bj < 2; ++bj)
#pragma unroll
                    for (int n = 0; n < 2; ++n) { const f32x4 a = acc[ai][bj][m][n]; v = fmaxf(v, fmaxf(fmaxf(a[0], a[1]), fmaxf(a[2], a[3]))); }
                v = fmaxf(v, __shfl_xor(v, 16)); v = fmaxf(v, __shfl_xor(v, 32));
                mw[ai][m] = v;
                float s = 0.f;
#pragma unroll
                for (int bj = 0; bj < 2; ++bj)
#pragma unroll
                    for (int n = 0; n < 2; ++n) { f32x4 a = acc[ai][bj][m][n];
#pragma unroll
                        for (int j = 0; j < 4; ++j) { a[j] = __builtin_amdgcn_exp2f((a[j] - v) * cr[ai][m]); s += a[j]; }
                        acc[ai][bj][m][n] = a; }
                s += __shfl_xor(s, 16); s += __shfl_xor(s, 32);
                if (fq == 0) { f32x2 t; t.x = v; t.y = s; *(LAS f32x2*)(xch + ((wr * 128 + ai * 64 + m * 16 + fr) * 4 + wc) * 2) = t; }
            }
        asm volatile("s_waitcnt lgkmcnt(0)" ::: "memory"); __builtin_amdgcn_s_barrier(); asm volatile("" ::: "memory");
#pragma unroll
        for (int ai = 0; ai < 2; ++ai)
#pragma unroll
            for (int m = 0; m < 4; ++m) {
                const LAS f32x4* q = (const LAS f32x4*)(xch + (wr * 128 + ai * 64 + m * 16 + fr) * 8); const f32x4 q0 = q[0], q1 = q[1];
                const float M = fmaxf(fmaxf(q0.x, q0.z), fmaxf(q1.x, q1.z));
                const float cc = cr[ai][m];
                const float S = (q0.y * __builtin_amdgcn_exp2f((q0.x - M) * cc) + q0.w * __builtin_amdgcn_exp2f((q0.z - M) * cc)) + (q1.y * __builtin_amdgcn_exp2f((q1.x - M) * cc) + q1.w * __builtin_amdgcn_exp2f((q1.z - M) * cc));
                const float f = __builtin_amdgcn_exp2f((mw[ai][m] - M) * cc) / S;
                bf16_t* rowp = P + (size_t)u.z * cZ + (size_t)(u.pm * BM + ai * HALF + wr * 64 + m * 16 + fr) * ldc + u.pn * BM + wc * 32 + 8 * fq;
#pragma unroll
                for (int bj = 0; bj < 2; ++bj) { const f32x4 v0 = acc[ai][bj][m][0] * f, v1 = acc[ai][bj][m][1] * f;
                    u32x4 w; w.x = cvt_pk_c(v0[0], v0[1]); w.y = cvt_pk_c(v0[2], v0[3]); w.z = cvt_pk_c(v1[0], v1[1]); w.w = cvt_pk_c(v1[2], v1[3]);
                    *(u32x4*)(rowp + bj * HALF) = w; }
            }
    }
};

template <class Epi>
__device__ __forceinline__ void gemm_phase(LAS unsigned char* lds, const Gemm g, const Order& S, const Epi& E) {
    int tid_ = threadIdx.x; asm volatile("" : "+v"(tid_));
    const int tid = tid_, wid = __builtin_amdgcn_readfirstlane(tid >> 6), lane = tid & 63, wr = wid >> 2, wc = wid & 3, fr = lane & 15, fq = lane >> 4;
    const int K = g.K, nt = K / BK;
    unsigned voffA[2], voffB[2];
#pragma unroll
    for (int i = 0; i < 2; ++i) { int R, C; stage_rc(tid * 16 + i * 8192, R, C); const int Rb = Epi::PERM ? ((R & ~31) + perm32(R & 31)) : R;
        const int Ra = Epi::PERMA ? ((R & ~63) + 4 * (R & 15) + ((R >> 4) & 3)) : R;
        voffA[i] = (unsigned)(Ra * g.lda + C) * 2u; voffB[i] = (unsigned)(Rb * g.ldb + C) * 2u; }
    const size_t kstep = (size_t)(BK * 2);
    const size_t hsA = (size_t)HALF * g.lda * 2, hsB = (size_t)HALF * g.ldb * 2;
    const unsigned ldsw = (unsigned)wid * 1024u;
    const int aoff = lds_byte(wr * 64 + fr, fq * 8), boff = lds_byte(wc * 32 + fr, fq * 8);
#define PG8_SA(b, h) (((b) * 2 + (h)) * HTB)
#define PG8_SB(b, h) ((4 + (b) * 2 + (h)) * HTB)
#define PG8_STAGE(bufoff, gbase, voff) do { _Pragma("unroll") for (int _i = 0; _i < 2; ++_i) \
        __builtin_amdgcn_global_load_lds((const unsigned*)((const char*)(gbase) + (voff)[_i]), (LAS unsigned*)(lds + (bufoff) + ldsw + _i * 8192), 16, 0, 0); } while (0)
#define PG8_LDA(dst, b, h) do { _Pragma("unroll") for (int m = 0; m < 4; ++m) _Pragma("unroll") for (int k = 0; k < 2; ++k) dst[m][k] = *(const LAS bf16x8*)(lds + PG8_SA(b, h) + aoff + m * 2048 + k * 1024); } while (0)
#define PG8_LDB(dst, b, h) do { _Pragma("unroll") for (int n = 0; n < 2; ++n) _Pragma("unroll") for (int k = 0; k < 2; ++k) dst[n][k] = *(const LAS bf16x8*)(lds + PG8_SB(b, h) + boff + n * 2048 + k * 1024); } while (0)
#define PG8_MMA(ai, bj, At, Bt) do { __builtin_amdgcn_s_setprio(1); _Pragma("unroll") for (int m = 0; m < 4; ++m) _Pragma("unroll") for (int n = 0; n < 2; ++n) _Pragma("unroll") for (int k = 0; k < 2; ++k) \
        acc[ai][bj][m][n] = __builtin_amdgcn_mfma_f32_16x16x32_bf16(Bt[n][k], At[m][k], acc[ai][bj][m][n], 0, 0, 0); __builtin_amdgcn_s_setprio(0); } while (0)
#define PG8_WAIT_V(n) asm volatile("s_waitcnt vmcnt(" #n ")" ::: "memory")
#define PG8_WAIT_L(n) asm volatile("s_waitcnt lgkmcnt(" #n ")" ::: "memory")
#define PG8_BAR __builtin_amdgcn_s_barrier()
#define PG8_SCHED __builtin_amdgcn_sched_barrier(0)
    Unit cur, nxt; int ui = 0;
    if (!S.next(0, cur)) return;
    f32x4 acc[2][2][4][2];
#pragma unroll
    for (int a = 0; a < 2; ++a)
#pragma unroll
        for (int b = 0; b < 2; ++b)
#pragma unroll
            for (int m = 0; m < 4; ++m)
#pragma unroll
                for (int n = 0; n < 2; ++n) acc[a][b][m][n] = (f32x4){0.f, 0.f, 0.f, 0.f};
    bf16x8 At[4][2], B0[2][2], B1[2][2];
    const char* cA = a_ptr(g, cur); const char* cB = b_ptr(g, cur);
    PG8_STAGE(PG8_SB(0, 0), cB, voffB); PG8_STAGE(PG8_SA(0, 0), cA, voffA); PG8_STAGE(PG8_SB(0, 1), cB + hsB, voffB); PG8_STAGE(PG8_SA(0, 1), cA + hsA, voffA);
    if (wr == 1) PG8_BAR;
    PG8_WAIT_V(4); PG8_BAR;
    PG8_STAGE(PG8_SB(1, 0), cB + kstep, voffB); PG8_STAGE(PG8_SA(1, 0), cA + kstep, voffA); PG8_STAGE(PG8_SB(1, 1), cB + hsB + kstep, voffB);
    PG8_WAIT_V(6); PG8_BAR;
    for (;;) {
        const bool has_next = S.next(ui + 1, nxt);
        const char* nA = has_next ? a_ptr(g, nxt) : cA; const char* nB = has_next ? b_ptr(g, nxt) : cB;
        for (int t = 0; t < nt; t += 2) {
            const bool last = (t == nt - 2);
            const char* a1 = cA + (size_t)(t + 1) * kstep;
            const char* a2 = last ? nA : cA + (size_t)(t + 2) * kstep; const char* b2 = last ? nB : cB + (size_t)(t + 2) * kstep;
            const char* a3 = a2 + kstep; const char* b3 = b2 + kstep;
            PG8_LDB(B0, 0, 0); PG8_SCHED; PG8_LDA(At, 0, 0); PG8_STAGE(PG8_SA(1, 1), a1 + hsA, voffA);
            PG8_WAIT_L(8); PG8_BAR; PG8_WAIT_L(0); PG8_MMA(0, 0, At, B0); PG8_BAR; PG8_SCHED;
            PG8_LDB(B1, 0, 1); PG8_STAGE(PG8_SB(0, 0), b2, voffB);
            PG8_BAR; PG8_WAIT_L(0); PG8_MMA(0, 1, At, B1); PG8_BAR;
            PG8_LDA(At, 0, 1); PG8_STAGE(PG8_SA(0, 0), a2, voffA);
            PG8_BAR; PG8_WAIT_L(0); PG8_MMA(1, 0, At, B0); PG8_BAR; PG8_SCHED;
            PG8_STAGE(PG8_SB(0, 1), b2 + hsB, voffB);
            PG8_WAIT_V(6); PG8_BAR; PG8_MMA(1, 1, At, B1); PG8_BAR;
            PG8_LDB(B0, 1, 0); PG8_SCHED; PG8_LDA(At, 1, 0); PG8_STAGE(PG8_SA(0, 1), a2 + hsA, voffA);
            PG8_WAIT_L(8); PG8_BAR; PG8_WAIT_L(0); PG8_MMA(0, 0, At, B0); PG8_BAR; PG8_SCHED;
            PG8_LDB(B1, 1, 1); PG8_STAGE(PG8_SB(1, 0), b3, voffB);
            PG8_BAR; PG8_WAIT_L(0); PG8_MMA(0, 1, At, B1); PG8_BAR;
            PG8_LDA(At, 1, 1); PG8_STAGE(PG8_SA(1, 0), a3, voffA);
            PG8_BAR; PG8_WAIT_L(0); PG8_MMA(1, 0, At, B0); PG8_BAR; PG8_SCHED;
            PG8_STAGE(PG8_SB(1, 1), b3 + hsB, voffB);
            PG8_WAIT_V(6); PG8_BAR; PG8_MMA(1, 1, At, B1); PG8_BAR;
        }
        E(acc, cur, wr, wc, fr, fq);
        if (!has_next) break;
#pragma unroll
        for (int a = 0; a < 2; ++a)
#pragma unroll
            for (int b = 0; b < 2; ++b)
#pragma unroll
                for (int m = 0; m < 4; ++m)
#pragma unroll
                    for (int n = 0; n < 2; ++n) acc[a][b][m][n] = (f32x4){0.f, 0.f, 0.f, 0.f};
        cur = nxt; cA = nA; cB = nB; ++ui;
    }
    PG8_WAIT_V(0);
    if (wr == 0) PG8_BAR;
    PG8_BAR;
#undef PG8_SA
#undef PG8_SB
#undef PG8_STAGE
#undef PG8_LDA
#undef PG8_LDB
#undef PG8_MMA
#undef PG8_WAIT_V
#undef PG8_WAIT_L
#undef PG8_BAR
#undef PG8_SCHED
}
}
#define XB_TMO      128
#define XB_XCNT(j)  (256  + 64 * (j))
#define XB_XSUB(j)  (1280 + 64 * (j))
#define XB_XGEN(j)  (2304 + 64 * (j))
#define XB_TOP      3328
#define XB_TOPGEN   3392
#define XCD_BAR_WORDS 3456
#define XB_SPIN_CAP (1u << 20)

__device__ __forceinline__ unsigned xb_ld(unsigned* p)              { return __hip_atomic_load(p, __ATOMIC_RELAXED, __HIP_MEMORY_SCOPE_AGENT); }
__device__ __forceinline__ unsigned xb_add(unsigned* p, unsigned v) { return __hip_atomic_fetch_add(p, v, __ATOMIC_RELAXED, __HIP_MEMORY_SCOPE_AGENT); }
__device__ __forceinline__ unsigned xb_xcc_id() { return (unsigned)__builtin_amdgcn_s_getreg((3 << 11) | 20) & 0xFu; }
#define XB_SPIN(cond, bar) do { unsigned _sp = 0; while (cond) { __builtin_amdgcn_s_sleep(1); \
    if ((++_sp & 255u) == 0u) { if (xb_ld(&(bar)[XB_TMO])) break; if (_sp > XB_SPIN_CAP) { atomicAdd(&(bar)[XB_TMO], 1u); break; } } } } while (0)

struct XcdBarrier { unsigned* bar; unsigned x; volatile LAS unsigned* st; };

__device__ __forceinline__ XcdBarrier xcd_barrier_post(unsigned* bar, volatile LAS unsigned* st) {
    XcdBarrier b; b.bar = bar; b.x = xb_xcc_id(); b.st = st;
    if (threadIdx.x == 0) (void)xb_add(&bar[XB_XCNT(b.x)], 1u);
    return b;
}
__device__ __forceinline__ void xcd_barrier_complete(unsigned* bar, unsigned x, unsigned& nloc, unsigned& nx) {
    const unsigned G = gridDim.x * gridDim.y * gridDim.z;
    unsigned sum, cnt, mine, sp = 0u;
    for (;;) {
        sum = 0u; cnt = 0u; mine = 0u;
#pragma unroll
        for (unsigned j = 0; j < 16; ++j) { const unsigned c = xb_ld(&bar[XB_XCNT(j)]); sum += c; cnt += (c > 0u) ? 1u : 0u; mine = (j == x) ? c : mine; }
        if (sum == G) break;
        __builtin_amdgcn_s_sleep(1);
        if ((++sp & 255u) == 0u) { if (xb_ld(&bar[XB_TMO])) break; if (sp > XB_SPIN_CAP) { atomicAdd(&bar[XB_TMO], 1u); break; } }
    }
    nloc = mine > 0u ? mine : 1u; nx = cnt > 0u ? cnt : 1u;
}
__device__ __forceinline__ void xcd_barrier(const XcdBarrier& b) {
    asm volatile("s_waitcnt vmcnt(0)" ::: "memory");
    __syncthreads();
    if (threadIdx.x == 0) {
        unsigned* bar = b.bar;
        __builtin_amdgcn_s_waitcnt(0);
        unsigned nloc = b.st[0], nx = b.st[1];
        if (nloc == 0u) { xcd_barrier_complete(bar, b.x, nloc, nx); b.st[0] = nloc; b.st[1] = nx; }
        const unsigned old = xb_add(&bar[XB_XSUB(b.x)], 1u);
        const unsigned gen = old / nloc;
        if (old + 1u == (gen + 1u) * nloc) {
            __builtin_amdgcn_fence(__ATOMIC_RELEASE, "agent");
            asm volatile("s_waitcnt vmcnt(0)" ::: "memory");
            const unsigned og = xb_add(&bar[XB_TOP], 1u);
            const unsigned tg = og / nx;
            if (og + 1u == (tg + 1u) * nx) xb_add(&bar[XB_TOPGEN], 1u);
            else XB_SPIN(xb_ld(&bar[XB_TOPGEN]) == tg, bar);
            __builtin_amdgcn_fence(__ATOMIC_ACQUIRE, "agent");
            xb_add(&bar[XB_XGEN(b.x)], 1u);
            asm volatile("s_waitcnt vmcnt(0)" ::: "memory");
        } else {
            XB_SPIN(xb_ld(&bar[XB_XGEN(b.x)]) == gen, bar);
            __builtin_amdgcn_fence(__ATOMIC_ACQUIRE, "agent");
            asm volatile("s_waitcnt vmcnt(0)" ::: "memory");
        }
    }
    __syncthreads();
}

struct Args { const float* in[40]; float* out; unsigned char* ws; int l_lo, l_hi, s_lo, s_hi, fused, pad; };
struct Frame {
    LAS unsigned char* lds;
    int tid, lane, wave, G, bid;
    float* out; unsigned char* ws;
    bf16_t* h;
    bf16_t* x16;
};
enum { I_XP = 0, I_XS, I_MP, I_MS, I_NMIX, I_NXA, I_NMEM, I_NFFN, I_WQ, I_WK, I_WV, I_WO, I_FIN, I_FCW, I_FCB, I_FOUT, I_MIN, I_MOUT, I_SCW, I_SCB, I_ALOG, I_DTB, I_SD, I_SNORM,
       I_QN, I_KN, I_HIN, I_HCW, I_HCB, I_FW1, I_FB1, I_FW2, I_FB2, I_FW3, I_FB3, I_FFREQ, I_FWO, I_HSKIP, I_HOUT, I_FNORM };

__device__ __forceinline__ const float* inp(int i) {
    unsigned off = (unsigned)i * 8u; asm volatile("" : "+s"(off));
    const char __attribute__((address_space(4)))* ka = (const char __attribute__((address_space(4)))*)__builtin_amdgcn_kernarg_segment_ptr();
    return *(const float* const __attribute__((address_space(4)))*)(ka + off);
}
__device__ __forceinline__ void tr_item(const float* W, int K, int Nsrc, int c0, bf16_t* WT, int r0, int nblk, LAS float* scr, int item, int lane) {
    const int kb = item / nblk, nb = item % nblk, k0 = 64 * kb, n0 = 32 * nb;
#pragma unroll 8
    for (int i = 0; i < 32; ++i) { const int kk = 2 * i + (lane >> 5); scr[kk * 33 + (lane & 31)] = W[(size_t)(k0 + kk) * Nsrc + c0 + n0 + (lane & 31)]; }
    LDS_WAIT(); asm volatile("" ::: "memory");
    const int c = lane & 7;
#pragma unroll
    for (int j = 0; j < 4; ++j) { const int n = (lane >> 3) + 8 * j; const LAS float* s = scr + (8 * c) * 33 + n;
        u32x4 o; o.x = cvt_pk_bf16(s[0 * 33], s[1 * 33]); o.y = cvt_pk_bf16(s[2 * 33], s[3 * 33]); o.z = cvt_pk_bf16(s[4 * 33], s[5 * 33]); o.w = cvt_pk_bf16(s[6 * 33], s[7 * 33]);
        *(u32x4*)(WT + (size_t)(r0 + n0 + n) * K + k0 + 8 * c) = o; }
    LDS_WAIT(); asm volatile("" ::: "memory");
}
__device__ __forceinline__ void tr_seg(const float* W, int K, int Nsrc, int c0, int ncols, bf16_t* WT, int r0, LAS float* scr, int gw, int NGW, int lane) {
    const int nblk = ncols / 32, nit = (K / 64) * nblk;
    for (int it = gw; it < nit; it += NGW) tr_item(W, K, Nsrc, c0, WT, r0, nblk, scr, it, lane);
}
__device__ __forceinline__ void rms_row(const float* xrow, const float* gain, bf16_t* orow, float* copy, int lane) {
    const f32x4* xr = (const f32x4*)xrow + lane; const f32x4* gr = (const f32x4*)gain + lane;
    f32x4 v[8]; float s = 0.f;
#pragma unroll
    for (int j = 0; j < 8; ++j) { v[j] = xr[64 * j]; s += (v[j].x * v[j].x + v[j].y * v[j].y) + (v[j].z * v[j].z + v[j].w * v[j].w); }
    if (copy) {
#pragma unroll
        for (int j = 0; j < 8; ++j) ((f32x4*)copy + lane)[64 * j] = v[j];
    }
    const float rstd = 1.0f / sqrtf(wave_sum(s) * (1.f / DM) + EPS);
    u32x2* o8 = (u32x2*)orow + lane;
#pragma unroll
    for (int j = 0; j < 8; ++j) { const f32x4 g = gr[64 * j]; u32x2 w; w.x = cvt_pk_bf16(v[j].x * rstd * g.x, v[j].y * rstd * g.y); w.y = cvt_pk_bf16(v[j].z * rstd * g.z, v[j].w * rstd * g.w); o8[64 * j] = w; }
}
__device__ __forceinline__ void phase_rms_x(Frame& F, const float* gain, bool from_inputs) {
    bf16_t* H = F.h; bf16_t* X = F.x16;
    const int gw = F.bid * 8 + F.wave, NGW = F.G * 8, lane = F.lane;
    f32x4 gn[4][2];
#pragma unroll
    for (int j = 0; j < 4; ++j) { gn[j][0] = *(const f32x4*)(gain + j * 512 + lane * 8); gn[j][1] = *(const f32x4*)(gain + j * 512 + lane * 8 + 4); }
    if (from_inputs) {
        for (int m = gw; m < T; m += NGW) {
            float v[4][8]; float s = 0.f;
            const float* src = (m < 4 * SEQ ? inp(I_XP) + (size_t)m * DM : inp(I_XS) + (size_t)(m - 4 * SEQ) * DM);
#pragma unroll
            for (int j = 0; j < 4; ++j) { const f32x4 a = *(const f32x4*)(src + j * 512 + lane * 8), b = *(const f32x4*)(src + j * 512 + lane * 8 + 4);
                v[j][0] = a.x; v[j][1] = a.y; v[j][2] = a.z; v[j][3] = a.w; v[j][4] = b.x; v[j][5] = b.y; v[j][6] = b.z; v[j][7] = b.w;
                *(u32x4*)(X + (size_t)m * DM + j * 512 + lane * 8) = pack8(v[j]); }
#pragma unroll
            for (int j = 0; j < 4; ++j)
#pragma unroll
                for (int i = 0; i < 8; ++i) s += v[j][i] * v[j][i];
            const float rstd = 1.0f / sqrtf(wave_sum(s) * (1.f / DM) + EPS);
#pragma unroll
            for (int j = 0; j < 4; ++j) { const f32x4 g0 = gn[j][0], g1 = gn[j][1];
                float o[8]; o[0] = v[j][0] * rstd * g0.x; o[1] = v[j][1] * rstd * g0.y; o[2] = v[j][2] * rstd * g0.z; o[3] = v[j][3] * rstd * g0.w;
                o[4] = v[j][4] * rstd * g1.x; o[5] = v[j][5] * rstd * g1.y; o[6] = v[j][6] * rstd * g1.z; o[7] = v[j][7] * rstd * g1.w;
                *(u32x4*)(H + (size_t)m * DM + j * 512 + lane * 8) = pack8(o); }
        }
    } else {
        for (int m = gw; m < T; m += 2 * NGW) {
            const int m1 = m + NGW; const bool has1 = m1 < T; const int mb = has1 ? m1 : m;
            u32x4 ra[4], rb[4];
#pragma unroll
            for (int j = 0; j < 4; ++j) { ra[j] = *(const u32x4*)(X + (size_t)m * DM + j * 512 + lane * 8); rb[j] = *(const u32x4*)(X + (size_t)mb * DM + j * 512 + lane * 8); }
#pragma unroll
            for (int q = 0; q < 2; ++q) {
                if (q == 1 && !has1) break;
                float v[4][8]; float s = 0.f;
#pragma unroll
                for (int j = 0; j < 4; ++j) unpack8(q ? rb[j] : ra[j], v[j]);
#pragma unroll
                for (int j = 0; j < 4; ++j)
#pragma unroll
                    for (int i = 0; i < 8; ++i) s += v[j][i] * v[j][i];
                const float rstd = 1.0f / sqrtf(wave_sum(s) * (1.f / DM) + EPS);
                const int mo = q ? m1 : m;
#pragma unroll
                for (int j = 0; j < 4; ++j) { const f32x4 g0 = gn[j][0], g1 = gn[j][1];
                    float o[8]; o[0] = v[j][0] * rstd * g0.x; o[1] = v[j][1] * rstd * g0.y; o[2] = v[j][2] * rstd * g0.z; o[3] = v[j][3] * rstd * g0.w;
                    o[4] = v[j][4] * rstd * g1.x; o[5] = v[j][5] * rstd * g1.y; o[6] = v[j][6] * rstd * g1.z; o[7] = v[j][7] * rstd * g1.w;
                    *(u32x4*)(H + (size_t)mo * DM + j * 512 + lane * 8) = pack8(o); }
            }
        }
    }
}
__device__ __forceinline__ void phase_final_norm(Frame& F) {
    const int gw = F.bid * 8 + F.wave, NGW = F.G * 8, lane = F.lane; const float* gain = inp(I_FNORM); const bf16_t* X = F.x16;
    f32x4 gn[4][2];
#pragma unroll
    for (int j = 0; j < 4; ++j) { gn[j][0] = *(const f32x4*)(gain + j * 512 + lane * 8); gn[j][1] = *(const f32x4*)(gain + j * 512 + lane * 8 + 4); }
    for (int m = gw; m < T; m += 2 * NGW) {
        const int m1 = m + NGW; const bool has1 = m1 < T; const int mb = has1 ? m1 : m;
        u32x4 ra[4], rb[4];
#pragma unroll
        for (int j = 0; j < 4; ++j) { ra[j] = *(const u32x4*)(X + (size_t)m * DM + j * 512 + lane * 8); rb[j] = *(const u32x4*)(X + (size_t)mb * DM + j * 512 + lane * 8); }
#pragma unroll
        for (int q = 0; q < 2; ++q) {
            if (q == 1 && !has1) break;
            float v[4][8]; float s = 0.f; const int mo = q ? m1 : m;
#pragma unroll
            for (int j = 0; j < 4; ++j) unpack8(q ? rb[j] : ra[j], v[j]);
#pragma unroll
            for (int j = 0; j < 4; ++j)
#pragma unroll
                for (int i = 0; i < 8; ++i) s += v[j][i] * v[j][i];
            const float rstd = 1.0f / sqrtf(wave_sum(s) * (1.f / DM) + EPS);
#pragma unroll
            for (int j = 0; j < 4; ++j) { const f32x4 g0 = gn[j][0], g1 = gn[j][1];
                f32x4 o0, o1; o0.x = v[j][0] * rstd * g0.x; o0.y = v[j][1] * rstd * g0.y; o0.z = v[j][2] * rstd * g0.z; o0.w = v[j][3] * rstd * g0.w;
                o1.x = v[j][4] * rstd * g1.x; o1.y = v[j][5] * rstd * g1.y; o1.z = v[j][6] * rstd * g1.z; o1.w = v[j][7] * rstd * g1.w;
                *(f32x4*)(F.out + (size_t)mo * DM + j * 512 + lane * 8) = o0; *(f32x4*)(F.out + (size_t)mo * DM + j * 512 + lane * 8 + 4) = o1; }
        }
    }
}

__device__ __forceinline__ void phase_prep(Frame& F, int layer) {
    LAS float* scr = (LAS float*)(F.lds + F.wave * 8448);
    const int gw = F.bid * 8 + F.wave, NGW = F.G * 8, lane = F.lane;
    unsigned char* ws = F.ws;
    const int e = layer >> 1;
    if (!(layer & 1)) {
        const float* win = inp(I_MIN) + (size_t)e * DM * 8256;
        bf16_t* WI = (bf16_t*)(ws + W_IN);
        tr_seg(win, DM, 8256, 0, 2048, WI, PC_Z, scr, gw, NGW, lane);
        tr_seg(win, DM, 8256, 5184, 2048, WI, PC_Q, scr, gw, NGW, lane);
        tr_seg(win, DM, 8256, 2048, 3072, WI, PC_X, scr, gw, NGW, lane);
        tr_seg(win, DM, 8256, 7232, 512, WI, PC_K, scr, gw, NGW, lane);
        tr_seg(win, DM, 8256, 7744, 512, WI, PC_V, scr, gw, NGW, lane);
        tr_seg(win, DM, 8256, 5120, 64, (bf16_t*)(ws + W_DT), 0, scr, gw, NGW, lane);
        { u32x4* z = (u32x4*)(ws + W_DT + (size_t)64 * DM * 2); const int n16 = 192 * DM * 2 / 16;
          for (int i = F.bid * 512 + F.tid; i < n16; i += F.G * 512) z[i] = (u32x4){0u, 0u, 0u, 0u}; }
        tr_seg(inp(I_MOUT) + (size_t)e * 4096 * DM, 4096, DM, 0, DM, (bf16_t*)(ws + W_OUT), 0, scr, gw, NGW, lane);
    } else {
        tr_seg(inp(I_HIN) + (size_t)e * DM * HYW, DM, HYW, 0, HYW, (bf16_t*)(ws + HW_IN), 0, scr, gw, NGW, lane);
        tr_seg(inp(I_HOUT) + (size_t)e * DM * DM, DM, DM, 0, DM, (bf16_t*)(ws + HW_OUT), 0, scr, gw, NGW, lane);
    }
    { const float* wq = inp(I_WQ) + (size_t)layer * DM * DM; bf16_t* o = (bf16_t*)(ws + W_Q);
      for (int i = F.bid * 512 + F.tid; i < DM * DM / 8; i += F.G * 512) { const f32x4 a = *(const f32x4*)(wq + (size_t)i * 8), b = *(const f32x4*)(wq + (size_t)i * 8 + 4);
          u32x4 w; w.x = cvt_pk_bf16(a.x, a.y); w.y = cvt_pk_bf16(a.z, a.w); w.z = cvt_pk_bf16(b.x, b.y); w.w = cvt_pk_bf16(b.z, b.w); *(u32x4*)(o + (size_t)i * 8) = w; } }
    tr_seg(inp(I_WK) + (size_t)layer * DM * DM, DM, DM, 0, DM, (bf16_t*)(ws + W_K), 0, scr, gw, NGW, lane);
    tr_seg(inp(I_WV) + (size_t)layer * DM * DM, DM, DM, 0, DM, (bf16_t*)(ws + W_V), 0, scr, gw, NGW, lane);
    tr_seg(inp(I_WO) + (size_t)layer * DM * DM, DM, DM, 0, DM, (bf16_t*)(ws + W_O), 0, scr, gw, NGW, lane);
    { const float* fin = inp(I_FIN) + (size_t)layer * DM * F2;
      for (int it = gw; it < 88 * 128; it += NGW) { const int sg = it >> 7, li = it & 127, j = sg >> 1, half = sg & 1;
          tr_item(fin, DM, F2, half * DFF + 128 * j, (bf16_t*)(ws + W_FIN), 128 * sg, 4, scr, li, lane); } }
    tr_seg(inp(I_FOUT) + (size_t)layer * DFF * DM, DFF, DM, 0, DM, (bf16_t*)(ws + W_FOUT), 0, scr, gw, NGW, lane);
    phase_rms_x(F, inp(I_NMIX) + (size_t)layer * DM, layer == 0);
    for (int m = gw; m < MROWS; m += NGW) {
        const float* src = m < 4 * NMEM ? inp(I_MP) + (size_t)m * DM : inp(I_MS) + (size_t)(m - 4 * NMEM) * DM;
        rms_row(src, inp(I_NMEM) + (size_t)layer * DM, (bf16_t*)(ws + WS_MEMN) + (size_t)m * DM, nullptr, lane);
    }
    if (layer & 1) {
        f32x2* tw = (f32x2*)(ws + WS_TW);
        for (int i = F.bid * 512 + F.tid; i < 4096; i += F.G * 512) { float s, c; sincospif(-(float)i * (1.0f / 8192.0f), &s, &c); { f32x2 tv; tv.x = c; tv.y = s; tw[i] = tv; } }
        const float* w1 = inp(I_FW1) + (size_t)e * 33 * 64; const float* b1 = inp(I_FB1) + e * 64;
        const float* w2 = inp(I_FW2) + (size_t)e * 64 * 64; const float* b2 = inp(I_FB2) + e * 64;
        const float* w3 = inp(I_FW3) + (size_t)e * 64 * 64; const float* b3 = inp(I_FB3) + e * 64;
        const float fr = inp(I_FFREQ)[e * 64 + lane];
        float* h3 = (float*)(ws + WS_H3);
        for (int t = gw; t < SEQ; t += NGW) {
            float z = 0.f;
            { const float wt = 6.283185307179586f * (float)t / (float)SEQ;
              if (lane == 0) z = (float)t / (float)(SEQ - 1);
              else if (lane <= 16) { const float f = 1e-4f + (float)(lane - 1) * ((15.0f - 1e-4f) / 15.0f); z = cosf(wt * f); }
              else if (lane <= 32) { const float f = 1e-4f + (float)(lane - 17) * ((15.0f - 1e-4f) / 15.0f); z = -sinf(wt * f); } }
            float a = b1[lane];
            for (int i = 0; i < 33; ++i) a += __shfl(z, i) * w1[i * 64 + lane];
            float h = sinf(fr * a);
            a = b2[lane];
            for (int i = 0; i < 64; ++i) a += __shfl(h, i) * w2[i * 64 + lane];
            h = sinf(fr * a);
            a = b3[lane];
            for (int i = 0; i < 64; ++i) a += __shfl(h, i) * w3[i * 64 + lane];
            h = sinf(fr * a);
            h3[(size_t)t * 64 + lane] = h;
        }
    }
}
__device__ __forceinline__ void phase_ssd_conv(Frame& F, int e) {
    const bf16_t* P = (const bf16_t*)(F.ws + WS_PROJ); bf16_t* XS = F.h; bf16_t* BC = (bf16_t*)(F.ws + WS_BC);
    const float* cw = inp(I_SCW) + (size_t)e * 5 * 3072; const float* cb = inp(I_SCB) + (size_t)e * 3072;
    const int nitem = (T / 16) * 384;
    for (int it = F.bid * 512 + F.tid; it < nitem; it += F.G * 512) {
        const int strip = it / 384, oc = it % 384, ch = oc * 8, m0 = strip * 16, t0 = m0 % SEQ;
        float w[5][8], bias[8];
#pragma unroll
        for (int k = 0; k < 5; ++k) { const f32x4 a = *(const f32x4*)(cw + k * 3072 + ch), b = *(const f32x4*)(cw + k * 3072 + ch + 4);
            w[k][0] = a.x; w[k][1] = a.y; w[k][2] = a.z; w[k][3] = a.w; w[k][4] = b.x; w[k][5] = b.y; w[k][6] = b.z; w[k][7] = b.w; }
        { const f32x4 a = *(const f32x4*)(cb + ch), b = *(const f32x4*)(cb + ch + 4); bias[0] = a.x; bias[1] = a.y; bias[2] = a.z; bias[3] = a.w; bias[4] = b.x; bias[5] = b.y; bias[6] = b.z; bias[7] = b.w; }
        u32x4 raw[20];
#pragma unroll
        for (int k = 0; k < 20; ++k) { const int tt = t0 + k - 2, tc = tt < 0 ? 0 : (tt >= SEQ ? SEQ - 1 : tt);
            raw[k] = *(const u32x4*)(P + (size_t)(m0 - t0 + tc) * PW + PC_X + ch); }
        if (t0 == 0) { raw[0] = (u32x4){0u, 0u, 0u, 0u}; raw[1] = (u32x4){0u, 0u, 0u, 0u}; }
        if (t0 + 16 == SEQ) { raw[18] = (u32x4){0u, 0u, 0u, 0u}; raw[19] = (u32x4){0u, 0u, 0u, 0u}; }
        float win[5][8];
#pragma unroll
        for (int k = 0; k < 4; ++k) unpack8(raw[k], win[k + 1]);
#pragma unroll
        for (int r = 0; r < 16; ++r) {
#pragma unroll
            for (int k = 0; k < 4; ++k)
#pragma unroll
                for (int j = 0; j < 8; ++j) win[k][j] = win[k + 1][j];
            unpack8(raw[r + 4], win[4]);
            float o[8];
#pragma unroll
            for (int j = 0; j < 8; ++j) { float a = bias[j];
#pragma unroll
                for (int k = 0; k < 5; ++k) a += win[k][j] * w[k][j];
                o[j] = silu_f(a); }
            const u32x4 ov = pack8(o);
            if (ch < 2048) *(u32x4*)(XS + (size_t)(m0 + r) * DM + ch) = ov;
            else *(u32x4*)(BC + (size_t)(m0 + r) * 1024 + (ch - 2048)) = ov;
        }
    }
}
__device__ __forceinline__ void phase_qk_rope(Frame& F, int e) {
    bf16_t* P = (bf16_t*)(F.ws + WS_PROJ);
    const int gw = F.bid * 8 + F.wave, NGW = F.G * 8, lane = F.lane;
    const float gq0 = inp(I_QN)[e * 128 + 2 * lane], gq1 = inp(I_QN)[e * 128 + 2 * lane + 1];
    const float gk0 = inp(I_KN)[e * 128 + 2 * lane], gk1 = inp(I_KN)[e * 128 + 2 * lane + 1];
    const float invf = exp2f(-13.287712379549449f * (float)(lane & 31) * (1.0f / 32.0f));
    for (int m = gw; m < T; m += NGW) {
        const int t = m % SEQ; const float pos = (lane < 32) ? (float)(t >> 6) : (float)(t & 63);
        float sn, cs; sincosf(pos * invf, &sn, &cs);
        unsigned* row = (unsigned*)(P + (size_t)m * PW);
        unsigned wv[20];
#pragma unroll
        for (int hd = 0; hd < 20; ++hd) { const int col = (hd < 16) ? (PC_Q + hd * 128) : (PC_K + (hd - 16) * 128); wv[hd] = row[(col >> 1) + lane]; }
#pragma unroll
        for (int hd = 0; hd < 20; ++hd) {
            const int col = (hd < 16) ? (PC_Q + hd * 128) : (PC_K + (hd - 16) * 128);
            float x0 = bflo(wv[hd]), x1 = bfhi(wv[hd]);
            const float ss = wave_sum(x0 * x0 + x1 * x1);
            const float rstd = __builtin_amdgcn_rsqf(ss * (1.f / 128.f) + EPS);
            x0 *= rstd * (hd < 16 ? gq0 : gk0); x1 *= rstd * (hd < 16 ? gq1 : gk1);
            row[(col >> 1) + lane] = cvt_pk_bf16(x0 * cs - x1 * sn, x0 * sn + x1 * cs);
        }
    }
}
__device__ __forceinline__ void phase_ssd_gate_norm(Frame& F, int e) {
    bf16_t* P = (bf16_t*)(F.ws + WS_PROJ);
    const int gw = F.bid * 8 + F.wave, NGW = F.G * 8, lane = F.lane; const float* gain = inp(I_SNORM) + (size_t)e * DM;
    f32x4 gn[4][2];
#pragma unroll
    for (int j = 0; j < 4; ++j) { gn[j][0] = *(const f32x4*)(gain + j * 512 + lane * 8); gn[j][1] = *(const f32x4*)(gain + j * 512 + lane * 8 + 4); }
    for (int m = gw; m < T; m += 2 * NGW) {
        const int m1 = m + NGW; const bool has1 = m1 < T; const int mb = has1 ? m1 : m;
        u32x4 ya[4], za[4], yb[4], zb[4];
#pragma unroll
        for (int j = 0; j < 4; ++j) { const int c = j * 512 + lane * 8;
            ya[j] = *(const u32x4*)(P + (size_t)m * PW + PC_X + c); za[j] = *(const u32x4*)(P + (size_t)m * PW + PC_Z + c);
            yb[j] = *(const u32x4*)(P + (size_t)mb * PW + PC_X + c); zb[j] = *(const u32x4*)(P + (size_t)mb * PW + PC_Z + c); }
#pragma unroll
        for (int q = 0; q < 2; ++q) {
            if (q == 1 && !has1) break;
            bf16_t* row = P + (size_t)(q ? m1 : m) * PW; float v[4][8]; float s = 0.f;
#pragma unroll
            for (int j = 0; j < 4; ++j) { float y[8], z[8];
                unpack8(q ? yb[j] : ya[j], y); unpack8(q ? zb[j] : za[j], z);
#pragma unroll
                for (int i = 0; i < 8; ++i) { v[j][i] = y[i] * silu_f(z[i]); s += v[j][i] * v[j][i]; } }
            const float rstd = 1.0f / sqrtf(wave_sum(s) * (1.f / DM) + EPS);
#pragma unroll
            for (int j = 0; j < 4; ++j) { const int c = j * 512 + lane * 8; const f32x4 g0 = gn[j][0], g1 = gn[j][1];
                float o[8]; o[0] = v[j][0] * rstd * g0.x; o[1] = v[j][1] * rstd * g0.y; o[2] = v[j][2] * rstd * g0.z; o[3] = v[j][3] * rstd * g0.w;
                o[4] = v[j][4] * rstd * g1.x; o[5] = v[j][5] * rstd * g1.y; o[6] = v[j][6] * rstd * g1.z; o[7] = v[j][7] * rstd * g1.w;
                *(u32x4*)(row + PC_Z + c) = pack8(o); }
        }
    }
}

constexpr int TP = 136;
__device__ __forceinline__ bf16x8 frag16(const LAS unsigned char* tile, int row, int k0, int lane) { return *(const LAS bf16x8*)(tile + row * (TP * 2) + (k0 + 8 * (lane >> 4)) * 2); }
constexpr int SC_CSF = 0, SC_EB = 128, SC_DTF = 256, SC_DTB = 384, SC_RSF = 512, SC_RSB = 640, SC_EBT = 768, SC_WORDS = 772;
__device__ __forceinline__ void ssd_scans(Frame& F, LAS float* sc, const float* dt, int m0, int h, float a_f, float a_b) {
    const int tid = F.tid;
    if (tid < 128) sc[SC_DTF + tid] = dt[(size_t)(m0 + tid) * 64 + h];
    else if (tid < 256) sc[SC_DTB + tid - 128] = dt[(size_t)(m0 + tid - 128) * 64 + 32 + h];
    __syncthreads();
    if (F.wave < 2) {
        const int lane = F.lane; const bool fw = (F.wave == 0);
        const float a0 = sc[(fw ? SC_DTF : SC_DTB) + 2 * lane] * (fw ? a_f : a_b), a1 = sc[(fw ? SC_DTF : SC_DTB) + 2 * lane + 1] * (fw ? a_f : a_b);
        float p = a0 + a1;
#pragma unroll
        for (int o = 1; o < 64; o <<= 1) { const float tt = __shfl_up(p, o); if (lane >= o) p += tt; }
        const float ex = p - (a0 + a1);
        if (fw) { sc[SC_CSF + 2 * lane] = ex + a0; sc[SC_CSF + 2 * lane + 1] = p; }
        else { sc[SC_EB + 2 * lane] = ex; sc[SC_EB + 2 * lane + 1] = ex + a0; if (lane == 63) sc[SC_EBT] = p; }
    }
    __syncthreads();
}
__device__ __forceinline__ void ssd_scans_r(Frame& F, LAS float* sc, float dtv, float a_f, float a_b) {
    const int tid = F.tid;
    if (tid < 128) sc[SC_DTF + tid] = dtv;
    else if (tid < 256) sc[SC_DTB + tid - 128] = dtv;
    LDS_BARRIER();
    if (F.wave < 2) {
        const int lane = F.lane; const bool fw = (F.wave == 0);
        const float a0 = sc[(fw ? SC_DTF : SC_DTB) + 2 * lane] * (fw ? a_f : a_b), a1 = sc[(fw ? SC_DTF : SC_DTB) + 2 * lane + 1] * (fw ? a_f : a_b);
        float p = a0 + a1;
#pragma unroll
        for (int o = 1; o < 64; o <<= 1) { const float tt = __shfl_up(p, o); if (lane >= o) p += tt; }
        const float ex = p - (a0 + a1);
        if (fw) { sc[SC_CSF + 2 * lane] = ex + a0; sc[SC_CSF + 2 * lane + 1] = p; }
        else { sc[SC_EB + 2 * lane] = ex; sc[SC_EB + 2 * lane + 1] = ex + a0; if (lane == 63) sc[SC_EBT] = p; }
    }
    LDS_BARRIER();
}
__device__ __forceinline__ void phase_ssd_states(Frame& F, int e) {
    LAS unsigned char* BT = F.lds; LAS unsigned char* XF = F.lds + 34816; LAS unsigned char* XB = F.lds + 52224; LAS float* sc = (LAS float*)(F.lds + 69632);
    const bf16_t* XS = F.h; const bf16_t* BC = (const bf16_t*)(F.ws + WS_BC); const float* dt = (const float*)(F.ws + WS_DT);
    bf16_t* STF = (bf16_t*)(F.ws + WS_STF); bf16_t* STB = (bf16_t*)(F.ws + WS_STB); float* TOT = (float*)(F.ws + WS_TOT);
    const int tid = F.tid, lane = F.lane, wave = F.wave;
    for (int u = F.bid; u < NSEQ * NCH * SSG; u += F.G) {
        const int g = u % SSG, c = (u / SSG) % NCH, b = u / (SSG * NCH), m0 = b * SEQ + c * SSQ;
        { const int s = tid & 127, og = tid >> 7;
#pragma unroll
          for (int i = 0; i < 4; ++i) { const int n0 = (og * 4 + i) * 8; const u32x4 v = *(const u32x4*)(BC + (size_t)(m0 + s) * 1024 + g * 128 + n0);
              const unsigned ws_[4] = {v.x, v.y, v.z, v.w};
#pragma unroll
              for (int j = 0; j < 8; ++j) *(LAS bf16_t*)(BT + ((n0 + j) * TP + s) * 2) = (bf16_t)((j & 1) ? (ws_[j >> 1] >> 16) : (ws_[j >> 1] & 0xffffu)); } }
        const int ps_ = tid & 127, pog = tid >> 7;
        const float* dtp = dt + (size_t)(m0 + ps_) * 64 + (tid < 128 ? 0 : 32);
        const bf16_t* xp = XS + (size_t)(m0 + ps_) * DM + pog * 16;
        float dtn = dtp[g * 8]; u32x4 xn0 = *(const u32x4*)(xp + g * 512), xn1 = *(const u32x4*)(xp + g * 512 + 8);
        for (int h8 = 0; h8 < 8; ++h8) {
            const int h = g * 8 + h8;
            const float a_f = -__expf(inp(I_ALOG)[e * 64 + h]), a_b = -__expf(inp(I_ALOG)[e * 64 + 32 + h]);
            const float dtv = dtn; const u32x4 xv0 = xn0, xv1 = xn1;
            if (h8 < 7) { dtn = dtp[h + 1]; xn0 = *(const u32x4*)(xp + (h + 1) * 64); xn1 = *(const u32x4*)(xp + (h + 1) * 64 + 8); }
            ssd_scans_r(F, sc, dtv, a_f, a_b);
            { const int s = ps_, og = pog; const float csl = sc[SC_CSF + 127];
              const float wf = sc[SC_DTF + s] * __expf(csl - sc[SC_CSF + s]), wb = sc[SC_DTB + s] * __expf(sc[SC_EB + s]);
#pragma unroll
              for (int i = 0; i < 2; ++i) { const int p0 = (og * 2 + i) * 8; float v[8]; unpack8(i ? xv1 : xv0, v);
#pragma unroll
                  for (int j = 0; j < 8; ++j) { *(LAS bf16_t*)(XF + ((p0 + j) * TP + s) * 2) = f2bf(v[j] * wf); *(LAS bf16_t*)(XB + ((p0 + j) * TP + s) * 2) = f2bf(v[j] * wb); } } }
            LDS_BARRIER();
            { const LAS unsigned char* X = (wave < 4) ? XF : XB; const int nb = (wave & 3) * 32;
              f32x4 acc[4][2];
#pragma unroll
              for (int pt = 0; pt < 4; ++pt)
#pragma unroll
                  for (int nt = 0; nt < 2; ++nt) acc[pt][nt] = (f32x4){0.f, 0.f, 0.f, 0.f};
#pragma unroll
              for (int k0 = 0; k0 < 128; k0 += 32) { bf16x8 a[2], bb[4];
#pragma unroll
                  for (int nt = 0; nt < 2; ++nt) a[nt] = frag16(BT, nb + 8 * ((lane & 15) >> 2) + 4 * nt + (lane & 3), k0, lane);
#pragma unroll
                  for (int pt = 0; pt < 4; ++pt) bb[pt] = frag16(X, pt * 16 + (lane & 15), k0, lane);
#pragma unroll
                  for (int pt = 0; pt < 4; ++pt)
#pragma unroll
                      for (int nt = 0; nt < 2; ++nt) acc[pt][nt] = __builtin_amdgcn_mfma_f32_16x16x32_bf16(a[nt], bb[pt], acc[pt][nt], 0, 0, 0); }
              bf16_t* ST = ((wave < 4) ? STF : STB) + (size_t)((b * NCH + c) * SSH + h) * (SSP * SSN);
#pragma unroll
              for (int pt = 0; pt < 4; ++pt) { const int p = pt * 16 + (lane & 15), n = nb + (lane >> 4) * 8;
                  u32x4 w; w.x = cvt_pk_c(acc[pt][0][0], acc[pt][0][1]); w.y = cvt_pk_c(acc[pt][0][2], acc[pt][0][3]); w.z = cvt_pk_c(acc[pt][1][0], acc[pt][1][1]); w.w = cvt_pk_c(acc[pt][1][2], acc[pt][1][3]);
                  *(u32x4*)(ST + p * SSN + n) = w; } }
            if (tid == 0) { TOT[((b * NCH + c) * SSH + h) * 2] = sc[SC_CSF + 127]; TOT[((b * NCH + c) * SSH + h) * 2 + 1] = sc[SC_EBT]; }
            LDS_BARRIER();
        }
    }
}
__device__ __forceinline__ void phase_ssd_scan(Frame& F) {
    bf16_t* STF = (bf16_t*)(F.ws + WS_STF); bf16_t* STB = (bf16_t*)(F.ws + WS_STB); const float* TOT = (const float*)(F.ws + WS_TOT);
    const int nitem = NSEQ * SSH * 2 * 1024;
    for (int it = F.bid * 512 + F.tid; it < nitem; it += F.G * 512) {
        const int o8 = it & 1023, dir = (it >> 10) & 1, h = (it >> 11) % SSH, b = it / (2048 * SSH);
        bf16_t* base = (dir ? STB : STF) + (size_t)o8 * 8;
        float carry[8];
#pragma unroll
        for (int j = 0; j < 8; ++j) carry[j] = 0.f;
        for (int cc0 = 0; cc0 < NCH; cc0 += 8) {
            u32x4 sv[8]; float tv[8];
#pragma unroll
            for (int k = 0; k < 8; ++k) { const int c = dir ? (NCH - 1 - cc0 - k) : (cc0 + k); const size_t idx = (size_t)((b * NCH + c) * SSH + h);
                sv[k] = *(const u32x4*)(base + idx * (SSP * SSN)); tv[k] = TOT[idx * 2 + dir]; }
#pragma unroll
            for (int k = 0; k < 8; ++k) { const int c = dir ? (NCH - 1 - cc0 - k) : (cc0 + k); const size_t idx = (size_t)((b * NCH + c) * SSH + h);
                float s[8]; unpack8(sv[k], s);
                *(u32x4*)(base + idx * (SSP * SSN)) = pack8(carry);
                const float dec = __expf(tv[k]);
#pragma unroll
                for (int j = 0; j < 8; ++j) carry[j] = carry[j] * dec + s[j]; }
        }
    }
}
__device__ __forceinline__ void phase_ssd_out(Frame& F, int e) {
    LAS unsigned char* CM = F.lds; LAS unsigned char* BM = F.lds + 34816; LAS unsigned char* SF = F.lds + 69632; LAS unsigned char* SB = F.lds + 87040;
    LAS unsigned char* XT = F.lds + 104448; LAS unsigned char* WM = BM; LAS float* sc = (LAS float*)(F.lds + 121856);
    const bf16_t* XS = F.h; const bf16_t* BC = (const bf16_t*)(F.ws + WS_BC); const float* dt = (const float*)(F.ws + WS_DT);
    const bf16_t* STF = (const bf16_t*)(F.ws + WS_STF); const bf16_t* STB = (const bf16_t*)(F.ws + WS_STB); bf16_t* P = (bf16_t*)(F.ws + WS_PROJ);
    const int tid = F.tid, lane = F.lane, wave = F.wave;
    for (int u = F.bid; u < NSEQ * NCH * SSG; u += F.G) {
        const int g = u % SSG, c = (u / SSG) % NCH, b = u / (SSG * NCH), m0 = b * SEQ + c * SSQ;
        { const int r = tid >> 2, q = tid & 3;
#pragma unroll
          for (int i = 0; i < 4; ++i) { const int o = q * 4 + i;
              *(LAS u32x4*)(CM + r * (TP * 2) + o * 16) = *(const u32x4*)(BC + (size_t)(m0 + r) * 1024 + 512 + g * 128 + o * 8);
              *(LAS u32x4*)(BM + r * (TP * 2) + o * 16) = *(const u32x4*)(BC + (size_t)(m0 + r) * 1024 + g * 128 + o * 8); } }
        LDS_BARRIER();
        const int lb = (wave >> 1) * 32, sb = (wave & 1) * 64;
        f32x4 cb[2][4];
#pragma unroll
        for (int lt = 0; lt < 2; ++lt)
#pragma unroll
            for (int st = 0; st < 4; ++st) cb[lt][st] = (f32x4){0.f, 0.f, 0.f, 0.f};
#pragma unroll
        for (int k0 = 0; k0 < 128; k0 += 32) { bf16x8 a[4], bb[2];
#pragma unroll
            for (int st = 0; st < 4; ++st) a[st] = frag16(BM, sb + st * 16 + (lane & 15), k0, lane);
#pragma unroll
            for (int lt = 0; lt < 2; ++lt) bb[lt] = frag16(CM, lb + lt * 16 + (lane & 15), k0, lane);
#pragma unroll
            for (int lt = 0; lt < 2; ++lt)
#pragma unroll
                for (int st = 0; st < 4; ++st) cb[lt][st] = __builtin_amdgcn_mfma_f32_16x16x32_bf16(a[st], bb[lt], cb[lt][st], 0, 0, 0); }
        const int ps_ = tid & 127, pog = tid >> 7;
        const float* dtp = dt + (size_t)(m0 + ps_) * 64 + (tid < 128 ? 0 : 32);
        const bf16_t* xp = XS + (size_t)(m0 + ps_) * DM + pog * 16;
        const size_t sb0 = (size_t)((b * NCH + c) * SSH) * (SSP * SSN) + (size_t)tid * 8;
        float dtn = dtp[g * 8]; u32x4 xn0 = *(const u32x4*)(xp + g * 512), xn1 = *(const u32x4*)(xp + g * 512 + 8);
        u32x4 fn0 = *(const u32x4*)(STF + sb0 + (size_t)(g * 8) * 8192), fn1 = *(const u32x4*)(STF + sb0 + (size_t)(g * 8) * 8192 + 4096);
        u32x4 bn0 = *(const u32x4*)(STB + sb0 + (size_t)(g * 8) * 8192), bn1 = *(const u32x4*)(STB + sb0 + (size_t)(g * 8) * 8192 + 4096);
        for (int h8 = 0; h8 < 8; ++h8) {
            const int h = g * 8 + h8;
            const float a_f = -__expf(inp(I_ALOG)[e * 64 + h]), a_b = -__expf(inp(I_ALOG)[e * 64 + 32 + h]), dsk = inp(I_SD)[e * 32 + h];
            const float dtv = dtn;
            {
#pragma unroll
              for (int i = 0; i < 2; ++i) { const int idx = tid + 512 * i, p = idx >> 4, o = idx & 15;
                  *(LAS u32x4*)(SF + p * (TP * 2) + o * 16) = i ? fn1 : fn0; *(LAS u32x4*)(SB + p * (TP * 2) + o * 16) = i ? bn1 : bn0; }
#pragma unroll
              for (int i = 0; i < 2; ++i) { const int p0 = (pog * 2 + i) * 8; const u32x4 v = i ? xn1 : xn0;
                  const unsigned ws_[4] = {v.x, v.y, v.z, v.w};
#pragma unroll
                  for (int j = 0; j < 8; ++j) *(LAS bf16_t*)(XT + ((p0 + j) * TP + ps_) * 2) = (bf16_t)((j & 1) ? (ws_[j >> 1] >> 16) : (ws_[j >> 1] & 0xffffu)); } }
            if (h8 < 7) { dtn = dtp[h + 1]; xn0 = *(const u32x4*)(xp + (h + 1) * 64); xn1 = *(const u32x4*)(xp + (h + 1) * 64 + 8);
                fn0 = *(const u32x4*)(STF + sb0 + (size_t)(h + 1) * 8192); fn1 = *(const u32x4*)(STF + sb0 + (size_t)(h + 1) * 8192 + 4096);
                bn0 = *(const u32x4*)(STB + sb0 + (size_t)(h + 1) * 8192); bn1 = *(const u32x4*)(STB + sb0 + (size_t)(h + 1) * 8192 + 4096); }
            ssd_scans_r(F, sc, dtv, a_f, a_b);
            if (tid < 128) { sc[SC_RSF + tid] = __expf(sc[SC_CSF + tid]); sc[SC_RSB + tid] = __expf(sc[SC_EBT] - sc[SC_EB + tid]); }
#pragma unroll
            for (int lt = 0; lt < 2; ++lt) { const int l = lb + lt * 16 + (lane & 15); const float csl = sc[SC_CSF + l], ebl = sc[SC_EB + l];
#pragma unroll
                for (int st = 0; st < 4; ++st) { const int s0 = sb + st * 16 + (lane >> 4) * 4; float w[4];
                    const int dtile = ((sb >> 4) + st) - ((lb >> 4) + lt);
                    if (dtile < 0) { const f32x4 cs4 = *(const LAS f32x4*)(sc + SC_CSF + s0), d4 = *(const LAS f32x4*)(sc + SC_DTF + s0);
#pragma unroll
                        for (int j = 0; j < 4; ++j) w[j] = cb[lt][st][j] * (__expf(csl - cs4[j]) * d4[j]); }
                    else if (dtile > 0) { const f32x4 eb4 = *(const LAS f32x4*)(sc + SC_EB + s0), d4 = *(const LAS f32x4*)(sc + SC_DTB + s0);
#pragma unroll
                        for (int j = 0; j < 4; ++j) w[j] = cb[lt][st][j] * (__expf(eb4[j] - ebl) * d4[j]); }
                    else { const f32x4 cs4 = *(const LAS f32x4*)(sc + SC_CSF + s0), df4 = *(const LAS f32x4*)(sc + SC_DTF + s0), eb4 = *(const LAS f32x4*)(sc + SC_EB + s0), db4 = *(const LAS f32x4*)(sc + SC_DTB + s0);
#pragma unroll
                        for (int j = 0; j < 4; ++j) { const int s = s0 + j; float mk = 0.f;
                            if (s <= l) mk += __expf(csl - cs4[j]) * df4[j];
                            if (s >= l) mk += __expf(eb4[j] - ebl) * db4[j];
                            w[j] = cb[lt][st][j] * mk + (s == l ? dsk : 0.f); } }
                    u32x2 pk; pk.x = cvt_pk_c(w[0], w[1]); pk.y = cvt_pk_c(w[2], w[3]);
                    *(LAS u32x2*)(WM + (l * TP + s0) * 2) = pk; } }
            LDS_BARRIER();
            { f32x4 aD[4], aF[4], aB[4];
#pragma unroll
              for (int pt = 0; pt < 4; ++pt) { aD[pt] = (f32x4){0.f, 0.f, 0.f, 0.f}; aF[pt] = aD[pt]; aB[pt] = aD[pt]; }
              const int l = wave * 16 + (lane & 15);
#pragma unroll
              for (int k0 = 0; k0 < 128; k0 += 32) { const bf16x8 wv = frag16(WM, l, k0, lane), cv = frag16(CM, l, k0, lane);
#pragma unroll
                  for (int pt = 0; pt < 4; ++pt) { const int pr = pt * 16 + (lane & 15);
                      aD[pt] = __builtin_amdgcn_mfma_f32_16x16x32_bf16(frag16(XT, pr, k0, lane), wv, aD[pt], 0, 0, 0);
                      aF[pt] = __builtin_amdgcn_mfma_f32_16x16x32_bf16(frag16(SF, pr, k0, lane), cv, aF[pt], 0, 0, 0);
                      aB[pt] = __builtin_amdgcn_mfma_f32_16x16x32_bf16(frag16(SB, pr, k0, lane), cv, aB[pt], 0, 0, 0); } }
              const float rsf = sc[SC_RSF + l], rsb = sc[SC_RSB + l];
              bf16_t* yrow = P + (size_t)(m0 + l) * PW + PC_X + h * 64;
#pragma unroll
              for (int pt = 0; pt < 4; ++pt) { const f32x4 y = aD[pt] + aF[pt] * rsf + aB[pt] * rsb; const int p = pt * 16 + (lane >> 4) * 4;
                  u32x2 pk; pk.x = cvt_pk_c(y[0], y[1]); pk.y = cvt_pk_c(y[2], y[3]); *(u32x2*)(yrow + p) = pk; } }
            LDS_BARRIER();
        }
    }
}
namespace att {
constexpr int D = 128, NW = 8, QBLK = 32, KVBLK = 64;
constexpr float SCALE = 0.088388347648318440f;
constexpr float THR = 8.f;
constexpr int LDQ = PW, LDK = PW, LDO = PW;
constexpr size_t SHM_V = KVBLK * D * 2, SHM_K = KVBLK * D * 2, SHM_ATTN = 3 * SHM_V + 2 * SHM_K + NW * 64 * 4;
#define KSWZ(row, colB) ((row) * 256 + ((colB) ^ (((row) & 7) << 4)))
#define SBAR() __builtin_amdgcn_sched_barrier(0)
__device__ __forceinline__ int crow(int r, int hi) { return (r & 3) + 8 * (r >> 2) + 4 * hi; }
__device__ __forceinline__ void partialSM(f32x16& p0, f32x16& p1, float& m_reg, float& mn, float& alpha) {
  constexpr float C = SCALE * 1.4426950408889634f;
  float pmax = p0[0]; for (int r = 1; r < 16; ++r) pmax = fmaxf(pmax, p0[r]); for (int r = 0; r < 16; ++r) pmax = fmaxf(pmax, p1[r]);
  { auto rr = __builtin_amdgcn_permlane32_swap(__float_as_uint(pmax), __float_as_uint(pmax), false, false);
    pmax = fmaxf(__uint_as_float(rr[0]), __uint_as_float(rr[1])); }
  if (__builtin_expect(__all(pmax - m_reg <= THR / SCALE), 1)) { mn = m_reg; alpha = 1.f; }
  else { mn = fmaxf(m_reg, pmax); alpha = __builtin_amdgcn_exp2f((m_reg - mn) * C); m_reg = mn; }
  float mnC = -mn * C;
  for (int r = 0; r < 16; ++r) p0[r] = fmaf(p0[r], C, mnC); for (int r = 0; r < 16; ++r) p1[r] = fmaf(p1[r], C, mnC);
  for (int r = 0; r < 16; ++r) p0[r] = __builtin_amdgcn_exp2f(p0[r]);
}
__device__ __forceinline__ void finishSM(f32x16& p0, f32x16& p1, float alpha, float& l_reg, bf16x8& pa0, bf16x8& pa1, bf16x8& pa2, bf16x8& pa3) {
  for (int r = 0; r < 16; ++r) p1[r] = __builtin_amdgcn_exp2f(p1[r]);
  float ps = 0; for (int r = 0; r < 16; ++r) ps += p0[r]; for (int r = 0; r < 16; ++r) ps += p1[r];
  { auto rr = __builtin_amdgcn_permlane32_swap(__float_as_uint(ps), __float_as_uint(ps), false, false);
    ps = __uint_as_float(rr[0]) + __uint_as_float(rr[1]); }
  l_reg = l_reg * alpha + ps;
#define PK4(P, BASE, OUT) do { unsigned a0 = cvt_pk_bf16(P[BASE + 0], P[BASE + 1]), a1 = cvt_pk_bf16(P[BASE + 2], P[BASE + 3]);   \
    unsigned b0 = cvt_pk_bf16(P[BASE + 4], P[BASE + 5]), b1 = cvt_pk_bf16(P[BASE + 6], P[BASE + 7]);                              \
    auto r0 = __builtin_amdgcn_permlane32_swap(a0, b0, false, false); auto r1 = __builtin_amdgcn_permlane32_swap(a1, b1, false, false); \
    u32x4 w = {r0[0], r1[0], r0[1], r1[1]}; OUT = *reinterpret_cast<bf16x8*>(&w); } while (0)
  PK4(p0, 0, pa0); PK4(p0, 8, pa1); PK4(p1, 0, pa2); PK4(p1, 8, pa3);
#undef PK4
}
__device__ __forceinline__ void qkt(f32x16& p0, f32x16& p1, const bf16_t* Ks, const bf16x8* qr, int r32, int hi) {
  p0 = f32x16{}; p1 = f32x16{};
  for (int d0 = 0; d0 < 8; ++d0) { int cb = (d0 * 16 + hi * 8) * 2;
    bf16x8 b0 = *reinterpret_cast<const bf16x8*>((const char*)Ks + KSWZ(r32, cb));
    bf16x8 b1 = *reinterpret_cast<const bf16x8*>((const char*)Ks + KSWZ(32 + r32, cb));
    p0 = __builtin_amdgcn_mfma_f32_32x32x16_bf16(b0, qr[d0], p0, 0, 0, 0);
    p1 = __builtin_amdgcn_mfma_f32_32x32x16_bf16(b1, qr[d0], p1, 0, 0, 0); }
}
__device__ __forceinline__ int v_st(int k, int c) { const int kk = (k & ~0xC) | ((k & 4) << 1) | ((k & 8) >> 1); return ((kk >> 3) * 4 + (c >> 5)) * 512 + ((kk & 7) * 32 + (c & 31)) * 2; }
__device__ __forceinline__ int v_rd_base(int lane) { return ((lane & 3) << 3) | (((lane >> 2) & 3) << 6) | (((lane >> 4) & 1) << 5) | (((lane >> 5) & 1) << 8); }
constexpr int v_rd_off(int d0, int ks, int half) { return d0 * 512 + ks * 4096 + half * 2048; }
template <int OFF> __device__ __forceinline__ s16x4 tr_read(int vb) {
  s16x4 r; asm volatile("ds_read_b64_tr_b16 %0, %1 offset:%2" : "=&v"(r) : "v"(vb), "i"(OFF) : "memory"); return r;
}
struct VFrag { s16x4 l0, h0, l1, h1, l2, h2, l3, h3; };
template <int D0> __device__ __forceinline__ void v_reads(VFrag& f, int vb) {
  f.l0 = tr_read<v_rd_off(D0, 0, 0)>(vb); f.h0 = tr_read<v_rd_off(D0, 0, 1)>(vb); f.l1 = tr_read<v_rd_off(D0, 1, 0)>(vb); f.h1 = tr_read<v_rd_off(D0, 1, 1)>(vb);
  f.l2 = tr_read<v_rd_off(D0, 2, 0)>(vb); f.h2 = tr_read<v_rd_off(D0, 2, 1)>(vb); f.l3 = tr_read<v_rd_off(D0, 3, 0)>(vb); f.h3 = tr_read<v_rd_off(D0, 3, 1)>(vb);
}
__device__ __forceinline__ void pv_mma(f32x16& od, const VFrag& f, bf16x8 pa0, bf16x8 pa1, bf16x8 pa2, bf16x8 pa3) {
#define PK(L, H) (bf16x8){L[0], L[1], L[2], L[3], H[0], H[1], H[2], H[3]}
  od = __builtin_amdgcn_mfma_f32_32x32x16_bf16(pa0, PK(f.l0, f.h0), od, 0, 0, 0);
  od = __builtin_amdgcn_mfma_f32_32x32x16_bf16(pa1, PK(f.l1, f.h1), od, 0, 0, 0);
  od = __builtin_amdgcn_mfma_f32_32x32x16_bf16(pa2, PK(f.l2, f.h2), od, 0, 0, 0);
  od = __builtin_amdgcn_mfma_f32_32x32x16_bf16(pa3, PK(f.l3, f.h3), od, 0, 0, 0);
#undef PK
}
__device__ __forceinline__ void pv_d0(f32x16* o, int vb, bf16x8 pa0, bf16x8 pa1, bf16x8 pa2, bf16x8 pa3) {
  VFrag A, B;
  v_reads<0>(A, vb); v_reads<1>(B, vb);
  asm volatile("s_waitcnt lgkmcnt(8)" ::: "memory"); SBAR(); pv_mma(o[0], A, pa0, pa1, pa2, pa3); SBAR();
  v_reads<2>(A, vb);
  asm volatile("s_waitcnt lgkmcnt(8)" ::: "memory"); SBAR(); pv_mma(o[1], B, pa0, pa1, pa2, pa3); SBAR();
  v_reads<3>(B, vb);
  asm volatile("s_waitcnt lgkmcnt(8)" ::: "memory"); SBAR(); pv_mma(o[2], A, pa0, pa1, pa2, pa3);
  asm volatile("s_waitcnt lgkmcnt(0)" ::: "memory"); SBAR(); pv_mma(o[3], B, pa0, pa1, pa2, pa3);
}
__device__ __forceinline__ void attn_dense_body(const bf16_t* Qb, const bf16_t* Kh, const bf16_t* Vh,
                                                bf16_t* Ob, int seq, LAS unsigned char* ldsl) {
#if MK_FUSED
  int tid_ = threadIdx.x; asm volatile("" : "+v"(tid_)); const int tid = tid_ & 511;
#else
  const int tid = threadIdx.x;
#endif
  char* lds = (char*)ldsl;
  const int wid = tid >> 6, lane = tid & 63, r32 = lane & 31, hi = lane >> 5, widu = __builtin_amdgcn_readfirstlane(wid);
  bf16_t* V_lds = (bf16_t*)lds; bf16_t* K_lds = (bf16_t*)(lds + 3 * SHM_V);
  float* ws = (float*)(lds + 3 * SHM_V + 2 * SHM_K) + wid * 64; float* li_l = ws; float* al_l = ws + 32;
  float m_reg = -1e30f, l_reg = 0; f32x16 o[4] = {}; bf16x8 qr[8];
  const bf16_t* Qw = Qb + (long)(wid * QBLK + r32) * LDQ + hi * 8;
#pragma unroll
  for (int d0 = 0; d0 < 8; ++d0) qr[d0] = *reinterpret_cast<const bf16x8*>(Qw + d0 * 16);
  const int vb0 = (int)(uintptr_t)V_lds + v_rd_base(lane);
  unsigned kof[2], vof[2];
#pragma unroll
  for (int i = 0; i < 2; ++i) { const int sl = i * 512 + tid, row = sl >> 4, ch = (sl & 15) ^ (row & 7);
    kof[i] = (unsigned)(row * LDK + ch * 8) * 2u;
    const int kk = ((sl >> 7) << 3) | ((sl & 31) >> 2), k = (kk & ~0xC) | ((kk & 4) << 1) | ((kk & 8) >> 1), c = ((sl >> 5) & 3) * 32 + (sl & 3) * 8;
    vof[i] = (unsigned)(k * LDK + c) * 2u; }
  const unsigned ldsw = (unsigned)widu * 1024u;
#define ADMA(t, kb, voff) do { const char* kp_ = (const char*)(Kh + (long)(t) * KVBLK * LDK); const char* vp_ = (const char*)(Vh + (long)(t) * KVBLK * LDK); \
    _Pragma("unroll") for (int i_ = 0; i_ < 2; ++i_) { \
      __builtin_amdgcn_global_load_lds((const unsigned*)(kp_ + kof[i_]), (LAS unsigned*)(ldsl + 3 * SHM_V + (kb) * SHM_K + ldsw + i_ * 8192), 16, 0, 0); \
      __builtin_amdgcn_global_load_lds((const unsigned*)(vp_ + vof[i_]), (LAS unsigned*)(ldsl + (voff) + ldsw + i_ * 8192), 16, 0, 0); } } while (0)
#define AWAIT() asm volatile("s_waitcnt vmcnt(0)" ::: "memory")
#define RESC(a) do { if (__any((a) < 1.f)) { if (hi == 0) al_l[r32] = (a); asm volatile("s_waitcnt lgkmcnt(0)" ::: "memory"); \
    for (int d = 0; d < 4; ++d) for (int r = 0; r < 16; ++r) o[d][r] *= al_l[crow(r, hi)]; } } while (0)
  f32x16 pA0, pA1, pB0, pB1; float mnA, mnB, alA, alB; bf16x8 pa0, pa1, pa2, pa3; const int NT = seq / KVBLK;
  int va = 0, vb = (int)SHM_V, vc = 2 * (int)SHM_V;
  ADMA(0, 0, 0); AWAIT(); __syncthreads();
  ADMA(1, 1, (unsigned)SHM_V);
  qkt(pA0, pA1, K_lds, qr, r32, hi); partialSM(pA0, pA1, m_reg, mnA, alA);
  AWAIT();
  for (int t = 1; t + 1 < NT; t += 2) {
    __syncthreads();
    ADMA(t + 1, 0, (unsigned)vc);
    SBAR(); qkt(pB0, pB1, (bf16_t*)((char*)K_lds + SHM_K), qr, r32, hi);
    finishSM(pA0, pA1, alA, l_reg, pa0, pa1, pa2, pa3); SBAR();
    pv_d0(o, vb0 + va, pa0, pa1, pa2, pa3); partialSM(pB0, pB1, m_reg, mnB, alB);
    RESC(alB);
    AWAIT();
    { const int t_ = va; va = vb; vb = vc; vc = t_; }
    __syncthreads();
    if (t + 2 < NT) ADMA(t + 2, 1, (unsigned)vc);
    SBAR(); qkt(pA0, pA1, K_lds, qr, r32, hi);
    finishSM(pB0, pB1, alB, l_reg, pa0, pa1, pa2, pa3); SBAR();
    pv_d0(o, vb0 + va, pa0, pa1, pa2, pa3); partialSM(pA0, pA1, m_reg, mnA, alA);
    RESC(alA);
    AWAIT();
    { const int t_ = va; va = vb; vb = vc; vc = t_; }
  }
  __syncthreads();
  SBAR(); qkt(pB0, pB1, (bf16_t*)((char*)K_lds + SHM_K), qr, r32, hi);
  finishSM(pA0, pA1, alA, l_reg, pa0, pa1, pa2, pa3); SBAR();
  pv_d0(o, vb0 + va, pa0, pa1, pa2, pa3); partialSM(pB0, pB1, m_reg, mnB, alB);
  RESC(alB);
  finishSM(pB0, pB1, alB, l_reg, pa0, pa1, pa2, pa3); SBAR();
  pv_d0(o, vb0 + vb, pa0, pa1, pa2, pa3);
  if (hi == 0) li_l[r32] = l_reg; asm volatile("s_waitcnt lgkmcnt(0)" ::: "memory");
  float rli[16];
#pragma unroll
  for (int r = 0; r < 16; ++r) rli[r] = __builtin_amdgcn_rcpf(li_l[crow(r, hi)]);
  bf16_t* Ow = Ob + (long)(wid * QBLK) * LDO;
#pragma unroll
  for (int r = 0; r < 16; r += 2) {
    const int odd = lane & 1, orow = crow(r + odd, hi);
    for (int d0 = 0; d0 < 4; ++d0) { const float a = o[d0][r] * rli[r], b = o[d0][r + 1] * rli[r + 1];
      const float recv = __shfl_xor(odd ? a : b, 1);
      *(unsigned*)(Ow + (long)orow * LDO + d0 * 32 + (r32 & ~1)) = odd ? cvt_pk_c(recv, b) : cvt_pk_c(a, recv); } }
#undef ADMA
#undef AWAIT
#undef RESC
}
#undef KSWZ
#undef SBAR
}

__device__ __forceinline__ void phase_attention(Frame& F) {
    bf16_t* P = (bf16_t*)(F.ws + WS_PROJ);
    const int vcu = (F.G % 8 == 0) ? (F.bid % 8) * (F.G / 8) + F.bid / 8 : F.bid;
    for (int u = vcu; u < NSEQ * AH * (SEQ / 256); u += F.G) {
        const int qb = u % (SEQ / 256), h = (u / (SEQ / 256)) % AH, b = u / ((SEQ / 256) * AH), kvh = h / (AH / AKV);
        bf16_t* Qb = P + (size_t)(b * SEQ + qb * 256) * PW + PC_Q + h * AD;
        const bf16_t* Kh = P + (size_t)(b * SEQ) * PW + PC_K + kvh * AD; const bf16_t* Vh = P + (size_t)(b * SEQ) * PW + PC_V + kvh * AD;
        att::attn_dense_body(Qb, Kh, Vh, Qb, SEQ, F.lds);
        __syncthreads();
    }
}
__device__ __forceinline__ void phase_xa_softmax(Frame& F) {
    const float* SC = (const float*)(F.ws + WS_SC); bf16_t* Pm = (bf16_t*)(F.ws + WS_P);
    const int gw = F.bid * 8 + F.wave, NGW = F.G * 8, lane = F.lane;
    for (int m = gw; m < T; m += NGW) {
#pragma unroll
        for (int hh = 0; hh < XAH; ++hh) {
            const f32x4 s = *(const f32x4*)(SC + (size_t)m * 1024 + hh * 256 + lane * 4);
            const float mx = wave_max(fmaxf(fmaxf(s.x, s.y), fmaxf(s.z, s.w)));
            const float e0 = __expf(s.x - mx), e1 = __expf(s.y - mx), e2 = __expf(s.z - mx), e3 = __expf(s.w - mx);
            const float inv = 1.0f / wave_sum((e0 + e1) + (e2 + e3));
            u32x2 w; w.x = cvt_pk_bf16(e0 * inv, e1 * inv); w.y = cvt_pk_bf16(e2 * inv, e3 * inv);
            *(u32x2*)(Pm + (size_t)m * 1024 + hh * 256 + lane * 4) = w;
        }
    }
}
__device__ __forceinline__ void phase_ffn_fix(Frame& F, int layer) {
    const bf16_t* SB = (const bf16_t*)(F.ws + WS_SB); bf16_t* ACT = (bf16_t*)(F.ws + WS_ACT);
    const float* cw = inp(I_FCW) + (size_t)layer * 3 * F2; const float* cb = inp(I_FCB) + (size_t)layer * F2;
    const int nitem = (T / 64) * 2 * (DFF / 8);
    for (int it = F.bid * 512 + F.tid; it < nitem; it += F.G * 512) {
        const int oc = it % (DFF / 8), rest = it / (DFF / 8), which = rest & 1, blk = rest >> 1, f = oc * 8, bs = blk % (SEQ / 64);
        const bf16_t* pp = which ? SB + ((size_t)blk * 4 + 2) * F2 : SB + ((size_t)(blk - 1) * 4 + 3) * F2;
        const bf16_t* ps = which ? SB + ((size_t)blk * 4 + 3) * F2 : SB + ((size_t)blk * 4 + 0) * F2;
        const bf16_t* pn = which ? SB + ((size_t)(blk + 1) * 4 + 0) * F2 : SB + ((size_t)blk * 4 + 1) * F2;
        const bool hasp = which ? true : (bs != 0), hasn = which ? (bs != SEQ / 64 - 1) : true;
        float gp[8], gq[8], gn[8], up[8], uq[8], un[8];
        unpack8(*(const u32x4*)(ps + f), gq); unpack8(*(const u32x4*)(ps + DFF + f), uq);
        if (hasp) { unpack8(*(const u32x4*)(pp + f), gp); unpack8(*(const u32x4*)(pp + DFF + f), up); }
        else {
#pragma unroll
            for (int j = 0; j < 8; ++j) { gp[j] = 0.f; up[j] = 0.f; } }
        if (hasn) { unpack8(*(const u32x4*)(pn + f), gn); unpack8(*(const u32x4*)(pn + DFF + f), un); }
        else {
#pragma unroll
            for (int j = 0; j < 8; ++j) { gn[j] = 0.f; un[j] = 0.f; } }
        float o[8];
#pragma unroll
        for (int j = 0; j < 8; ++j) {
            const float G = cb[f + j] + cw[f + j] * gp[j] + cw[F2 + f + j] * gq[j] + cw[2 * F2 + f + j] * gn[j];
            const float U = cb[DFF + f + j] + cw[DFF + f + j] * up[j] + cw[F2 + DFF + f + j] * uq[j] + cw[2 * F2 + DFF + f + j] * un[j];
            o[j] = silu_f(G) * U; }
        *(u32x4*)(ACT + (size_t)(blk * 64 + (which ? 63 : 0)) * DFF + f) = pack8(o);
    }
}

__device__ __forceinline__ void phase_hy_kern(Frame& F, int e) {
    const float* h3 = (const float*)(F.ws + WS_H3); float* KERN = (float*)(F.ws + WS_KERN); const float* wo = inp(I_FWO) + (size_t)e * 64 * 4096;
    typedef float f32x16c __attribute__((ext_vector_type(16)));
    const f32x16c __attribute__((address_space(4)))* wo16 = (const f32x16c __attribute__((address_space(4)))*)(uintptr_t)wo;
    LAS f32x4* hl = (LAS f32x4*)F.lds;
    for (int u = F.bid; u < 16 * 32; u += F.G) {
        const int tb = u & 15, cbk = u >> 4, t = tb * 512 + F.tid;
#pragma unroll
        for (int j = 0; j < 16; ++j) hl[j * 512 + F.tid] = *(const f32x4*)(h3 + (size_t)t * 64 + j * 4);
        const float tl = (float)t / (float)(SEQ - 1);
#pragma unroll 1
        for (int cb16 = 0; cb16 < 8; ++cb16) {
            const int c2b = __builtin_amdgcn_readfirstlane(cbk * 128 + cb16 * 16);
            float a[16];
#pragma unroll
            for (int i = 0; i < 16; ++i) a[i] = 0.f;
#pragma unroll 1
            for (int j4 = 0; j4 < 16; ++j4) {
                const f32x4 h = hl[j4 * 512 + F.tid];
#pragma unroll
                for (int q = 0; q < 4; ++q) { const f32x16c w16 = wo16[((j4 * 4 + q) * 4096 + c2b) >> 4];
#pragma unroll
                    for (int i = 0; i < 16; ++i) a[i] += h[q] * w16[i]; }
            }
#pragma unroll
            for (int i = 0; i < 16; ++i) {
                const int c2 = c2b + i, ch = c2 & (DM - 1);
                const float delta = fabsf(-3.0701134573253944f + (float)ch * ((-15.350567286626972f + 3.0701134573253944f) / (float)(DM - 1)));
                const float val = a[i] * __expf(-tl * delta);
                if (c2 < DM) KERN[(size_t)ch * FFTN + t] = val;
                else { if (t >= 1) KERN[(size_t)ch * FFTN + FFTN - t] = val; else KERN[(size_t)ch * FFTN + SEQ] = 0.f; }
            }
        }
    }
}
__device__ __forceinline__ void phase_hy_tout(Frame& F, int e) {
    const bf16_t* PHT = (const bf16_t*)(F.ws + WS_PHY); const bf16_t* UT = (const bf16_t*)(F.ws + WS_UT); bf16_t* Y = F.h;
    const float* cw = inp(I_HCW) + (size_t)e * 3 * HYW; const float* cb = inp(I_HCB) + (size_t)e * HYW;
    LAS bf16_t* tile = (LAS bf16_t*)(F.lds + F.wave * (64 * 72 * 2));
    const int gw = F.bid * 8 + F.wave, NGW = F.G * 8, lane = F.lane;
    for (int it = gw; it < (T / 64) * (DM / 64); it += NGW) {
        const int cblk = it % (DM / 64), tblk = it / (DM / 64), m0 = tblk * 64, t0 = m0 % SEQ, b = m0 / SEQ, c0 = cblk * 64;
        u32x4 xw[8], yw[8]; unsigned xl[8], xh[8];
#pragma unroll
        for (int ps = 0; ps < 8; ++ps) { const int c = (lane >> 3) + 8 * ps, to = (lane & 7) * 8, ch = c0 + c, t = t0 + to;
            const bf16_t* xr = PHT + (size_t)ch * T + (size_t)b * SEQ + t;
            xw[ps] = *(const u32x4*)xr; yw[ps] = *(const u32x4*)(UT + ((size_t)(b * DM + ch)) * SEQ + t);
            xl[ps] = t > 0 ? (unsigned)xr[-1] : 0u; xh[ps] = t + 8 < SEQ ? (unsigned)xr[8] : 0u; }
#pragma unroll
        for (int ps = 0; ps < 8; ++ps) {
            const int c = (lane >> 3) + 8 * ps, to = (lane & 7) * 8, ch = c0 + c;
            float x[10], y[8];
            unpack8(xw[ps], *(float (*)[8])&x[1]); unpack8(yw[ps], y);
            x[0] = bf2f(xl[ps]); x[9] = bf2f(xh[ps]);
            const float w0 = cw[ch], w1 = cw[HYW + ch], w2 = cw[2 * HYW + ch], bb = cb[ch];
            float ov[8];
#pragma unroll
            for (int j = 0; j < 8; ++j) ov[j] = (bb + w0 * x[j] + w1 * x[j + 1] + w2 * x[j + 2]) * y[j];
            *(LAS u32x4*)(tile + c * 72 + to) = pack8(ov);
        }
        LDS_WAIT(); asm volatile("" ::: "memory");
        const int o = lane & 7, rs = lane >> 3;
        for (int ps = 0; ps < 8; ++ps) {
            const int r = rs + 8 * ps; unsigned short v[8];
#pragma unroll
            for (int j = 0; j < 8; ++j) v[j] = tile[(o * 8 + j) * 72 + r];
            u32x4 w; w.x = v[0] | ((unsigned)v[1] << 16); w.y = v[2] | ((unsigned)v[3] << 16); w.z = v[4] | ((unsigned)v[5] << 16); w.w = v[6] | ((unsigned)v[7] << 16);
            *(u32x4*)(Y + (size_t)(m0 + r) * DM + c0 + o * 8) = w;
        }
        LDS_WAIT(); asm volatile("" ::: "memory");
    }
}
__device__ __forceinline__ f32x2 mk2(float a, float b) { f32x2 r; r.x = a; r.y = b; return r; }
__device__ __forceinline__ void dft16(f32x2 (&x)[16]) {
  f32x2 a[4][4];
  { const f32x2 s0 = x[0] + x[8], s1 = x[0] - x[8], s2 = x[4] + x[12], t3 = x[4] - x[12]; const f32x2 s3 = mk2(t3.y, -t3.x);
    a[0][0] = s0 + s2; a[0][1] = s1 + s3; a[0][2] = s0 - s2; a[0][3] = s1 - s3; }
  { const f32x2 s0 = x[1] + x[9], s1 = x[1] - x[9], s2 = x[5] + x[13], t3 = x[5] - x[13]; const f32x2 s3 = mk2(t3.y, -t3.x);
    a[1][0] = s0 + s2; a[1][1] = s1 + s3; a[1][2] = s0 - s2; a[1][3] = s1 - s3; }
  { const f32x2 s0 = x[2] + x[10], s1 = x[2] - x[10], s2 = x[6] + x[14], t3 = x[6] - x[14]; const f32x2 s3 = mk2(t3.y, -t3.x);
    a[2][0] = s0 + s2; a[2][1] = s1 + s3; a[2][2] = s0 - s2; a[2][3] = s1 - s3; }
  { const f32x2 s0 = x[3] + x[11], s1 = x[3] - x[11], s2 = x[7] + x[15], t3 = x[7] - x[15]; const f32x2 s3 = mk2(t3.y, -t3.x);
    a[3][0] = s0 + s2; a[3][1] = s1 + s3; a[3][2] = s0 - s2; a[3][3] = s1 - s3; }
  a[1][1] = mk2(a[1][1].x * 0.9238795325112867f - a[1][1].y * -0.3826834323650898f, a[1][1].x * -0.3826834323650898f + a[1][1].y * 0.9238795325112867f);
  a[1][2] = mk2(a[1][2].x * 0.7071067811865476f - a[1][2].y * -0.7071067811865475f, a[1][2].x * -0.7071067811865475f + a[1][2].y * 0.7071067811865476f);
  a[1][3] = mk2(a[1][3].x * 0.38268343236508984f - a[1][3].y * -0.9238795325112867f, a[1][3].x * -0.9238795325112867f + a[1][3].y * 0.38268343236508984f);
  a[2][1] = mk2(a[2][1].x * 0.7071067811865476f - a[2][1].y * -0.7071067811865475f, a[2][1].x * -0.7071067811865475f + a[2][1].y * 0.7071067811865476f);
  a[2][2] = mk2(a[2][2].x * 6.123233995736766e-17f - a[2][2].y * -1.0f, a[2][2].x * -1.0f + a[2][2].y * 6.123233995736766e-17f);
  a[2][3] = mk2(a[2][3].x * -0.7071067811865475f - a[2][3].y * -0.7071067811865476f, a[2][3].x * -0.7071067811865476f + a[2][3].y * -0.7071067811865475f);
  a[3][1] = mk2(a[3][1].x * 0.38268343236508984f - a[3][1].y * -0.9238795325112867f, a[3][1].x * -0.9238795325112867f + a[3][1].y * 0.38268343236508984f);
  a[3][2] = mk2(a[3][2].x * -0.7071067811865475f - a[3][2].y * -0.7071067811865476f, a[3][2].x * -0.7071067811865476f + a[3][2].y * -0.7071067811865475f);
  a[3][3] = mk2(a[3][3].x * -0.9238795325112868f - a[3][3].y * 0.38268343236508967f, a[3][3].x * 0.38268343236508967f + a[3][3].y * -0.9238795325112868f);
  { const f32x2 s0 = a[0][0] + a[2][0], s1 = a[0][0] - a[2][0], s2 = a[1][0] + a[3][0], t3 = a[1][0] - a[3][0]; const f32x2 s3 = mk2(t3.y, -t3.x);
    x[0] = s0 + s2; x[4] = s1 + s3; x[8] = s0 - s2; x[12] = s1 - s3; }
  { const f32x2 s0 = a[0][1] + a[2][1], s1 = a[0][1] - a[2][1], s2 = a[1][1] + a[3][1], t3 = a[1][1] - a[3][1]; const f32x2 s3 = mk2(t3.y, -t3.x);
    x[1] = s0 + s2; x[5] = s1 + s3; x[9] = s0 - s2; x[13] = s1 - s3; }
  { const f32x2 s0 = a[0][2] + a[2][2], s1 = a[0][2] - a[2][2], s2 = a[1][2] + a[3][2], t3 = a[1][2] - a[3][2]; const f32x2 s3 = mk2(t3.y, -t3.x);
    x[2] = s0 + s2; x[6] = s1 + s3; x[10] = s0 - s2; x[14] = s1 - s3; }
  { const f32x2 s0 = a[0][3] + a[2][3], s1 = a[0][3] - a[2][3], s2 = a[1][3] + a[3][3], t3 = a[1][3] - a[3][3]; const f32x2 s3 = mk2(t3.y, -t3.x);
    x[3] = s0 + s2; x[7] = s1 + s3; x[11] = s0 - s2; x[15] = s1 - s3; }
}
constexpr int FFT_PAD_ELEMS = FFTN + FFTN / 16;
__device__ __forceinline__ int pidx(int i) { return i + (i >> 4); }
__device__ __forceinline__ f32x2 cmul(f32x2 a, f32x2 b) { return mk2(a.x * b.x - a.y * b.y, a.x * b.y + a.y * b.x); }
template <bool HALF_IN, int P>
__device__ __forceinline__ void fft_pass16(LAS f32x2* data, const f32x2* tw, f32x2 (&v)[32], int tid) {
    constexpr int sh = 4 * P, Ns = 1 << sh, pst = Ns + (Ns >> 4);
    { const LAS f32x2* rd = data + pidx(tid);
#pragma unroll
      for (int i = 0; i < 2; ++i)
#pragma unroll
          for (int r = 0; r < 16; ++r) { if (HALF_IN && P == 0 && r >= 8) v[16 * i + r] = mk2(0.f, 0.f); else v[16 * i + r] = rd[544 * i + 1088 * r]; } }
    LDS_BARRIER();
#pragma unroll
    for (int i = 0; i < 2; ++i) { const int j = tid + 512 * i, k = j & (Ns - 1);
        f32x2 (&x)[16] = *(f32x2 (*)[16])&v[16 * i];
        if (P > 0) {
            const f32x2 w1 = tw[k * (1024 >> sh)];
            const f32x2 w2 = cmul(w1, w1), w4 = cmul(w2, w2), w8 = cmul(w4, w4);
            x[1] = cmul(x[1], w1); x[2] = cmul(x[2], w2); x[4] = cmul(x[4], w4); x[8] = cmul(x[8], w8);
            { const f32x2 w3 = cmul(w2, w1); x[3] = cmul(x[3], w3); x[6] = cmul(x[6], cmul(w3, w3)); x[11] = cmul(x[11], cmul(w8, w3));
              const f32x2 w7 = cmul(w4, w3); x[7] = cmul(x[7], w7); x[14] = cmul(x[14], cmul(w7, w7)); x[15] = cmul(x[15], cmul(w8, w7)); x[12] = cmul(x[12], cmul(w8, w4)); }
            { const f32x2 w5 = cmul(w4, w1); x[5] = cmul(x[5], w5); x[10] = cmul(x[10], cmul(w5, w5)); x[13] = cmul(x[13], cmul(w8, w5)); x[9] = cmul(x[9], cmul(w8, w1)); }
        }
        dft16(x);
        LAS f32x2* wr = data + pidx(((j >> sh) << (sh + 4)) + k);
#pragma unroll
        for (int r = 0; r < 16; ++r) wr[r * pst] = x[r];
        __builtin_amdgcn_sched_barrier(0); }
    LDS_BARRIER();
}
template <bool HALF_IN>
__device__ __forceinline__ void fft16k(LAS f32x2* data, const f32x2* tw, f32x2 (&v)[32], int tid) {
    fft_pass16<HALF_IN, 0>(data, tw, v, tid); fft_pass16<HALF_IN, 1>(data, tw, v, tid); fft_pass16<HALF_IN, 2>(data, tw, v, tid);
    { const LAS f32x2* rd = data + pidx(tid);
#pragma unroll
      for (int i = 0; i < 8; ++i)
#pragma unroll
          for (int r = 0; r < 4; ++r) v[4 * i + r] = rd[544 * i + 4352 * r]; }
    LDS_BARRIER();
#pragma unroll
    for (int i = 0; i < 8; ++i) { const int j = tid + 512 * i;
        const f32x2 w1 = tw[j], w2 = cmul(w1, w1), w3 = cmul(w2, w1);
        const f32x2 x0 = v[4 * i], x1 = cmul(v[4 * i + 1], w1), x2 = cmul(v[4 * i + 2], w2), x3 = cmul(v[4 * i + 3], w3);
        const f32x2 a = x0 + x2, bq = x0 - x2, c = x1 + x3, d0 = x1 - x3; const f32x2 d = mk2(d0.y, -d0.x);
        v[4 * i] = a + c; v[4 * i + 1] = bq + d; v[4 * i + 2] = a - c; v[4 * i + 3] = bq - d; }
}
__device__ __forceinline__ void phase_hy_fft(Frame& F, int e) {
    LAS f32x2* data = (LAS f32x2*)F.lds; LAS float* red = (LAS float*)(F.lds + FFT_PAD_ELEMS * 8);
    const float* KERN = (const float*)(F.ws + WS_KERN); bf16_t* UT = (bf16_t*)(F.ws + WS_UT); const f32x2* tw = (const f32x2*)(F.ws + WS_TW);
    const bf16_t* PHT = (const bf16_t*)(F.ws + WS_PHY); const float* hcw = inp(I_HCW) + (size_t)e * 3 * HYW; const float* hcb = inp(I_HCB) + (size_t)e * HYW;
    const int tid = F.tid & 511, lane = F.lane, wave = F.wave; const unsigned utid = (unsigned)tid;
    const int pt = pidx(tid), pt8 = 8 * tid + (tid >> 1);
    for (int ch = F.bid; ch < DM; ch += F.G) {
        float asum = 0.f;
        for (int i = 0; i < 32; ++i) { const float val = (KERN + (size_t)ch * FFTN + 512 * i)[utid]; data[pt + 544 * i] = mk2(val, 0.f); asum += fabsf(val); }
        asum = wave_sum(asum);
        if (lane == 0) red[wave] = asum;
        LDS_BARRIER();
        float tot = 0.f;
#pragma unroll
        for (int w = 0; w < 8; ++w) tot += red[w];
        const float kscale = 1.0f / (tot * (float)FFTN), skip = inp(I_HSKIP)[e * DM + ch] * (1.0f / (float)FFTN);
        f32x2 v[32];
        f32x2* ks = (f32x2*)(F.ws + WS_KS) + (size_t)F.bid * FFTN;
        fft16k<false>(data, tw, v, tid);
#pragma unroll
        for (int q = 0; q < 32; ++q) (ks + q * 512)[utid] = mk2(v[q].x * kscale + skip, v[q].y * kscale);
        LDS_BARRIER();
        for (int pi = 0; pi < 3; ++pi) {
            const int b0 = 2 * pi, b1 = 2 * pi + 1;
            bf16_t* u0 = UT + ((size_t)(b0 * DM + ch)) * SEQ; bf16_t* u1 = UT + ((size_t)((b1 < NSEQ ? b1 : b0) * DM + ch)) * SEQ;
            {
              const float a0 = hcw[2048 + ch], a1 = hcw[HYW + 2048 + ch], a2 = hcw[2 * HYW + 2048 + ch], ab = hcb[2048 + ch];
              const float c0 = hcw[4096 + ch], c1 = hcw[HYW + 4096 + ch], c2 = hcw[2 * HYW + 4096 + ch], cbv = hcb[4096 + ch];
              const bf16_t* r1 = PHT + (size_t)(2048 + ch) * T; const bf16_t* rv = PHT + (size_t)(4096 + ch) * T;
#pragma unroll
              for (int i = 0; i < 2; ++i) { const unsigned t8 = (utid + 512u * i) * 8u; float pr[2][8];
#pragma unroll
                  for (int q = 0; q < 2; ++q) { const int bq = q ? b1 : b0;
                      if (bq < NSEQ) { const bf16_t* p1 = r1 + (size_t)bq * SEQ + t8; const bf16_t* pv = rv + (size_t)bq * SEQ + t8; float x[10], w[10];
                          unpack8(*(const u32x4*)p1, *(float (*)[8])&x[1]); unpack8(*(const u32x4*)pv, *(float (*)[8])&w[1]);
                          x[0] = t8 > 0u ? bf2f(p1[-1]) : 0.f; x[9] = t8 + 8u < (unsigned)SEQ ? bf2f(p1[8]) : 0.f;
                          w[0] = t8 > 0u ? bf2f(pv[-1]) : 0.f; w[9] = t8 + 8u < (unsigned)SEQ ? bf2f(pv[8]) : 0.f;
#pragma unroll
                          for (int j = 0; j < 8; ++j) pr[q][j] = (ab + a0 * x[j] + a1 * x[j + 1] + a2 * x[j + 2]) * (cbv + c0 * w[j] + c1 * w[j + 1] + c2 * w[j + 2]); }
                      else {
#pragma unroll
                          for (int j = 0; j < 8; ++j) pr[q][j] = 0.f; } }
#pragma unroll
                  for (int j = 0; j < 8; ++j) data[pt8 + 4352 * i + j] = mk2(pr[0][j], pr[1][j]); } }
            LDS_BARRIER();
            fft16k<true>(data, tw, v, tid);
            LDS_BARRIER();
#pragma unroll
            for (int i = 0; i < 8; ++i)
#pragma unroll
                for (int r = 0; r < 4; ++r) { const f32x2 a = v[4 * i + r], k = (ks + (4 * i + r) * 512)[utid];
                    data[pt + 544 * i + 4352 * r] = mk2(a.x * k.x - a.y * k.y, -(a.x * k.y + a.y * k.x)); }
            LDS_BARRIER();
            fft16k<false>(data, tw, v, tid);
#pragma unroll
            for (int i = 0; i < 8; ++i)
#pragma unroll
                for (int r = 0; r < 2; ++r) { (u0 + 512 * i + 4096 * r)[utid] = f2bf(v[4 * i + r].x); if (b1 < NSEQ) (u1 + 512 * i + 4096 * r)[utid] = f2bf(-v[4 * i + r].y); }
            LDS_BARRIER();
        }
    }
}
constexpr int SPL = 32;
#ifndef EVEN_ON
#define EVEN_ON 1
#endif
#ifndef ODD_ON
#define ODD_ON 1
#endif
#ifndef STEPMASK
#define STEPMASK 0xffffffffu
#endif
#define RUN(k) ((ONLY >= 0) ? ((k) == ONLY) : ((((STEPMASK >> (k)) & 1u) != 0u) && (layer * SPL + (k)) >= args.s_lo && (layer * SPL + (k)) < args.s_hi))
#define PH() do { int t_ = threadIdx.x; asm volatile("" : "+v"(t_)); F.tid = t_; F.lane = t_ & 63; F.wave = __builtin_amdgcn_readfirstlane(t_ >> 6); } while (0)
#ifndef MK_DUP
#define MK_DUP 0u
#endif
#define REP(k) for (int rep_ = 0; rep_ < (((MK_DUP >> (k)) & 1u) ? 2 : 1); ++rep_)
#define SEAM() do { if (ONLY < 0) xcd_barrier(bar); } while (0)
template <int ONLY, int PAR, int LAYER> __device__ __forceinline__ void layer_body(const Args& args, Frame& F, const XcdBarrier& bar) {
    unsigned char* ws = args.ws;
    bf16_t* H = F.h;
    const int layer = (LAYER >= 0) ? LAYER : args.l_lo;
    {
        const int e = layer >> 1;
        if (RUN(0)) { PH(); REP(0) phase_prep(F, layer); SEAM(); }
        if (!(layer & 1) && EVEN_ON && PAR != 1) {
            bf16_t* PR = (bf16_t*)(ws + WS_PROJ);
            if (RUN(1)) { PH();
                { pg8::Gemm g{H, (const bf16_t*)(ws + W_IN), DM, DM, DM, T / 256, PW / 256, 1, 1, 0, 0, 0, 0}; pg8::Order S; S.init(g, F.G, F.bid);
                  pg8::EpiBf16 E{PR, PW, 1, 0, 0, 1.0f}; pg8::gemm_phase(F.lds, g, S, E); }
                { pg8::Gemm g{H, (const bf16_t*)(ws + W_DT), DM, DM, DM, T / 256, 1, 1, 1, 0, 0, 0, 0}; pg8::Order S; S.init(g, F.G, F.bid);
                  pg8::EpiDt E{(float*)(ws + WS_DT), inp(I_DTB) + e * 64}; pg8::gemm_phase(F.lds, g, S, E); }
                { pg8::Gemm g{(const bf16_t*)(ws + WS_MEMN), (const bf16_t*)(ws + W_K), DM, DM, DM, MROWS / 256, DM / 256, 1, 1, 0, 0, 0, 0}; pg8::Order S; S.init(g, F.G, (F.bid + F.G - 160) % F.G);
                  pg8::EpiBf16 E{(bf16_t*)(ws + WS_MK), DM, 1, 0, 0, 1.0f}; pg8::gemm_phase(F.lds, g, S, E); }
                { pg8::Gemm g{(const bf16_t*)(ws + WS_MEMN), (const bf16_t*)(ws + W_V), DM, DM, DM, MROWS / 256, DM / 256, 1, 1, 0, 0, 0, 0}; pg8::Order S; S.init(g, F.G, (F.bid + F.G - 200) % F.G);
                  pg8::EpiBf16 E{(bf16_t*)(ws + WS_MV), DM, 1, 0, 0, 1.0f}; pg8::gemm_phase(F.lds, g, S, E); }
                SEAM();
            }
            if (RUN(2)) { PH(); REP(2) phase_ssd_conv(F, e); phase_qk_rope(F, e); SEAM(); }
            if (RUN(3)) { PH(); REP(3) phase_ssd_states(F, e); SEAM(); }
            if (RUN(4)) { PH(); phase_ssd_scan(F); SEAM(); }
            if (RUN(5)) { PH(); REP(5) phase_ssd_out(F, e); SEAM(); }
            if (RUN(6)) { PH(); phase_attention(F); SEAM(); }
            if (RUN(7)) { PH(); phase_ssd_gate_norm(F, e); SEAM(); }
            if (RUN(8)) { PH();
                pg8::Gemm g{PR, (const bf16_t*)(ws + W_OUT), PW, 4096, 4096, T / 256, DM / 256, 1, 1, 0, 0, 0, 0}; pg8::Order S; S.init(g, F.G, F.bid);
                pg8::EpiResAddPS E{F.x16, DM, (float*)(ws + WS_PS)}; pg8::gemm_phase(F.lds, g, S, E);
                { pg8::Gemm g{(const bf16_t*)(ws + WS_MK), (const bf16_t*)(ws + W_Q), DM, DM, XAD, 1, DM / 256, NSEQ * XAH, XAH, (long)NMEM * DM, XAD, 0, XAD}; pg8::Order S; S.init(g, F.G, F.bid);
                  pg8::EpiBf16G E{(bf16_t*)(ws + WS_WQK), DM, XAH, (long)XAH * NMEM * DM, (long)NMEM * DM, inp(I_NXA) + (size_t)layer * DM}; pg8::gemm_phase(F.lds, g, S, E); }
                SEAM();
            }
        } else if ((layer & 1) && ODD_ON && PAR != 0) {
            if (RUN(1)) { PH();
                { pg8::Gemm g{(const bf16_t*)(ws + HW_IN), H, DM, DM, DM, HYW / 256, T / 256, 1, 1, 0, 0, 0, 0}; pg8::Order S; S.init(g, F.G, F.bid);
                  pg8::EpiBf16 E{(bf16_t*)(ws + WS_PHY), T, 1, 0, 0, 1.0f}; pg8::gemm_phase(F.lds, g, S, E); }
                { pg8::Gemm g{(const bf16_t*)(ws + WS_MEMN), (const bf16_t*)(ws + W_K), DM, DM, DM, MROWS / 256, DM / 256, 1, 1, 0, 0, 0, 0}; pg8::Order S; S.init(g, F.G, F.bid);
                  pg8::EpiBf16 E{(bf16_t*)(ws + WS_MK), DM, 1, 0, 0, 1.0f}; pg8::gemm_phase(F.lds, g, S, E); }
                { pg8::Gemm g{(const bf16_t*)(ws + WS_MEMN), (const bf16_t*)(ws + W_V), DM, DM, DM, MROWS / 256, DM / 256, 1, 1, 0, 0, 0, 0}; pg8::Order S; S.init(g, F.G, (F.bid + F.G - 40) % F.G);
                  pg8::EpiBf16 E{(bf16_t*)(ws + WS_MV), DM, 1, 0, 0, 1.0f}; pg8::gemm_phase(F.lds, g, S, E); }
                REP(24) phase_hy_kern(F, e);
                SEAM();
            }
            if (RUN(3)) { PH(); phase_hy_fft(F, e); SEAM(); }
            if (RUN(4)) { PH(); REP(26) phase_hy_tout(F, e); SEAM(); }
            if (RUN(5)) { PH();
                pg8::Gemm g{H, (const bf16_t*)(ws + HW_OUT), DM, DM, DM, T / 256, DM / 256, 1, 1, 0, 0, 0, 0}; pg8::Order S; S.init(g, F.G, F.bid);
                pg8::EpiResAddPS E{F.x16, DM, (float*)(ws + WS_PS)}; pg8::gemm_phase(F.lds, g, S, E);
                { pg8::Gemm g{(const bf16_t*)(ws + WS_MK), (const bf16_t*)(ws + W_Q), DM, DM, XAD, 1, DM / 256, NSEQ * XAH, XAH, (long)NMEM * DM, XAD, 0, XAD}; pg8::Order S; S.init(g, F.G, F.bid);
                  pg8::EpiBf16G E{(bf16_t*)(ws + WS_WQK), DM, XAH, (long)XAH * NMEM * DM, (long)NMEM * DM, inp(I_NXA) + (size_t)layer * DM}; pg8::gemm_phase(F.lds, g, S, E); }
                SEAM();
            }
        }
        if (RUN(10)) { PH();
            pg8::Gemm g{F.x16, (const bf16_t*)(ws + WS_WQK), DM, DM, DM, SEQ / 256, (XAH * NMEM) / 256, NSEQ, 1, (long)SEQ * DM, 0, (long)XAH * NMEM * DM, 0}; pg8::Order S; S.init(g, F.G, F.bid);
            pg8::EpiSoftmax E{(bf16_t*)(ws + WS_P), XAH * NMEM, (long)SEQ * XAH * NMEM, 0.044194173824159216f * 1.4426950408889634f, (LAS float*)(F.lds + pg8::STAGE_BYTES), (const float*)(ws + WS_PS)}; pg8::gemm_phase(F.lds, g, S, E);
            if (2 * F.bid >= F.G) { pg8::Gemm g2{(const bf16_t*)(ws + W_O), (const bf16_t*)(ws + WS_MV), DM, DM, XAD, DM / 256, 1, NSEQ * XAH, XAH, 0, XAD, (long)NMEM * DM, XAD}; pg8::Order S2; S2.init(g2, F.G - F.G / 2, F.bid - F.G / 2);
                  pg8::EpiBf16 E2{(bf16_t*)(ws + WS_VWOT), XAH * NMEM, XAH, (long)DM * XAH * NMEM, NMEM, 1.0f}; pg8::gemm_phase(F.lds, g2, S2, E2); }
            SEAM();
        }
        if (RUN(14)) { PH();
            pg8::Gemm g{(const bf16_t*)(ws + WS_P), (const bf16_t*)(ws + WS_VWOT), XAH * NMEM, XAH * NMEM, XAH * NMEM, SEQ / 256, DM / 256, NSEQ, 1, (long)SEQ * XAH * NMEM, 0, (long)DM * XAH * NMEM, 0}; pg8::Order S; S.init(g, F.G, F.bid);
            pg8::EpiResAdd E{F.x16, DM, (long)SEQ * DM}; pg8::gemm_phase(F.lds, g, S, E);
            SEAM();
        }
        if (RUN(15)) { PH(); REP(15) phase_rms_x(F, inp(I_NFFN) + (size_t)layer * DM, false); SEAM(); }
        if (RUN(16)) { PH();
            pg8::Gemm g{H, (const bf16_t*)(ws + W_FIN), DM, DM, DM, T / 256, F2 / 256, 1, 1, 0, 0, 0, 0}; pg8::Order S; S.init(g, F.G, F.bid);
            pg8::EpiFfnGate E{(bf16_t*)(ws + WS_ACT), (bf16_t*)(ws + WS_SB), inp(I_FCW) + (size_t)layer * 3 * F2, inp(I_FCB) + (size_t)layer * F2}; pg8::gemm_phase(F.lds, g, S, E);
            SEAM();
        }
        if (RUN(17)) { PH(); phase_ffn_fix(F, layer); SEAM(); }
        if (RUN(21)) { PH();
            pg8::Gemm g{(const bf16_t*)(ws + WS_ACT), (const bf16_t*)(ws + W_FOUT), DFF, DFF, DFF, T / 256, DM / 256, 1, 1, 0, 0, 0, 0}; pg8::Order S; S.init(g, F.G, F.bid);
            pg8::EpiResAdd E{F.x16, DM, 0}; pg8::gemm_phase(F.lds, g, S, E);
            SEAM();
        }
        if (layer == 3 && RUN(22)) { PH(); phase_final_norm(F); }
    }
}
#undef RUN
#undef SEAM
#undef PH
#undef REP
template <int ONLY, int PAR> __device__ __forceinline__ void program(const Args& args) {
    extern __shared__ __attribute__((aligned(16))) unsigned char lds_raw[];
    Frame F;
    F.lds = (LAS unsigned char*)lds_raw;
    F.tid = threadIdx.x; F.lane = F.tid & 63; F.wave = __builtin_amdgcn_readfirstlane(F.tid >> 6);
    F.G = gridDim.x; F.bid = blockIdx.x;
    F.out = args.out; F.ws = args.ws; F.h = (bf16_t*)args.out; F.x16 = (bf16_t*)(args.ws + WS_H);
    unsigned char* ws = args.ws;
    volatile LAS unsigned* MISC = (volatile LAS unsigned*)(F.lds + LDS_CTL);
    if (F.tid < 64) MISC[F.tid] = 0u;
    __syncthreads();
    XcdBarrier bar; bar.bar = (unsigned*)(ws + WS_CTL) + 4096; bar.x = 0; bar.st = nullptr;
    if (ONLY < 0) bar = xcd_barrier_post((unsigned*)(ws + WS_CTL) + 4096, MISC + 8);
    if (ONLY >= 0) layer_body<ONLY, PAR, -1>(args, F, bar);
    else { layer_body<-1, 0, 0>(args, F, bar); layer_body<-1, 1, 1>(args, F, bar); layer_body<-1, 0, 2>(args, F, bar); layer_body<-1, 1, 3>(args, F, bar); }
}
template <int ONLY, int PAR> __global__ void __launch_bounds__(512, 2) trunk_step(Args args) { program<ONLY, PAR>(args); }
__global__ void __launch_bounds__(512, 2) trunk_fwd(Args args) { program<-1, -1>(args); }
typedef void (*StepFn)(Args);
template <int K> struct StepTab { static void fill(StepFn (*t)[2]) { t[K][0] = trunk_step<K, 0>; t[K][1] = trunk_step<K, (K <= 5) ? 1 : 0>; StepTab<K - 1>::fill(t); } };
template <> struct StepTab<-1> { static void fill(StepFn (*)[2]) {} };

static const int kSteps[2][23] = {
    {0, 1, 2, 3, 4, 5, 6, 7, 8, 9, 10, 12, 14, 15, 16, 17, 21, 22, -1, -1, -1, -1, -1},
    {0, 1, 3, 4, 5, 9, 10, 12, 14, 15, 16, 17, 21, 22, -1, -1, -1, -1, -1, -1, -1, -1, -1}};
static StepFn g_steps[23][2];
extern "C" void kernel_launch(void* const* d_in, const int* in_sizes, int n_in, void* d_out, int out_size, void* d_ws, size_t ws_size, hipStream_t stream) {
    static int grid = 0;
    if (grid == 0) {
        if (n_in != 40 || out_size != T * DM || ws_size < WS_END) { fprintf(stderr, "kernel_launch: unexpected shapes: n_in %d out %d ws %zu (need %zu)\n", n_in, out_size, ws_size, (size_t)WS_END); grid = -1; return; }
        int dev = 0, cus = 0;
        if (hipGetDevice(&dev) != hipSuccess || hipDeviceGetAttribute(&cus, hipDeviceAttributeMultiprocessorCount, dev) != hipSuccess) { grid = -1; return; }
        if (hipFuncSetAttribute((const void*)trunk_fwd, hipFuncAttributeMaxDynamicSharedMemorySize, LDS_BYTES) != hipSuccess) { fprintf(stderr, "kernel_launch: hipFuncSetAttribute failed\n"); grid = -1; return; }
#if MK_FUSED != 1
        StepTab<22>::fill(g_steps);
        for (int k = 0; k < 23; ++k) for (int p = 0; p < 2; ++p)
            if (hipFuncSetAttribute((const void*)g_steps[k][p], hipFuncAttributeMaxDynamicSharedMemorySize, LDS_BYTES) != hipSuccess) { fprintf(stderr, "kernel_launch: hipFuncSetAttribute failed (step %d)\n", k); grid = -1; return; }
#endif
        (void)hipGetLastError();
        grid = cus;
    }
    if (grid < 0) return;
    (void)hipMemsetAsync((char*)d_ws + WS_CTL, 0, CTL_BYTES, stream);
    Args a{};
    for (int i = 0; i < 40; ++i) a.in[i] = (const float*)d_in[i];
    a.out = (float*)d_out; a.ws = (unsigned char*)d_ws;
#if MK_FUSED == 1
    { static const int cuts[] = { MK_CUTS };
      const int ncut = (int)(sizeof(cuts) / sizeof(cuts[0]));
      for (int ci = 0; ci + 1 < ncut; ++ci) {
          if (ci > 0) (void)hipMemsetAsync((char*)d_ws + WS_CTL, 0, CTL_BYTES, stream);
          a.l_lo = 0; a.l_hi = 4; a.s_lo = cuts[ci]; a.s_hi = cuts[ci + 1]; a.fused = 1; a.pad = 0;
          hipLaunchKernelGGL(trunk_fwd, dim3(grid), dim3(512), LDS_BYTES, stream, a); } }
#else
    for (int layer = 0; layer < 4; ++layer)
        for (int si = 0; si < 23; ++si) {
            const int k = kSteps[layer & 1][si]; if (k < 0) continue; if (k == 22 && layer != 3) continue;
            a.l_lo = layer; a.l_hi = layer + 1; a.s_lo = layer * SPL + k; a.s_hi = a.s_lo + 1; a.fused = 0; a.pad = 0;
#if MK_FUSED == 2
            if (((MK_FSET >> k) & 1u) && (layer & 1) == MK_FPAR) { (void)hipMemsetAsync((char*)d_ws + WS_CTL, 0, CTL_BYTES, stream); a.l_lo = 0; a.l_hi = 4; hipLaunchKernelGGL(trunk_fwd, dim3(grid), dim3(512), LDS_BYTES, stream, a); continue; }
#endif
            hipLaunchKernelGGL(g_steps[k][layer & 1], dim3(grid), dim3(512), LDS_BYTES, stream, a);
        }
#endif
    const hipError_t le = hipPeekAtLastError();
    if (le != hipSuccess) fprintf(stderr, "kernel_launch: launch failed: %s\n", hipGetErrorName(le));
}
```

```cpp
#include <hip/hip_runtime.h>
#include <cstdio>
#include <cstdint>
#ifndef MK_FUSED
#define MK_FUSED 1
#endif
#ifndef MK_FPAR
#define MK_FPAR 0
#endif
#ifndef MK_FSET
#define MK_FSET 0x8u
#endif
#ifndef MK_CUTS
#define MK_CUTS 0, 128
#endif

#define GAS __attribute__((address_space(1)))
#define LAS __attribute__((address_space(3)))
typedef unsigned short bf16_t;
typedef short bf16x8 __attribute__((ext_vector_type(8)));
typedef short s16x4 __attribute__((ext_vector_type(4)));
typedef float f32x4 __attribute__((ext_vector_type(4)));
typedef float f32x2 __attribute__((ext_vector_type(2)));
typedef float f32x16 __attribute__((ext_vector_type(16)));
typedef unsigned u32x4 __attribute__((ext_vector_type(4)));
typedef unsigned u32x2 __attribute__((ext_vector_type(2)));

constexpr int DM = 2048, SEQ = 8192, NSEQ = 5, T = NSEQ * SEQ, NMEM = 256, MROWS = NSEQ * NMEM;
constexpr int XAH = 4, XAD = 512;
constexpr int SSH = 32, SSP = 64, SSG = 4, SSN = 128, SSQ = 128, NCH = SEQ / SSQ;
constexpr int AH = 16, AKV = 4, AD = 128;
constexpr int PW = 8192, PC_Z = 0, PC_Q = 2048, PC_X = 4096, PC_K = 7168, PC_V = 7680;
constexpr int DFF = 5632, F2 = 11264, HYW = 6144;
constexpr int FCH = 20480, FCHP = 81;
constexpr float EPS = 1e-6f;
constexpr int FFTN = 16384;

constexpr size_t MiB = 1u << 20;
constexpr size_t WS_CTL = 0, CTL_BYTES = 1 * MiB;
constexpr size_t WS_TW = 1 * MiB;
constexpr size_t WS_H3 = 2 * MiB;
constexpr size_t WS_MEMN = 4 * MiB, WS_MK = 9 * MiB, WS_MV = 14 * MiB;
constexpr size_t WS_DT = 19 * MiB;
constexpr size_t WS_TOT = 29 * MiB;
constexpr size_t WS_W = 32 * MiB;
constexpr size_t W_IN = WS_W, W_DT = WS_W + 32 * MiB, W_OUT = WS_W + 33 * MiB;
constexpr size_t HW_IN = WS_W, HW_OUT = WS_W + 24 * MiB;
constexpr size_t W_Q = WS_W + 49 * MiB, W_K = WS_W + 57 * MiB, W_V = WS_W + 65 * MiB, W_O = WS_W + 73 * MiB, W_FIN = WS_W + 81 * MiB, W_FOUT = WS_W + 125 * MiB;
constexpr size_t WS_H = 184 * MiB;
constexpr size_t WS_BIG = 344 * MiB;
constexpr size_t WS_PROJ = WS_BIG, WS_BC = WS_BIG + 640 * MiB, WS_STF = WS_BIG + 720 * MiB, WS_STB = WS_BIG + 880 * MiB;
constexpr size_t WS_SC = WS_BIG + 160 * MiB, WS_P = WS_BIG + 320 * MiB;
constexpr size_t WS_PS = WS_BIG + 700 * MiB;
constexpr size_t WS_WQK = WS_BIG + 640 * MiB, WS_VWOT = WS_BIG + 660 * MiB;
constexpr size_t WS_ACT = WS_BIG, WS_SB = WS_BIG + 440 * MiB;
constexpr size_t WS_PHY = WS_BIG, WS_UT = WS_BIG + 480 * MiB, WS_KERN = WS_BIG + 640 * MiB, WS_KS = WS_BIG + 768 * MiB;
constexpr size_t WS_END = WS_BIG + 1040 * MiB;
static_assert(W_FOUT + (size_t)DM * DFF * 2 <= WS_H, "weights region");
static_assert(WS_ACT + (size_t)T * DFF * 2 <= WS_SB && WS_SB + (size_t)(T / 64) * 4 * F2 * 2 <= WS_END && WS_KERN + (size_t)DM * FFTN * 4 <= WS_END, "big region");

constexpr int LDS_BYTES = 163840, LDS_CTL = 161792;

__device__ __forceinline__ float bf2f(unsigned b) { return __uint_as_float(b << 16); }
__device__ __forceinline__ float bflo(unsigned w) { return __uint_as_float(w << 16); }
__device__ __forceinline__ float bfhi(unsigned w) { return __uint_as_float(w & 0xffff0000u); }
__device__ __forceinline__ unsigned cvt_pk_bf16(float lo, float hi) { unsigned r; asm volatile("v_cvt_pk_bf16_f32 %0, %1, %2" : "=v"(r) : "v"(lo), "v"(hi)); return r; }
typedef __bf16 bf16x2_t __attribute__((ext_vector_type(2)));
__device__ __forceinline__ unsigned cvt_pk_c(float lo, float hi) { f32x2 v; v.x = lo; v.y = hi; bf16x2_t r = __builtin_convertvector(v, bf16x2_t); return __builtin_bit_cast(unsigned, r); }
__device__ __forceinline__ unsigned short f2bf(float f) { return (unsigned short)(cvt_pk_bf16(f, 0.f) & 0xffffu); }
__device__ __forceinline__ float wave_sum(float v) {
#pragma unroll
    for (int o = 1; o < 64; o <<= 1) v += __shfl_xor(v, o);
    return v;
}
__device__ __forceinline__ float wave_max(float v) {
#pragma unroll
    for (int o = 1; o < 64; o <<= 1) v = fmaxf(v, __shfl_xor(v, o));
    return v;
}
__device__ __forceinline__ float silu_f(float x) { return x * __builtin_amdgcn_rcpf(1.f + __builtin_amdgcn_exp2f(x * -1.4426950408889634f)); }
__device__ __forceinline__ void unpack8(const u32x4 w, float (&f)[8]) {
    f[0] = bflo(w.x); f[1] = bfhi(w.x); f[2] = bflo(w.y); f[3] = bfhi(w.y); f[4] = bflo(w.z); f[5] = bfhi(w.z); f[6] = bflo(w.w); f[7] = bfhi(w.w);
}
__device__ __forceinline__ u32x4 pack8(const float (&f)[8]) {
    u32x4 w; w.x = cvt_pk_bf16(f[0], f[1]); w.y = cvt_pk_bf16(f[2], f[3]); w.z = cvt_pk_bf16(f[4], f[5]); w.w = cvt_pk_bf16(f[6], f[7]); return w;
}
#define LDS_WAIT() asm volatile("s_waitcnt lgkmcnt(0)" ::: "memory")
#define LDS_BARRIER() do { asm volatile("s_waitcnt lgkmcnt(0)" ::: "memory"); __builtin_amdgcn_s_barrier(); asm volatile("" ::: "memory"); } while (0)
#define VM_WAIT() asm volatile("s_waitcnt vmcnt(0)" ::: "memory")
namespace pg8 {
constexpr int BM = 256, BK = 64, HALF = 128, HTB = HALF * BK * 2, STAGE_BYTES = 8 * HTB, NXCD = 8, WGM = 8;
__host__ __device__ __forceinline__ int lds_byte(int r, int c) { const int st = (r >> 4) * 2 + (c >> 5), rr = r & 15, cc = c & 31, ob = rr * 64 + cc * 2; return st * 1024 + (ob ^ (((ob >> 9) & 1) << 5)); }
__host__ __device__ __forceinline__ void stage_rc(int b, int& R, int& C) { const int st = b / 1024, sb = b % 1024, swz = sb ^ (((sb >> 9) & 1) << 5); R = (st >> 1) * 16 + swz / 64; C = (st & 1) * 32 + (swz % 64) / 2; }
__host__ __device__ __forceinline__ int perm32(int rho) { const int n = rho >> 4, i = rho & 15; return 8 * (i >> 2) + 4 * n + (i & 3); }

struct Unit { int pm, pn, z; };
struct Gemm { const bf16_t* A; const bf16_t* Bt; int lda, ldb, K, nM, nN, nZ, zdiv; long aZhi, aZlo, bZhi, bZlo; };
__device__ __forceinline__ const char* a_ptr(const Gemm& g, const Unit& u) { return (const char*)g.A + ((size_t)(u.z / g.zdiv) * g.aZhi + (size_t)(u.z % g.zdiv) * g.aZlo + (size_t)u.pm * BM * g.lda) * 2; }
__device__ __forceinline__ const char* b_ptr(const Gemm& g, const Unit& u) { return (const char*)g.Bt + ((size_t)(u.z / g.zdiv) * g.bZhi + (size_t)(u.z % g.zdiv) * g.bZlo + (size_t)u.pn * BM * g.ldb) * 2; }

struct Order {
    int nM, nN, per, nwg, G, c;
    __device__ __forceinline__ void init(const Gemm& g, int G_, int c_) { nM = g.nM; nN = g.nN; per = nM * nN; nwg = per * g.nZ; G = G_; c = c_; }
    __device__ __forceinline__ bool next(int i, Unit& u) const {
        const long Lid = (long)i * G + c; if (Lid >= nwg) return false;
        u.z = (int)(Lid / per); int wgid = (int)(Lid % per);
        { const int q = per / NXCD, r = per % NXCD, xcd = wgid % NXCD, off = wgid / NXCD; wgid = (xcd < r ? xcd * (q + 1) : r * (q + 1) + (xcd - r) * q) + off; }
        const int nig = WGM * nN, gid = wgid / nig, fm = gid * WGM, gsz = (nM - fm) < WGM ? (nM - fm) : WGM;
        u.pm = fm + ((wgid % nig) % gsz); u.pn = (wgid % nig) / gsz; return true;
    }
};

struct EpiBf16 {
    static constexpr bool PERM = true; static constexpr bool PERMA = false;
    bf16_t* O; int ldc, zdiv; long cZhi, cZlo; float scale;
    __device__ __forceinline__ void operator()(const f32x4 (&acc)[2][2][4][2], const Unit& u, int wr, int wc, int fr, int fq) const {
        bf16_t* base = O + (size_t)(u.z / zdiv) * cZhi + (size_t)(u.z % zdiv) * cZlo;
        const int row0 = u.pm * BM + wr * 64 + fr, col0 = u.pn * BM + wc * 32 + 8 * fq;
#pragma unroll
        for (int ai = 0; ai < 2; ++ai)
#pragma unroll
            for (int m = 0; m < 4; ++m) { bf16_t* rowp = base + (size_t)(row0 + ai * HALF + m * 16) * ldc + col0;
#pragma unroll
                for (int bj = 0; bj < 2; ++bj) { const f32x4 v0 = acc[ai][bj][m][0] * scale, v1 = acc[ai][bj][m][1] * scale;
                    u32x4 w; w.x = cvt_pk_bf16(v0[0], v0[1]); w.y = cvt_pk_bf16(v0[2], v0[3]); w.z = cvt_pk_bf16(v1[0], v1[1]); w.w = cvt_pk_bf16(v1[2], v1[3]);
                    *(u32x4*)(rowp + bj * HALF) = w; } }
    }
};
struct EpiF32 {
    static constexpr bool PERM = false; static constexpr bool PERMA = false;
    float* C; int ldc, zdiv; long cZhi, cZlo; float scale;
    __device__ __forceinline__ void operator()(const f32x4 (&acc)[2][2][4][2], const Unit& u, int wr, int wc, int fr, int fq) const {
        float* base = C + (size_t)(u.z / zdiv) * cZhi + (size_t)(u.z % zdiv) * cZlo;
        const int row0 = u.pm * BM + wr * 64 + fr, col0 = u.pn * BM + wc * 32 + 4 * fq;
#pragma unroll
        for (int ai = 0; ai < 2; ++ai)
#pragma unroll
            for (int m = 0; m < 4; ++m) { float* rowp = base + (size_t)(row0 + ai * HALF + m * 16) * ldc + col0;
#pragma unroll
                for (int bj = 0; bj < 2; ++bj)
#pragma unroll
                    for (int n = 0; n < 2; ++n) *(f32x4*)(rowp + bj * HALF + n * 16) = acc[ai][bj][m][n] * scale; }
    }
};
struct EpiResAdd {
    static constexpr bool PERM = true; static constexpr bool PERMA = false;
    bf16_t* X; int ldc; long cZ;
    __device__ __forceinline__ void operator()(const f32x4 (&acc)[2][2][4][2], const Unit& u, int wr, int wc, int fr, int fq) const {
        const int row0 = u.pm * BM + wr * 64 + fr, col0 = u.pn * BM + wc * 32 + 8 * fq;
#pragma unroll
        for (int ai = 0; ai < 2; ++ai) {
            u32x4 old[4][2];
#pragma unroll
            for (int m = 0; m < 4; ++m)
#pragma unroll
                for (int bj = 0; bj < 2; ++bj) old[m][bj] = *(const u32x4*)(X + (size_t)u.z * cZ + (size_t)(row0 + ai * HALF + m * 16) * ldc + col0 + bj * HALF);
#pragma unroll
            for (int m = 0; m < 4; ++m)
#pragma unroll
                for (int bj = 0; bj < 2; ++bj) { float v[8]; unpack8(old[m][bj], v);
                    const f32x4 a0 = acc[ai][bj][m][0], a1 = acc[ai][bj][m][1];
                    u32x4 w; w.x = cvt_pk_c(v[0] + a0[0], v[1] + a0[1]); w.y = cvt_pk_c(v[2] + a0[2], v[3] + a0[3]); w.z = cvt_pk_c(v[4] + a1[0], v[5] + a1[1]); w.w = cvt_pk_c(v[6] + a1[2], v[7] + a1[3]);
                    *(u32x4*)(X + (size_t)u.z * cZ + (size_t)(row0 + ai * HALF + m * 16) * ldc + col0 + bj * HALF) = w; }
            asm volatile("" ::: "memory"); }
    }
};
struct EpiResAddPS {
    static constexpr bool PERM = true; static constexpr bool PERMA = false;
    bf16_t* X; int ldc; float* PS;
    __device__ __forceinline__ void operator()(const f32x4 (&acc)[2][2][4][2], const Unit& u, int wr, int wc, int fr, int fq) const {
        const int row0 = u.pm * BM + wr * 64 + fr, col0 = u.pn * BM + wc * 32 + 8 * fq;
#pragma unroll
        for (int ai = 0; ai < 2; ++ai) {
            u32x4 old[4][2];
#pragma unroll
            for (int m = 0; m < 4; ++m)
#pragma unroll
                for (int bj = 0; bj < 2; ++bj) old[m][bj] = *(const u32x4*)(X + (size_t)(row0 + ai * HALF + m * 16) * ldc + col0 + bj * HALF);
#pragma unroll
            for (int m = 0; m < 4; ++m) { float ss = 0.f;
#pragma unroll
                for (int bj = 0; bj < 2; ++bj) { float v[8]; unpack8(old[m][bj], v);
                    const f32x4 a0 = acc[ai][bj][m][0], a1 = acc[ai][bj][m][1];
                    v[0] += a0[0]; v[1] += a0[1]; v[2] += a0[2]; v[3] += a0[3]; v[4] += a1[0]; v[5] += a1[1]; v[6] += a1[2]; v[7] += a1[3];
                    ss += ((v[0] * v[0] + v[1] * v[1]) + (v[2] * v[2] + v[3] * v[3])) + ((v[4] * v[4] + v[5] * v[5]) + (v[6] * v[6] + v[7] * v[7]));
                    u32x4 w; w.x = cvt_pk_c(v[0], v[1]); w.y = cvt_pk_c(v[2], v[3]); w.z = cvt_pk_c(v[4], v[5]); w.w = cvt_pk_c(v[6], v[7]);
                    *(u32x4*)(X + (size_t)(row0 + ai * HALF + m * 16) * ldc + col0 + bj * HALF) = w; }
                ss += __shfl_xor(ss, 16); ss += __shfl_xor(ss, 32);
                if (fq == 0) PS[(size_t)(row0 + ai * HALF + m * 16) * 32 + u.pn * 4 + wc] = ss; }
            asm volatile("" ::: "memory"); }
    }
};
struct EpiBf16G {
    static constexpr bool PERM = true; static constexpr bool PERMA = false;
    bf16_t* O; int ldc, zdiv; long cZhi, cZlo; const float* cg;
    __device__ __forceinline__ void operator()(const f32x4 (&acc)[2][2][4][2], const Unit& u, int wr, int wc, int fr, int fq) const {
        bf16_t* base = O + (size_t)(u.z / zdiv) * cZhi + (size_t)(u.z % zdiv) * cZlo;
        const int row0 = u.pm * BM + wr * 64 + fr, col0 = u.pn * BM + wc * 32 + 8 * fq;
        f32x4 gn[2][2];
#pragma unroll
        for (int bj = 0; bj < 2; ++bj) { gn[bj][0] = *(const f32x4*)(cg + col0 + bj * HALF); gn[bj][1] = *(const f32x4*)(cg + col0 + bj * HALF + 4); }
#pragma unroll
        for (int ai = 0; ai < 2; ++ai)
#pragma unroll
            for (int m = 0; m < 4; ++m) { bf16_t* rowp = base + (size_t)(row0 + ai * HALF + m * 16) * ldc + col0;
#pragma unroll
                for (int bj = 0; bj < 2; ++bj) { const f32x4 v0 = acc[ai][bj][m][0] * gn[bj][0], v1 = acc[ai][bj][m][1] * gn[bj][1];
                    u32x4 w; w.x = cvt_pk_c(v0[0], v0[1]); w.y = cvt_pk_c(v0[2], v0[3]); w.z = cvt_pk_c(v1[0], v1[1]); w.w = cvt_pk_c(v1[2], v1[3]);
                    *(u32x4*)(rowp + bj * HALF) = w; } }
    }
};
struct EpiDt {
    static constexpr bool PERM = false; static constexpr bool PERMA = false;
    float* DT; const float* bias;
    __device__ __forceinline__ void operator()(const f32x4 (&acc)[2][2][4][2], const Unit& u, int wr, int wc, int fr, int fq) const {
        if (wc >= 2 || u.pn != 0) return;
        const int row0 = u.pm * BM + wr * 64 + fr, col0 = wc * 32 + 4 * fq;
#pragma unroll
        for (int ai = 0; ai < 2; ++ai)
#pragma unroll
            for (int m = 0; m < 4; ++m) { float* rowp = DT + (size_t)(row0 + ai * HALF + m * 16) * 64 + col0;
#pragma unroll
                for (int n = 0; n < 2; ++n) { const f32x4 bv = *(const f32x4*)(bias + col0 + n * 16); f32x4 v = acc[ai][0][m][n] + bv;
#pragma unroll
                    for (int j = 0; j < 4; ++j) v[j] = v[j] > 20.f ? v[j] : log1pf(__expf(v[j]));
                    *(f32x4*)(rowp + n * 16) = v; } }
    }
};

struct EpiFfnGate {
    static constexpr bool PERM = true; static constexpr bool PERMA = true;
    bf16_t* ACT; bf16_t* SB; const float* cw; const float* cb;
    __device__ __forceinline__ void operator()(const f32x4 (&acc)[2][2][4][2], const Unit& u, int wr, int wc, int fr, int fq) const {
        const int lane = fr + 16 * fq, src_prev = (lane & 48) | ((fr + 15) & 15), src_next = (lane & 48) | ((fr + 1) & 15);
        f32x4 wgs[2][3], wus[2][3], bgs[2], bus[2];
#pragma unroll
        for (int n = 0; n < 2; ++n) { const int f = u.pn * 128 + wc * 32 + 8 * fq + 4 * n;
#pragma unroll
            for (int k = 0; k < 3; ++k) { wgs[n][k] = *(const f32x4*)(cw + k * F2 + f); wus[n][k] = *(const f32x4*)(cw + k * F2 + DFF + f); }
            bgs[n] = *(const f32x4*)(cb + f); bus[n] = *(const f32x4*)(cb + DFF + f); }
        const int f0 = u.pn * 128 + wc * 32 + 8 * fq;
#pragma unroll
        for (int ai = 0; ai < 2; ++ai) {
            f32x4 gpl[2], upl[2], gnl[2], unl[2];
#pragma unroll
            for (int n = 0; n < 2; ++n)
#pragma unroll
                for (int j = 0; j < 4; ++j) { gpl[n][j] = __shfl(acc[ai][0][3][n][j], src_prev); upl[n][j] = __shfl(acc[ai][1][3][n][j], src_prev);
                                              gnl[n][j] = __shfl(acc[ai][0][0][n][j], src_next); unl[n][j] = __shfl(acc[ai][1][0][n][j], src_next); }
#pragma unroll
            for (int m = 0; m < 4; ++m) {
                const int lr = 4 * fr + m, row = u.pm * BM + ai * HALF + wr * 64 + lr;
                float o[8];
#pragma unroll
                for (int n = 0; n < 2; ++n) {
                    const f32x4 g0 = acc[ai][0][m][n], u0 = acc[ai][1][m][n];
                    const f32x4 gp = m > 0 ? acc[ai][0][m > 0 ? m - 1 : 0][n] : gpl[n], up = m > 0 ? acc[ai][1][m > 0 ? m - 1 : 0][n] : upl[n];
                    const f32x4 gn = m < 3 ? acc[ai][0][m < 3 ? m + 1 : 3][n] : gnl[n], un = m < 3 ? acc[ai][1][m < 3 ? m + 1 : 3][n] : unl[n];
                    const f32x4 G = bgs[n] + wgs[n][0] * gp + wgs[n][1] * g0 + wgs[n][2] * gn;
                    const f32x4 U = bus[n] + wus[n][0] * up + wus[n][1] * u0 + wus[n][2] * un;
#pragma unroll
                    for (int j = 0; j < 4; ++j) o[4 * n + j] = silu_f(G[j]) * U[j]; }
                if (lr >= 1 && lr <= 62) { u32x4 w; w.x = cvt_pk_c(o[0], o[1]); w.y = cvt_pk_c(o[2], o[3]); w.z = cvt_pk_c(o[4], o[5]); w.w = cvt_pk_c(o[6], o[7]); *(u32x4*)(ACT + (size_t)row * DFF + f0) = w; }
                if (lr <= 1 || lr >= 62) {
                    const int slot = lr <= 1 ? lr : lr - 60; bf16_t* sb = SB + ((size_t)(row >> 6) * 4 + slot) * F2 + f0;
                    const f32x4 ga = acc[ai][0][m][0], gb = acc[ai][0][m][1], ua = acc[ai][1][m][0], ub = acc[ai][1][m][1];
                    u32x4 w; w.x = cvt_pk_c(ga[0], ga[1]); w.y = cvt_pk_c(ga[2], ga[3]); w.z = cvt_pk_c(gb[0], gb[1]); w.w = cvt_pk_c(gb[2], gb[3]); *(u32x4*)sb = w;
                    w.x = cvt_pk_c(ua[0], ua[1]); w.y = cvt_pk_c(ua[2], ua[3]); w.z = cvt_pk_c(ub[0], ub[1]); w.w = cvt_pk_c(ub[2], ub[3]); *(u32x4*)(sb + DFF) = w; }
            }
        }
    }
};

struct EpiSoftmax {
    static constexpr bool PERM = true; static constexpr bool PERMA = false;
    bf16_t* P; int ldc; long cZ; float c; LAS float* xch; const float* PS;
    __device__ __forceinline__ void operator()(f32x4 (&acc)[2][2][4][2], const Unit& u, int wr, int wc, int fr, int fq) const {
        float mw[2][4], cr[2][4];
#pragma unroll
        for (int ai = 0; ai < 2; ++ai)
#pragma unroll
            for (int m = 0; m < 4; ++m) { const float* pp = PS + (size_t)(u.z * SEQ + u.pm * BM + ai * HALF + wr * 64 + m * 16 + fr) * 32 + fq * 8;
                const f32x4 a = *(const f32x4*)pp, b = *(const f32x4*)(pp + 4); float t = ((a.x + a.y) + (a.z + a.w)) + ((b.x + b.y) + (b.z + b.w));
                t += __shfl_xor(t, 16); t += __shfl_xor(t, 32); cr[ai][m] = c * (1.0f / sqrtf(t * (1.f / DM) + EPS)); }
#pragma unroll
        for (int ai = 0; ai < 2; ++ai)
#pragma unroll
            for (int m = 0; m < 4; ++m) {
                float v = -3.0e38f;
#pragma unroll
                for (int bj = 0; bj < 2; ++bj)
#pragma unroll
                    for (int n = 0; n < 2; ++n) { const f32x4 a = acc[ai][bj][m][n]; v = fmaxf(v, fmaxf(fmaxf(a[0], a[1]), fmaxf(a[2], a[3]))); }
                v = fmaxf(v, __shfl_xor(v, 16)); v = fmaxf(v, __shfl_xor(v, 32));
                mw[ai][m] = v;
                float s = 0.f;
#pragma unroll
                for (int bj = 0; bj < 2; ++bj)
#pragma unroll
                    for (int n = 0; n < 2; ++n) { f32x4 a = acc[ai][bj][m][n];
#pragma unroll
                        for (int j = 0; j < 4; ++j) { a[j] = __builtin_amdgcn_exp2f((a[j] - v) * cr[ai][m]); s += a[j]; }
                        acc[ai][bj][m][n] = a; }
                s += __shfl_xor(s, 16); s += __shfl_xor(s, 32);
                if (fq == 0) { f32x2 t; t.x = v; t.y = s; *(LAS f32x2*)(xch + ((wr * 128 + ai * 64 + m * 16 + fr) * 4 + wc) * 2) = t; }
            }
        asm volatile("s_waitcnt lgkmcnt(0)" ::: "memory"); __builtin_amdgcn_s_barrier(); asm volatile("" ::: "memory");
#pragma unroll
        for (int ai = 0; ai < 2; ++ai)
#pragma unroll
            for (int m = 0; m < 4; ++m) {
                const LAS f32x4* q = (const LAS f32x4*)(xch + (wr * 128 + ai * 64 + m * 16 + fr) * 8); const f32x4 q0 = q[0], q1 = q[1];
                const float M = fmaxf(fmaxf(q0.x, q0.z), fmaxf(q1.x, q1.z));
                const float cc = cr[ai][m];
                const float S = (q0.y * __builtin_amdgcn_exp2f((q0.x - M) * cc) + q0.w * __builtin_amdgcn_exp2f((q0.z - M) * cc)) + (q1.y * __builtin_amdgcn_exp2f((q1.x - M) * cc) + q1.w * __builtin_amdgcn_exp2f((q1.z - M) * cc));
                const float f = __builtin_amdgcn_exp2f((mw[ai][m] - M) * cc) / S;
                bf16_t* rowp = P + (size_t)u.z * cZ + (size_t)(u.pm * BM + ai * HALF + wr * 64 + m * 16 + fr) * ldc + u.pn * BM + wc * 32 + 8 * fq;
#pragma unroll
                for (int bj = 0; bj < 2; ++bj) { const f32x4 v0 = acc[ai][bj][m][0] * f, v1 = acc[ai][bj][m][1] * f;
                    u32x4 w; w.x = cvt_pk_c(v0[0], v0[1]); w.y = cvt_pk_c(v0[2], v0[3]); w.z = cvt_pk_c(v1[0], v1[1]); w.w = cvt_pk_c(v1[2], v1[3]);
                    *(u32x4*)(rowp + bj * HALF) = w; }
            }
    }
};

template <class Epi>
__device__ __forceinline__ void gemm_phase(LAS unsigned char* lds, const Gemm g, const Order& S, const Epi& E) {
    int tid_ = threadIdx.x; asm volatile("" : "+v"(tid_));
    const int tid = tid_, wid = __builtin_amdgcn_readfirstlane(tid >> 6), lane = tid & 63, wr = wid >> 2, wc = wid & 3, fr = lane & 15, fq = lane >> 4;
    const int K = g.K, nt = K / BK;
    unsigned voffA[2], voffB[2];
#pragma unroll
    for (int i = 0; i < 2; ++i) { int R, C; stage_rc(tid * 16 + i * 8192, R, C); const int Rb = Epi::PERM ? ((R & ~31) + perm32(R & 31)) : R;
        const int Ra = Epi::PERMA ? ((R & ~63) + 4 * (R & 15) + ((R >> 4) & 3)) : R;
        voffA[i] = (unsigned)(Ra * g.lda + C) * 2u; voffB[i] = (unsigned)(Rb * g.ldb + C) * 2u; }
    const size_t kstep = (size_t)(BK * 2);
    const size_t hsA = (size_t)HALF * g.lda * 2, hsB = (size_t)HALF * g.ldb * 2;
    const unsigned ldsw = (unsigned)wid * 1024u;
    const int aoff = lds_byte(wr * 64 + fr, fq * 8), boff = lds_byte(wc * 32 + fr, fq * 8);
#define PG8_SA(b, h) (((b) * 2 + (h)) * HTB)
#define PG8_SB(b, h) ((4 + (b) * 2 + (h)) * HTB)
#define PG8_STAGE(bufoff, gbase, voff) do { _Pragma("unroll") for (int _i = 0; _i < 2; ++_i) \
        __builtin_amdgcn_global_load_lds((const unsigned*)((const char*)(gbase) + (voff)[_i]), (LAS unsigned*)(lds + (bufoff) + ldsw + _i * 8192), 16, 0, 0); } while (0)
#define PG8_LDA(dst, b, h) do { _Pragma("unroll") for (int m = 0; m < 4; ++m) _Pragma("unroll") for (int k = 0; k < 2; ++k) dst[m][k] = *(const LAS bf16x8*)(lds + PG8_SA(b, h) + aoff + m * 2048 + k * 1024); } while (0)
#define PG8_LDB(dst, b, h) do { _Pragma("unroll") for (int n = 0; n < 2; ++n) _Pragma("unroll") for (int k = 0; k < 2; ++k) dst[n][k] = *(const LAS bf16x8*)(lds + PG8_SB(b, h) + boff + n * 2048 + k * 1024); } while (0)
#define PG8_MMA(ai, bj, At, Bt) do { __builtin_amdgcn_s_setprio(1); _Pragma("unroll") for (int m = 0; m < 4; ++m) _Pragma("unroll") for (int n = 0; n < 2; ++n) _Pragma("unroll") for (int k = 0; k < 2; ++k) \
        acc[ai][bj][m][n] = __builtin_amdgcn_mfma_f32_16x16x32_bf16(Bt[n][k], At[m][k], acc[ai][bj][m][n], 0, 0, 0); __builtin_amdgcn_s_setprio(0); } while (0)
#define PG8_WAIT_V(n) asm volatile("s_waitcnt vmcnt(" #n ")" ::: "memory")
#define PG8_WAIT_L(n) asm volatile("s_waitcnt lgkmcnt(" #n ")" ::: "memory")
#define PG8_BAR __builtin_amdgcn_s_barrier()
#define PG8_SCHED __builtin_amdgcn_sched_barrier(0)
    Unit cur, nxt; int ui = 0;
    if (!S.next(0, cur)) return;
    f32x4 acc[2][2][4][2];
#pragma unroll
    for (int a = 0; a < 2; ++a)
#pragma unroll
        for (int b = 0; b < 2; ++b)
#pragma unroll
            for (int m = 0; m < 4; ++m)
#pragma unroll
                for (int n = 0; n < 2; ++n) acc[a][b][m][n] = (f32x4){0.f, 0.f, 0.f, 0.f};
    bf16x8 At[4][2], B0[2][2], B1[2][2];
    const char* cA = a_ptr(g, cur); const char* cB = b_ptr(g, cur);
    PG8_STAGE(PG8_SB(0, 0), cB, voffB); PG8_STAGE(PG8_SA(0, 0), cA, voffA); PG8_STAGE(PG8_SB(0, 1), cB + hsB, voffB); PG8_STAGE(PG8_SA(0, 1), cA + hsA, voffA);
    if (wr == 1) PG8_BAR;
    PG8_WAIT_V(4); PG8_BAR;
    PG8_STAGE(PG8_SB(1, 0), cB + kstep, voffB); PG8_STAGE(PG8_SA(1, 0), cA + kstep, voffA); PG8_STAGE(PG8_SB(1, 1), cB + hsB + kstep, voffB);
    PG8_WAIT_V(6); PG8_BAR;
    for (;;) {
        const bool has_next = S.next(ui + 1, nxt);
        const char* nA = has_next ? a_ptr(g, nxt) : cA; const char* nB = has_next ? b_ptr(g, nxt) : cB;
        for (int t = 0; t < nt; t += 2) {
            const bool last = (t == nt - 2);
            const char* a1 = cA + (size_t)(t + 1) * kstep;
            const char* a2 = last ? nA : cA + (size_t)(t + 2) * kstep; const char* b2 = last ? nB : cB + (size_t)(t + 2) * kstep;
            const char* a3 = a2 + kstep; const char* b3 = b2 + kstep;
            PG8_LDB(B0, 0, 0); PG8_SCHED; PG8_LDA(At, 0, 0); PG8_STAGE(PG8_SA(1, 1), a1 + hsA, voffA);
            PG8_WAIT_L(8); PG8_BAR; PG8_WAIT_L(0); PG8_MMA(0, 0, At, B0); PG8_BAR; PG8_SCHED;
            PG8_LDB(B1, 0, 1); PG8_STAGE(PG8_SB(0, 0), b2, voffB);
            PG8_BAR; PG8_WAIT_L(0); PG8_MMA(0, 1, At, B1); PG8_BAR;
            PG8_LDA(At, 0, 1); PG8_STAGE(PG8_SA(0, 0), a2, voffA);
            PG8_BAR; PG8_WAIT_L(0); PG8_MMA(1, 0, At, B0); PG8_BAR; PG8_SCHED;
            PG8_STAGE(PG8_SB(0, 1), b2 + hsB, voffB);
            PG8_WAIT_V(6); PG8_BAR; PG8_MMA(1, 1, At, B1); PG8_BAR;
            PG8_LDB(B0, 1, 0); PG8_SCHED; PG8_LDA(At, 1, 0); PG8_STAGE(PG8_SA(0, 1), a2 + hsA, voffA);
            PG8_WAIT_L(8); PG8_BAR; PG8_WAIT_L(0); PG8_MMA(0, 0, At, B0); PG8_BAR; PG8_SCHED;
            PG8_LDB(B1, 1, 1); PG8_STAGE(PG8_SB(1, 0), b3, voffB);
            PG8_BAR; PG8_WAIT_L(0); PG8_MMA(0, 1, At, B1); PG8_BAR;
            PG8_LDA(At, 1, 1); PG8_STAGE(PG8_SA(1, 0), a3, voffA);
            PG8_BAR; PG8_WAIT_L(0); PG8_MMA(1, 0, At, B0); PG8_BAR; PG8_SCHED;
            PG8_STAGE(PG8_SB(1, 1), b3 + hsB, voffB);
            PG8_WAIT_V(6); PG8_BAR; PG8_MMA(1, 1, At, B1); PG8_BAR;
        }
        E(acc, cur, wr, wc, fr, fq);
        if (!has_next) break;
#pragma unroll
        for (int a = 0; a < 2; ++a)
#pragma unroll
            for (int b = 0; b < 2; ++b)
#pragma unroll
                for (int m = 0; m < 4; ++m)
#pragma unroll
                    for (int n = 0; n < 2; ++n) acc[a][b][m][n] = (f32x4){0.f, 0.f, 0.f, 0.f};
        cur = nxt; cA = nA; cB = nB; ++ui;
    }
    PG8_WAIT_V(0);
    if (wr == 0) PG8_BAR;
    PG8_BAR;
#undef PG8_SA
#undef PG8_SB
#undef PG8_STAGE
#undef PG8_LDA
#undef PG8_LDB
#undef PG8_MMA
#undef PG8_WAIT_V
#undef PG8_WAIT_L
#undef PG8_BAR
#undef PG8_SCHED
}
}
#define XB_TMO      128
#define XB_XCNT(j)  (256  + 64 * (j))
#define XB_XSUB(j)  (1280 + 64 * (j))
#define XB_XGEN(j)  (2304 + 64 * (j))
#define XB_TOP      3328
#define XB_TOPGEN   3392
#define XCD_BAR_WORDS 3456
#define XB_SPIN_CAP (1u << 20)

__device__ __forceinline__ unsigned xb_ld(unsigned* p)              { return __hip_atomic_load(p, __ATOMIC_RELAXED, __HIP_MEMORY_SCOPE_AGENT); }
__device__ __forceinline__ unsigned xb_add(unsigned* p, unsigned v) { return __hip_atomic_fetch_add(p, v, __ATOMIC_RELAXED, __HIP_MEMORY_SCOPE_AGENT); }
__device__ __forceinline__ unsigned xb_xcc_id() { return (unsigned)__builtin_amdgcn_s_getreg((3 << 11) | 20) & 0xFu; }
#define XB_SPIN(cond, bar) do { unsigned _sp = 0; while (cond) { __builtin_amdgcn_s_sleep(1); \
    if ((++_sp & 255u) == 0u) { if (xb_ld(&(bar)[XB_TMO])) break; if (_sp > XB_SPIN_CAP) { atomicAdd(&(bar)[XB_TMO], 1u); break; } } } } while (0)

struct XcdBarrier { unsigned* bar; unsigned x; volatile LAS unsigned* st; };

__device__ __forceinline__ XcdBarrier xcd_barrier_post(unsigned* bar, volatile LAS unsigned* st) {
    XcdBarrier b; b.bar = bar; b.x = xb_xcc_id(); b.st = st;
    if (threadIdx.x == 0) (void)xb_add(&bar[XB_XCNT(b.x)], 1u);
    return b;
}
__device__ __forceinline__ void xcd_barrier_complete(unsigned* bar, unsigned x, unsigned& nloc, unsigned& nx) {
    const unsigned G = gridDim.x * gridDim.y * gridDim.z;
    unsigned sum, cnt, mine, sp = 0u;
    for (;;) {
        sum = 0u; cnt = 0u; mine = 0u;
#pragma unroll
        for (unsigned j = 0; j < 16; ++j) { const unsigned c = xb_ld(&bar[XB_XCNT(j)]); sum += c; cnt += (c > 0u) ? 1u : 0u; mine = (j == x) ? c : mine; }
        if (sum == G) break;
        __builtin_amdgcn_s_sleep(1);
        if ((++sp & 255u) == 0u) { if (xb_ld(&bar[XB_TMO])) break; if (sp > XB_SPIN_CAP) { atomicAdd(&bar[XB_TMO], 1u); break; } }
    }
    nloc = mine > 0u ? mine : 1u; nx = cnt > 0u ? cnt : 1u;
}
__device__ __forceinline__ void xcd_barrier(const XcdBarrier& b) {
    asm volatile("s_waitcnt vmcnt(0)" ::: "memory");
    __syncthreads();
    if (threadIdx.x == 0) {
        unsigned* bar = b.bar;
        __builtin_amdgcn_s_waitcnt(0);
        unsigned nloc = b.st[0], nx = b.st[1];
        if (nloc == 0u) { xcd_barrier_complete(bar, b.x, nloc, nx); b.st[0] = nloc; b.st[1] = nx; }
        const unsigned old = xb_add(&bar[XB_XSUB(b.x)], 1u);
        const unsigned gen = old / nloc;
        if (old + 1u == (gen + 1u) * nloc) {
            __builtin_amdgcn_fence(__ATOMIC_RELEASE, "agent");
            asm volatile("s_waitcnt vmcnt(0)" ::: "memory");
            const unsigned og = xb_add(&bar[XB_TOP], 1u);
            const unsigned tg = og / nx;
            if (og + 1u == (tg + 1u) * nx) xb_add(&bar[XB_TOPGEN], 1u);
            else XB_SPIN(xb_ld(&bar[XB_TOPGEN]) == tg, bar);
            __builtin_amdgcn_fence(__ATOMIC_ACQUIRE, "agent");
            xb_add(&bar[XB_XGEN(b.x)], 1u);
            asm volatile("s_waitcnt vmcnt(0)" ::: "memory");
        } else {
            XB_SPIN(xb_ld(&bar[XB_XGEN(b.x)]) == gen, bar);
            __builtin_amdgcn_fence(__ATOMIC_ACQUIRE, "agent");
            asm volatile("s_waitcnt vmcnt(0)" ::: "memory");
        }
    }
    __syncthreads();
}

struct Args { const float* in[40]; float* out; unsigned char* ws; int l_lo, l_hi, s_lo, s_hi, fused, pad; };
struct Frame {
    LAS unsigned char* lds;
    int tid, lane, wave, G, bid;
    float* out; unsigned char* ws;
    bf16_t* h;
    bf16_t* x16;
};
enum { I_XP = 0, I_XS, I_MP, I_MS, I_NMIX, I_NXA, I_NMEM, I_NFFN, I_WQ, I_WK, I_WV, I_WO, I_FIN, I_FCW, I_FCB, I_FOUT, I_MIN, I_MOUT, I_SCW, I_SCB, I_ALOG, I_DTB, I_SD, I_SNORM,
       I_QN, I_KN, I_HIN, I_HCW, I_HCB, I_FW1, I_FB1, I_FW2, I_FB2, I_FW3, I_FB3, I_FFREQ, I_FWO, I_HSKIP, I_HOUT, I_FNORM };

__device__ __forceinline__ const float* inp(int i) {
    unsigned off = (unsigned)i * 8u; asm volatile("" : "+s"(off));
    const char __attribute__((address_space(4)))* ka = (const char __attribute__((address_space(4)))*)__builtin_amdgcn_kernarg_segment_ptr();
    return *(const float* const __attribute__((address_space(4)))*)(ka + off);
}
__device__ __forceinline__ void tr_item(const float* W, int K, int Nsrc, int c0, bf16_t* WT, int r0, int nblk, LAS float* scr, int item, int lane) {
    const int kb = item / nblk, nb = item % nblk, k0 = 64 * kb, n0 = 32 * nb;
#pragma unroll 8
    for (int i = 0; i < 32; ++i) { const int kk = 2 * i + (lane >> 5); scr[kk * 33 + (lane & 31)] = W[(size_t)(k0 + kk) * Nsrc + c0 + n0 + (lane & 31)]; }
    LDS_WAIT(); asm volatile("" ::: "memory");
    const int c = lane & 7;
#pragma unroll
    for (int j = 0; j < 4; ++j) { const int n = (lane >> 3) + 8 * j; const LAS float* s = scr + (8 * c) * 33 + n;
        u32x4 o; o.x = cvt_pk_bf16(s[0 * 33], s[1 * 33]); o.y = cvt_pk_bf16(s[2 * 33], s[3 * 33]); o.z = cvt_pk_bf16(s[4 * 33], s[5 * 33]); o.w = cvt_pk_bf16(s[6 * 33], s[7 * 33]);
        *(u32x4*)(WT + (size_t)(r0 + n0 + n) * K + k0 + 8 * c) = o; }
    LDS_WAIT(); asm volatile("" ::: "memory");
}
__device__ __forceinline__ void tr_seg(const float* W, int K, int Nsrc, int c0, int ncols, bf16_t* WT, int r0, LAS float* scr, int gw, int NGW, int lane) {
    const int nblk = ncols / 32, nit = (K / 64) * nblk;
    for (int it = gw; it < nit; it += NGW) tr_item(W, K, Nsrc, c0, WT, r0, nblk, scr, it, lane);
}
__device__ __forceinline__ void rms_row(const float* xrow, const float* gain, bf16_t* orow, float* copy, int lane) {
    const f32x4* xr = (const f32x4*)xrow + lane; const f32x4* gr = (const f32x4*)gain + lane;
    f32x4 v[8]; float s = 0.f;
#pragma unroll
    for (int j = 0; j < 8; ++j) { v[j] = xr[64 * j]; s += (v[j].x * v[j].x + v[j].y * v[j].y) + (v[j].z * v[j].z + v[j].w * v[j].w); }
    if (copy) {
#pragma unroll
        for (int j = 0; j < 8; ++j) ((f32x4*)copy + lane)[64 * j] = v[j];
    }
    const float rstd = 1.0f / sqrtf(wave_sum(s) * (1.f / DM) + EPS);
    u32x2* o8 = (u32x2*)orow + lane;
#pragma unroll
    for (int j = 0; j < 8; ++j) { const f32x4 g = gr[64 * j]; u32x2 w; w.x = cvt_pk_bf16(v[j].x * rstd * g.x, v[j].y * rstd * g.y); w.y = cvt_pk_bf16(v[j].z * rstd * g.z, v[j].w * rstd * g.w); o8[64 * j] = w; }
}
__device__ __forceinline__ void phase_rms_x(Frame& F, const float* gain, bool from_inputs) {
    bf16_t* H = F.h; bf16_t* X = F.x16;
    const int gw = F.bid * 8 + F.wave, NGW = F.G * 8, lane = F.lane;
    f32x4 gn[4][2];
#pragma unroll
    for (int j = 0; j < 4; ++j) { gn[j][0] = *(const f32x4*)(gain + j * 512 + lane * 8); gn[j][1] = *(const f32x4*)(gain + j * 512 + lane * 8 + 4); }
    if (from_inputs) {
        for (int m = gw; m < T; m += NGW) {
            float v[4][8]; float s = 0.f;
            const float* src = (m < 4 * SEQ ? inp(I_XP) + (size_t)m * DM : inp(I_XS) + (size_t)(m - 4 * SEQ) * DM);
#pragma unroll
            for (int j = 0; j < 4; ++j) { const f32x4 a = *(const f32x4*)(src + j * 512 + lane * 8), b = *(const f32x4*)(src + j * 512 + lane * 8 + 4);
                v[j][0] = a.x; v[j][1] = a.y; v[j][2] = a.z; v[j][3] = a.w; v[j][4] = b.x; v[j][5] = b.y; v[j][6] = b.z; v[j][7] = b.w;
                *(u32x4*)(X + (size_t)m * DM + j * 512 + lane * 8) = pack8(v[j]); }
#pragma unroll
            for (int j = 0; j < 4; ++j)
#pragma unroll
                for (int i = 0; i < 8; ++i) s += v[j][i] * v[j][i];
            const float rstd = 1.0f / sqrtf(wave_sum(s) * (1.f / DM) + EPS);
#pragma unroll
            for (int j = 0; j < 4; ++j) { const f32x4 g0 = gn[j][0], g1 = gn[j][1];
                float o[8]; o[0] = v[j][0] * rstd * g0.x; o[1] = v[j][1] * rstd * g0.y; o[2] = v[j][2] * rstd * g0.z; o[3] = v[j][3] * rstd * g0.w;
                o[4] = v[j][4] * rstd * g1.x; o[5] = v[j][5] * rstd * g1.y; o[6] = v[j][6] * rstd * g1.z; o[7] = v[j][7] * rstd * g1.w;
                *(u32x4*)(H + (size_t)m * DM + j * 512 + lane * 8) = pack8(o); }
        }
    } else {
        for (int m = gw; m < T; m += 2 * NGW) {
            const int m1 = m + NGW; const bool has1 = m1 < T; const int mb = has1 ? m1 : m;
            u32x4 ra[4], rb[4];
#pragma unroll
            for (int j = 0; j < 4; ++j) { ra[j] = *(const u32x4*)(X + (size_t)m * DM + j * 512 + lane * 8); rb[j] = *(const u32x4*)(X + (size_t)mb * DM + j * 512 + lane * 8); }
#pragma unroll
            for (int q = 0; q < 2; ++q) {
                if (q == 1 && !has1) break;
                float v[4][8]; float s = 0.f;
#pragma unroll
                for (int j = 0; j < 4; ++j) unpack8(q ? rb[j] : ra[j], v[j]);
#pragma unroll
                for (int j = 0; j < 4; ++j)
#pragma unroll
                    for (int i = 0; i < 8; ++i) s += v[j][i] * v[j][i];
                const float rstd = 1.0f / sqrtf(wave_sum(s) * (1.f / DM) + EPS);
                const int mo = q ? m1 : m;
#pragma unroll
                for (int j = 0; j < 4; ++j) { const f32x4 g0 = gn[j][0], g1 = gn[j][1];
                    float o[8]; o[0] = v[j][0] * rstd * g0.x; o[1] = v[j][1] * rstd * g0.y; o[2] = v[j][2] * rstd * g0.z; o[3] = v[j][3] * rstd * g0.w;
                    o[4] = v[j][4] * rstd * g1.x; o[5] = v[j][5] * rstd * g1.y; o[6] = v[j][6] * rstd * g1.z; o[7] = v[j][7] * rstd * g1.w;
                    *(u32x4*)(H + (size_t)mo * DM + j * 512 + lane * 8) = pack8(o); }
            }
        }
    }
}
__device__ __forceinline__ void phase_final_norm(Frame& F) {
    const int gw = F.bid * 8 + F.wave, NGW = F.G * 8, lane = F.lane; const float* gain = inp(I_FNORM); const bf16_t* X = F.x16;
    f32x4 gn[4][2];
#pragma unroll
    for (int j = 0; j < 4; ++j) { gn[j][0] = *(const f32x4*)(gain + j * 512 + lane * 8); gn[j][1] = *(const f32x4*)(gain + j * 512 + lane * 8 + 4); }
    for (int m = gw; m < T; m += 2 * NGW) {
        const int m1 = m + NGW; const bool has1 = m1 < T; const int mb = has1 ? m1 : m;
        u32x4 ra[4], rb[4];
#pragma unroll
        for (int j = 0; j < 4; ++j) { ra[j] = *(const u32x4*)(X + (size_t)m * DM + j * 512 + lane * 8); rb[j] = *(const u32x4*)(X + (size_t)mb * DM + j * 512 + lane * 8); }
#pragma unroll
        for (int q = 0; q < 2; ++q) {
            if (q == 1 && !has1) break;
            float v[4][8]; float s = 0.f; const int mo = q ? m1 : m;
#pragma unroll
            for (int j = 0; j < 4; ++j) unpack8(q ? rb[j] : ra[j], v[j]);
#pragma unroll
            for (int j = 0; j < 4; ++j)
#pragma unroll
                for (int i = 0; i < 8; ++i) s += v[j][i] * v[j][i];
            const float rstd = 1.0f / sqrtf(wave_sum(s) * (1.f / DM) + EPS);
#pragma unroll
            for (int j = 0; j < 4; ++j) { const f32x4 g0 = gn[j][0], g1 = gn[j][1];
                f32x4 o0, o1; o0.x = v[j][0] * rstd * g0.x; o0.y = v[j][1] * rstd * g0.y; o0.z = v[j][2] * rstd * g0.z; o0.w = v[j][3] * rstd * g0.w;
                o1.x = v[j][4] * rstd * g1.x; o1.y = v[j][5] * rstd * g1.y; o1.z = v[j][6] * rstd * g1.z; o1.w = v[j][7] * rstd * g1.w;
                *(f32x4*)(F.out + (size_t)mo * DM + j * 512 + lane * 8) = o0; *(f32x4*)(F.out + (size_t)mo * DM + j * 512 + lane * 8 + 4) = o1; }
        }
    }
}

__device__ __forceinline__ void phase_prep(Frame& F, int layer) {
    LAS float* scr = (LAS float*)(F.lds + F.wave * 8448);
    const int gw = F.bid * 8 + F.wave, NGW = F.G * 8, lane = F.lane;
    unsigned char* ws = F.ws;
    const int e = layer >> 1;
    if (!(layer & 1)) {
        const float* win = inp(I_MIN) + (size_t)e * DM * 8256;
        bf16_t* WI = (bf16_t*)(ws + W_IN);
        tr_seg(win, DM, 8256, 0, 2048, WI, PC_Z, scr, gw, NGW, lane);
        tr_seg(win, DM, 8256, 5184, 2048, WI, PC_Q, scr, gw, NGW, lane);
        tr_seg(win, DM, 8256, 2048, 3072, WI, PC_X, scr, gw, NGW, lane);
        tr_seg(win, DM, 8256, 7232, 512, WI, PC_K, scr, gw, NGW, lane);
        tr_seg(win, DM, 8256, 7744, 512, WI, PC_V, scr, gw, NGW, lane);
        tr_seg(win, DM, 8256, 5120, 64, (bf16_t*)(ws + W_DT), 0, scr, gw, NGW, lane);
        { u32x4* z = (u32x4*)(ws + W_DT + (size_t)64 * DM * 2); const int n16 = 192 * DM * 2 / 16;
          for (int i = F.bid * 512 + F.tid; i < n16; i += F.G * 512) z[i] = (u32x4){0u, 0u, 0u, 0u}; }
        tr_seg(inp(I_MOUT) + (size_t)e * 4096 * DM, 4096, DM, 0, DM, (bf16_t*)(ws + W_OUT), 0, scr, gw, NGW, lane);
    } else {
        tr_seg(inp(I_HIN) + (size_t)e * DM * HYW, DM, HYW, 0, HYW, (bf16_t*)(ws + HW_IN), 0, scr, gw, NGW, lane);
        tr_seg(inp(I_HOUT) + (size_t)e * DM * DM, DM, DM, 0, DM, (bf16_t*)(ws + HW_OUT), 0, scr, gw, NGW, lane);
    }
    { const float* wq = inp(I_WQ) + (size_t)layer * DM * DM; bf16_t* o = (bf16_t*)(ws + W_Q);
      for (int i = F.bid * 512 + F.tid; i < DM * DM / 8; i += F.G * 512) { const f32x4 a = *(const f32x4*)(wq + (size_t)i * 8), b = *(const f32x4*)(wq + (size_t)i * 8 + 4);
          u32x4 w; w.x = cvt_pk_bf16(a.x, a.y); w.y = cvt_pk_bf16(a.z, a.w); w.z = cvt_pk_bf16(b.x, b.y); w.w = cvt_pk_bf16(b.z, b.w); *(u32x4*)(o + (size_t)i * 8) = w; } }
    tr_seg(inp(I_WK) + (size_t)layer * DM * DM, DM, DM, 0, DM, (bf16_t*)(ws + W_K), 0, scr, gw, NGW, lane);
    tr_seg(inp(I_WV) + (size_t)layer * DM * DM, DM, DM, 0, DM, (bf16_t*)(ws + W_V), 0, scr, gw, NGW, lane);
    tr_seg(inp(I_WO) + (size_t)layer * DM * DM, DM, DM, 0, DM, (bf16_t*)(ws + W_O), 0, scr, gw, NGW, lane);
    { const float* fin = inp(I_FIN) + (size_t)layer * DM * F2;
      for (int it = gw; it < 88 * 128; it += NGW) { const int sg = it >> 7, li = it & 127, j = sg >> 1, half = sg & 1;
          tr_item(fin, DM, F2, half * DFF + 128 * j, (bf16_t*)(ws + W_FIN), 128 * sg, 4, scr, li, lane); } }
    tr_seg(inp(I_FOUT) + (size_t)layer * DFF * DM, DFF, DM, 0, DM, (bf16_t*)(ws + W_FOUT), 0, scr, gw, NGW, lane);
    phase_rms_x(F, inp(I_NMIX) + (size_t)layer * DM, layer == 0);
    for (int m = gw; m < MROWS; m += NGW) {
        const float* src = m < 4 * NMEM ? inp(I_MP) + (size_t)m * DM : inp(I_MS) + (size_t)(m - 4 * NMEM) * DM;
        rms_row(src, inp(I_NMEM) + (size_t)layer * DM, (bf16_t*)(ws + WS_MEMN) + (size_t)m * DM, nullptr, lane);
    }
    if (layer & 1) {
        f32x2* tw = (f32x2*)(ws + WS_TW);
        for (int i = F.bid * 512 + F.tid; i < 4096; i += F.G * 512) { float s, c; sincospif(-(float)i * (1.0f / 8192.0f), &s, &c); { f32x2 tv; tv.x = c; tv.y = s; tw[i] = tv; } }
        const float* w1 = inp(I_FW1) + (size_t)e * 33 * 64; const float* b1 = inp(I_FB1) + e * 64;
        const float* w2 = inp(I_FW2) + (size_t)e * 64 * 64; const float* b2 = inp(I_FB2) + e * 64;
        const float* w3 = inp(I_FW3) + (size_t)e * 64 * 64; const float* b3 = inp(I_FB3) + e * 64;
        const float fr = inp(I_FFREQ)[e * 64 + lane];
        float* h3 = (float*)(ws + WS_H3);
        for (int t = gw; t < SEQ; t += NGW) {
            float z = 0.f;
            { const float wt = 6.283185307179586f * (float)t / (float)SEQ;
              if (lane == 0) z = (float)t / (float)(SEQ - 1);
              else if (lane <= 16) { const float f = 1e-4f + (float)(lane - 1) * ((15.0f - 1e-4f) / 15.0f); z = cosf(wt * f); }
              else if (lane <= 32) { const float f = 1e-4f + (float)(lane - 17) * ((15.0f - 1e-4f) / 15.0f); z = -sinf(wt * f); } }
            float a = b1[lane];
            for (int i = 0; i < 33; ++i) a += __shfl(z, i) * w1[i * 64 + lane];
            float h = sinf(fr * a);
            a = b2[lane];
            for (int i = 0; i < 64; ++i) a += __shfl(h, i) * w2[i * 64 + lane];
            h = sinf(fr * a);
            a = b3[lane];
            for (int i = 0; i < 64; ++i) a += __shfl(h, i) * w3[i * 64 + lane];
            h = sinf(fr * a);
            h3[(size_t)t * 64 + lane] = h;
        }
    }
}
__device__ __forceinline__ void phase_ssd_conv(Frame& F, int e) {
    const bf16_t* P = (const bf16_t*)(F.ws + WS_PROJ); bf16_t* XS = F.h; bf16_t* BC = (bf16_t*)(F.ws + WS_BC);
    const float* cw = inp(I_SCW) + (size_t)e * 5 * 3072; const float* cb = inp(I_SCB) + (size_t)e * 3072;
    const int nitem = (T / 16) * 384;
    for (int it = F.bid * 512 + F.tid; it < nitem; it += F.G * 512) {
        const int strip = it / 384, oc = it % 384, ch = oc * 8, m0 = strip * 16, t0 = m0 % SEQ;
        float w[5][8], bias[8];
#pragma unroll
        for (int k = 0; k < 5; ++k) { const f32x4 a = *(const f32x4*)(cw + k * 3072 + ch), b = *(const f32x4*)(cw + k * 3072 + ch + 4);
            w[k][0] = a.x; w[k][1] = a.y; w[k][2] = a.z; w[k][3] = a.w; w[k][4] = b.x; w[k][5] = b.y; w[k][6] = b.z; w[k][7] = b.w; }
        { const f32x4 a = *(const f32x4*)(cb + ch), b = *(const f32x4*)(cb + ch + 4); bias[0] = a.x; bias[1] = a.y; bias[2] = a.z; bias[3] = a.w; bias[4] = b.x; bias[5] = b.y; bias[6] = b.z; bias[7] = b.w; }
        u32x4 raw[20];
#pragma unroll
        for (int k = 0; k < 20; ++k) { const int tt = t0 + k - 2, tc = tt < 0 ? 0 : (tt >= SEQ ? SEQ - 1 : tt);
            raw[k] = *(const u32x4*)(P + (size_t)(m0 - t0 + tc) * PW + PC_X + ch); }
        if (t0 == 0) { raw[0] = (u32x4){0u, 0u, 0u, 0u}; raw[1] = (u32x4){0u, 0u, 0u, 0u}; }
        if (t0 + 16 == SEQ) { raw[18] = (u32x4){0u, 0u, 0u, 0u}; raw[19] = (u32x4){0u, 0u, 0u, 0u}; }
        float win[5][8];
#pragma unroll
        for (int k = 0; k < 4; ++k) unpack8(raw[k], win[k + 1]);
#pragma unroll
        for (int r = 0; r < 16; ++r) {
#pragma unroll
            for (int k = 0; k < 4; ++k)
#pragma unroll
                for (int j = 0; j < 8; ++j) win[k][j] = win[k + 1][j];
            unpack8(raw[r + 4], win[4]);
            float o[8];
#pragma unroll
            for (int j = 0; j < 8; ++j) { float a = bias[j];
#pragma unroll
                for (int k = 0; k < 5; ++k) a += win[k][j] * w[k][j];
                o[j] = silu_f(a); }
            const u32x4 ov = pack8(o);
            if (ch < 2048) *(u32x4*)(XS + (size_t)(m0 + r) * DM + ch) = ov;
            else *(u32x4*)(BC + (size_t)(m0 + r) * 1024 + (ch - 2048)) = ov;
        }
    }
}
__device__ __forceinline__ void phase_qk_rope(Frame& F, int e) {
    bf16_t* P = (bf16_t*)(F.ws + WS_PROJ);
    const int gw = F.bid * 8 + F.wave, NGW = F.G * 8, lane = F.lane;
    const float gq0 = inp(I_QN)[e * 128 + 2 * lane], gq1 = inp(I_QN)[e * 128 + 2 * lane + 1];
    const float gk0 = inp(I_KN)[e * 128 + 2 * lane], gk1 = inp(I_KN)[e * 128 + 2 * lane + 1];
    const float invf = exp2f(-13.287712379549449f * (float)(lane & 31) * (1.0f / 32.0f));
    for (int m = gw; m < T; m += NGW) {
        const int t = m % SEQ; const float pos = (lane < 32) ? (float)(t >> 6) : (float)(t & 63);
        float sn, cs; sincosf(pos * invf, &sn, &cs);
        unsigned* row = (unsigned*)(P + (size_t)m * PW);
        unsigned wv[20];
#pragma unroll
        for (int hd = 0; hd < 20; ++hd) { const int col = (hd < 16) ? (PC_Q + hd * 128) : (PC_K + (hd - 16) * 128); wv[hd] = row[(col >> 1) + lane]; }
#pragma unroll
        for (int hd = 0; hd < 20; ++hd) {
            const int col = (hd < 16) ? (PC_Q + hd * 128) : (PC_K + (hd - 16) * 128);
            float x0 = bflo(wv[hd]), x1 = bfhi(wv[hd]);
            const float ss = wave_sum(x0 * x0 + x1 * x1);
            const float rstd = __builtin_amdgcn_rsqf(ss * (1.f / 128.f) + EPS);
            x0 *= rstd * (hd < 16 ? gq0 : gk0); x1 *= rstd * (hd < 16 ? gq1 : gk1);
            row[(col >> 1) + lane] = cvt_pk_bf16(x0 * cs - x1 * sn, x0 * sn + x1 * cs);
        }
    }
}
__device__ __forceinline__ void phase_ssd_gate_norm(Frame& F, int e) {
    bf16_t* P = (bf16_t*)(F.ws + WS_PROJ);
    const int gw = F.bid * 8 + F.wave, NGW = F.G * 8, lane = F.lane; const float* gain = inp(I_SNORM) + (size_t)e * DM;
    f32x4 gn[4][2];
#pragma unroll
    for (int j = 0; j < 4; ++j) { gn[j][0] = *(const f32x4*)(gain + j * 512 + lane * 8); gn[j][1] = *(const f32x4*)(gain + j * 512 + lane * 8 + 4); }
    for (int m = gw; m < T; m += 2 * NGW) {
        const int m1 = m + NGW; const bool has1 = m1 < T; const int mb = has1 ? m1 : m;
        u32x4 ya[4], za[4], yb[4], zb[4];
#pragma unroll
        for (int j = 0; j < 4; ++j) { const int c = j * 512 + lane * 8;
            ya[j] = *(const u32x4*)(P + (size_t)m * PW + PC_X + c); za[j] = *(const u32x4*)(P + (size_t)m * PW + PC_Z + c);
            yb[j] = *(const u32x4*)(P + (size_t)mb * PW + PC_X + c); zb[j] = *(const u32x4*)(P + (size_t)mb * PW + PC_Z + c); }
#pragma unroll
        for (int q = 0; q < 2; ++q) {
            if (q == 1 && !has1) break;
            bf16_t* row = P + (size_t)(q ? m1 : m) * PW; float v[4][8]; float s = 0.f;
#pragma unroll
            for (int j = 0; j < 4; ++j) { float y[8], z[8];
                unpack8(q ? yb[j] : ya[j], y); unpack8(q ? zb[j] : za[j], z);
#pragma unroll
                for (int i = 0; i < 8; ++i) { v[j][i] = y[i] * silu_f(z[i]); s += v[j][i] * v[j][i]; } }
            const float rstd = 1.0f / sqrtf(wave_sum(s) * (1.f / DM) + EPS);
#pragma unroll
            for (int j = 0; j < 4; ++j) { const int c = j * 512 + lane * 8; const f32x4 g0 = gn[j][0], g1 = gn[j][1];
                float o[8]; o[0] = v[j][0] * rstd * g0.x; o[1] = v[j][1] * rstd * g0.y; o[2] = v[j][2] * rstd * g0.z; o[3] = v[j][3] * rstd * g0.w;
                o[4] = v[j][4] * rstd * g1.x; o[5] = v[j][5] * rstd * g1.y; o[6] = v[j][6] * rstd * g1.z; o[7] = v[j][7] * rstd * g1.w;
                *(u32x4*)(row + PC_Z + c) = pack8(o); }
        }
    }
}

constexpr int TP = 136;
__device__ __forceinline__ bf16x8 frag16(const LAS unsigned char* tile, int row, int k0, int lane) { return *(const LAS bf16x8*)(tile + row * (TP * 2) + (k0 + 8 * (lane >> 4)) * 2); }
constexpr int SC_CSF = 0, SC_EB = 128, SC_DTF = 256, SC_DTB = 384, SC_RSF = 512, SC_RSB = 640, SC_EBT = 768, SC_WORDS = 772;
__device__ __forceinline__ void ssd_scans(Frame& F, LAS float* sc, const float* dt, int m0, int h, float a_f, float a_b) {
    const int tid = F.tid;
    if (tid < 128) sc[SC_DTF + tid] = dt[(size_t)(m0 + tid) * 64 + h];
    else if (tid < 256) sc[SC_DTB + tid - 128] = dt[(size_t)(m0 + tid - 128) * 64 + 32 + h];
    __syncthreads();
    if (F.wave < 2) {
        const int lane = F.lane; const bool fw = (F.wave == 0);
        const float a0 = sc[(fw ? SC_DTF : SC_DTB) + 2 * lane] * (fw ? a_f : a_b), a1 = sc[(fw ? SC_DTF : SC_DTB) + 2 * lane + 1] * (fw ? a_f : a_b);
        float p = a0 + a1;
#pragma unroll
        for (int o = 1; o < 64; o <<= 1) { const float tt = __shfl_up(p, o); if (lane >= o) p += tt; }
        const float ex = p - (a0 + a1);
        if (fw) { sc[SC_CSF + 2 * lane] = ex + a0; sc[SC_CSF + 2 * lane + 1] = p; }
        else { sc[SC_EB + 2 * lane] = ex; sc[SC_EB + 2 * lane + 1] = ex + a0; if (lane == 63) sc[SC_EBT] = p; }
    }
    __syncthreads();
}
__device__ __forceinline__ void ssd_scans_r(Frame& F, LAS float* sc, float dtv, float a_f, float a_b) {
    const int tid = F.tid;
    if (tid < 128) sc[SC_DTF + tid] = dtv;
    else if (tid < 256) sc[SC_DTB + tid - 128] = dtv;
    LDS_BARRIER();
    if (F.wave < 2) {
        const int lane = F.lane; const bool fw = (F.wave == 0);
        const float a0 = sc[(fw ? SC_DTF : SC_DTB) + 2 * lane] * (fw ? a_f : a_b), a1 = sc[(fw ? SC_DTF : SC_DTB) + 2 * lane + 1] * (fw ? a_f : a_b);
        float p = a0 + a1;
#pragma unroll
        for (int o = 1; o < 64; o <<= 1) { const float tt = __shfl_up(p, o); if (lane >= o) p += tt; }
        const float ex = p - (a0 + a1);
        if (fw) { sc[SC_CSF + 2 * lane] = ex + a0; sc[SC_CSF + 2 * lane + 1] = p; }
        else { sc[SC_EB + 2 * lane] = ex; sc[SC_EB + 2 * lane + 1] = ex + a0; if (lane == 63) sc[SC_EBT] = p; }
    }
    LDS_BARRIER();
}
__device__ __forceinline__ void phase_ssd_states(Frame& F, int e) {
    LAS unsigned char* BT = F.lds; LAS unsigned char* XF = F.lds + 34816; LAS unsigned char* XB = F.lds + 52224; LAS float* sc = (LAS float*)(F.lds + 69632);
    const bf16_t* XS = F.h; const bf16_t* BC = (const bf16_t*)(F.ws + WS_BC); const float* dt = (const float*)(F.ws + WS_DT);
    bf16_t* STF = (bf16_t*)(F.ws + WS_STF); bf16_t* STB = (bf16_t*)(F.ws + WS_STB); float* TOT = (float*)(F.ws + WS_TOT);
    const int tid = F.tid, lane = F.lane, wave = F.wave;
    for (int u = F.bid; u < NSEQ * NCH * SSG; u += F.G) {
        const int g = u % SSG, c = (u / SSG) % NCH, b = u / (SSG * NCH), m0 = b * SEQ + c * SSQ;
        { const int s = tid & 127, og = tid >> 7;
#pragma unroll
          for (int i = 0; i < 4; ++i) { const int n0 = (og * 4 + i) * 8; const u32x4 v = *(const u32x4*)(BC + (size_t)(m0 + s) * 1024 + g * 128 + n0);
              const unsigned ws_[4] = {v.x, v.y, v.z, v.w};
#pragma unroll
              for (int j = 0; j < 8; ++j) *(LAS bf16_t*)(BT + ((n0 + j) * TP + s) * 2) = (bf16_t)((j & 1) ? (ws_[j >> 1] >> 16) : (ws_[j >> 1] & 0xffffu)); } }
        const int ps_ = tid & 127, pog = tid >> 7;
        const float* dtp = dt + (size_t)(m0 + ps_) * 64 + (tid < 128 ? 0 : 32);
        const bf16_t* xp = XS + (size_t)(m0 + ps_) * DM + pog * 16;
        float dtn = dtp[g * 8]; u32x4 xn0 = *(const u32x4*)(xp + g * 512), xn1 = *(const u32x4*)(xp + g * 512 + 8);
        for (int h8 = 0; h8 < 8; ++h8) {
            const int h = g * 8 + h8;
            const float a_f = -__expf(inp(I_ALOG)[e * 64 + h]), a_b = -__expf(inp(I_ALOG)[e * 64 + 32 + h]);
            const float dtv = dtn; const u32x4 xv0 = xn0, xv1 = xn1;
            if (h8 < 7) { dtn = dtp[h + 1]; xn0 = *(const u32x4*)(xp + (h + 1) * 64); xn1 = *(const u32x4*)(xp + (h + 1) * 64 + 8); }
            ssd_scans_r(F, sc, dtv, a_f, a_b);
            { const int s = ps_, og = pog; const float csl = sc[SC_CSF + 127];
              const float wf = sc[SC_DTF + s] * __expf(csl - sc[SC_CSF + s]), wb = sc[SC_DTB + s] * __expf(sc[SC_EB + s]);
#pragma unroll
              for (int i = 0; i < 2; ++i) { const int p0 = (og * 2 + i) * 8; float v[8]; unpack8(i ? xv1 : xv0, v);
#pragma unroll
                  for (int j = 0; j < 8; ++j) { *(LAS bf16_t*)(XF + ((p0 + j) * TP + s) * 2) = f2bf(v[j] * wf); *(LAS bf16_t*)(XB + ((p0 + j) * TP + s) * 2) = f2bf(v[j] * wb); } } }
            LDS_BARRIER();
            { const LAS unsigned char* X = (wave < 4) ? XF : XB; const int nb = (wave & 3) * 32;
              f32x4 acc[4][2];
#pragma unroll
              for (int pt = 0; pt < 4; ++pt)
#pragma unroll
                  for (int nt = 0; nt < 2; ++nt) acc[pt][nt] = (f32x4){0.f, 0.f, 0.f, 0.f};
#pragma unroll
              for (int k0 = 0; k0 < 128; k0 += 32) { bf16x8 a[2], bb[4];
#pragma unroll
                  for (int nt = 0; nt < 2; ++nt) a[nt] = frag16(BT, nb + 8 * ((lane & 15) >> 2) + 4 * nt + (lane & 3), k0, lane);
#pragma unroll
                  for (int pt = 0; pt < 4; ++pt) bb[pt] = frag16(X, pt * 16 + (lane & 15), k0, lane);
#pragma unroll
                  for (int pt = 0; pt < 4; ++pt)
#pragma unroll
                      for (int nt = 0; nt < 2; ++nt) acc[pt][nt] = __builtin_amdgcn_mfma_f32_16x16x32_bf16(a[nt], bb[pt], acc[pt][nt], 0, 0, 0); }
              bf16_t* ST = ((wave < 4) ? STF : STB) + (size_t)((b * NCH + c) * SSH + h) * (SSP * SSN);
#pragma unroll
              for (int pt = 0; pt < 4; ++pt) { const int p = pt * 16 + (lane & 15), n = nb + (lane >> 4) * 8;
                  u32x4 w; w.x = cvt_pk_c(acc[pt][0][0], acc[pt][0][1]); w.y = cvt_pk_c(acc[pt][0][2], acc[pt][0][3]); w.z = cvt_pk_c(acc[pt][1][0], acc[pt][1][1]); w.w = cvt_pk_c(acc[pt][1][2], acc[pt][1][3]);
                  *(u32x4*)(ST + p * SSN + n) = w; } }
            if (tid == 0) { TOT[((b * NCH + c) * SSH + h) * 2] = sc[SC_CSF + 127]; TOT[((b * NCH + c) * SSH + h) * 2 + 1] = sc[SC_EBT]; }
            LDS_BARRIER();
        }
    }
}
__device__ __forceinline__ void phase_ssd_scan(Frame& F) {
    bf16_t* STF = (bf16_t*)(F.ws + WS_STF); bf16_t* STB = (bf16_t*)(F.ws + WS_STB); const float* TOT = (const float*)(F.ws + WS_TOT);
    const int nitem = NSEQ * SSH * 2 * 1024;
    for (int it = F.bid * 512 + F.tid; it < nitem; it += F.G * 512) {
        const int o8 = it & 1023, dir = (it >> 10) & 1, h = (it >> 11) % SSH, b = it / (2048 * SSH);
        bf16_t* base = (dir ? STB : STF) + (size_t)o8 * 8;
        float carry[8];
#pragma unroll
        for (int j = 0; j < 8; ++j) carry[j] = 0.f;
        for (int cc0 = 0; cc0 < NCH; cc0 += 8) {
            u32x4 sv[8]; float tv[8];
#pragma unroll
            for (int k = 0; k < 8; ++k) { const int c = dir ? (NCH - 1 - cc0 - k) : (cc0 + k); const size_t idx = (size_t)((b * NCH + c) * SSH + h);
                sv[k] = *(const u32x4*)(base + idx * (SSP * SSN)); tv[k] = TOT[idx * 2 + dir]; }
#pragma unroll
            for (int k = 0; k < 8; ++k) { const int c = dir ? (NCH - 1 - cc0 - k) : (cc0 + k); const size_t idx = (size_t)((b * NCH + c) * SSH + h);
                float s[8]; unpack8(sv[k], s);
                *(u32x4*)(base + idx * (SSP * SSN)) = pack8(carry);
                const float dec = __expf(tv[k]);
#pragma unroll
                for (int j = 0; j < 8; ++j) carry[j] = carry[j] * dec + s[j]; }
        }
    }
}
__device__ __forceinline__ void phase_ssd_out(Frame& F, int e) {
    LAS unsigned char* CM = F.lds; LAS unsigned char* BM = F.lds + 34816; LAS unsigned char* SF = F.lds + 69632; LAS unsigned char* SB = F.lds + 87040;
    LAS unsigned char* XT = F.lds + 104448; LAS unsigned char* WM = BM; LAS float* sc = (LAS float*)(F.lds + 121856);
    const bf16_t* XS = F.h; const bf16_t* BC = (const bf16_t*)(F.ws + WS_BC); const float* dt = (const float*)(F.ws + WS_DT);
    const bf16_t* STF = (const bf16_t*)(F.ws + WS_STF); const bf16_t* STB = (const bf16_t*)(F.ws + WS_STB); bf16_t* P = (bf16_t*)(F.ws + WS_PROJ);
    const int tid = F.tid, lane = F.lane, wave = F.wave;
    for (int u = F.bid; u < NSEQ * NCH * SSG; u += F.G) {
        const int g = u % SSG, c = (u / SSG) % NCH, b = u / (SSG * NCH), m0 = b * SEQ + c * SSQ;
        { const int r = tid >> 2, q = tid & 3;
#pragma unroll
          for (int i = 0; i < 4; ++i) { const int o = q * 4 + i;
              *(LAS u32x4*)(CM + r * (TP * 2) + o * 16) = *(const u32x4*)(BC + (size_t)(m0 + r) * 1024 + 512 + g * 128 + o * 8);
              *(LAS u32x4*)(BM + r * (TP * 2) + o * 16) = *(const u32x4*)(BC + (size_t)(m0 + r) * 1024 + g * 128 + o * 8); } }
        LDS_BARRIER();
        const int lb = (wave >> 1) * 32, sb = (wave & 1) * 64;
        f32x4 cb[2][4];
#pragma unroll
        for (int lt = 0; lt < 2; ++lt)
#pragma unroll
            for (int st = 0; st < 4; ++st) cb[lt][st] = (f32x4){0.f, 0.f, 0.f, 0.f};
#pragma unroll
        for (int k0 = 0; k0 < 128; k0 += 32) { bf16x8 a[4], bb[2];
#pragma unroll
            for (int st = 0; st < 4; ++st) a[st] = frag16(BM, sb + st * 16 + (lane & 15), k0, lane);
#pragma unroll
            for (int lt = 0; lt < 2; ++lt) bb[lt] = frag16(CM, lb + lt * 16 + (lane & 15), k0, lane);
#pragma unroll
            for (int lt = 0; lt < 2; ++lt)
#pragma unroll
                for (int st = 0; st < 4; ++st) cb[lt][st] = __builtin_amdgcn_mfma_f32_16x16x32_bf16(a[st], bb[lt], cb[lt][st], 0, 0, 0); }
        const int ps_ = tid & 127, pog = tid >> 7;
        const float* dtp = dt + (size_t)(m0 + ps_) * 64 + (tid < 128 ? 0 : 32);
        const bf16_t* xp = XS + (size_t)(m0 + ps_) * DM + pog * 16;
        const size_t sb0 = (size_t)((b * NCH + c) * SSH) * (SSP * SSN) + (size_t)tid * 8;
        float dtn = dtp[g * 8]; u32x4 xn0 = *(const u32x4*)(xp + g * 512), xn1 = *(const u32x4*)(xp + g * 512 + 8);
        u32x4 fn0 = *(const u32x4*)(STF + sb0 + (size_t)(g * 8) * 8192), fn1 = *(const u32x4*)(STF + sb0 + (size_t)(g * 8) * 8192 + 4096);
        u32x4 bn0 = *(const u32x4*)(STB + sb0 + (size_t)(g * 8) * 8192), bn1 = *(const u32x4*)(STB + sb0 + (size_t)(g * 8) * 8192 + 4096);
        for (int h8 = 0; h8 < 8; ++h8) {
            const int h = g * 8 + h8;
            const float a_f = -__expf(inp(I_ALOG)[e * 64 + h]), a_b = -__expf(inp(I_ALOG)[e * 64 + 32 + h]), dsk = inp(I_SD)[e * 32 + h];
            const float dtv = dtn;
            {
#pragma unroll
              for (int i = 0; i < 2; ++i) { const int idx = tid + 512 * i, p = idx >> 4, o = idx & 15;
                  *(LAS u32x4*)(SF + p * (TP * 2) + o * 16) = i ? fn1 : fn0; *(LAS u32x4*)(SB + p * (TP * 2) + o * 16) = i ? bn1 : bn0; }
#pragma unroll
              for (int i = 0; i < 2; ++i) { const int p0 = (pog * 2 + i) * 8; const u32x4 v = i ? xn1 : xn0;
                  const unsigned ws_[4] = {v.x, v.y, v.z, v.w};
#pragma unroll
                  for (int j = 0; j < 8; ++j) *(LAS bf16_t*)(XT + ((p0 + j) * TP + ps_) * 2) = (bf16_t)((j & 1) ? (ws_[j >> 1] >> 16) : (ws_[j >> 1] & 0xffffu)); } }
            if (h8 < 7) { dtn = dtp[h + 1]; xn0 = *(const u32x4*)(xp + (h + 1) * 64); xn1 = *(const u32x4*)(xp + (h + 1) * 64 + 8);
                fn0 = *(const u32x4*)(STF + sb0 + (size_t)(h + 1) * 8192); fn1 = *(const u32x4*)(STF + sb0 + (size_t)(h + 1) * 8192 + 4096);
                bn0 = *(const u32x4*)(STB + sb0 + (size_t)(h + 1) * 8192); bn1 = *(const u32x4*)(STB + sb0 + (size_t)(h + 1) * 8192 + 4096); }
            ssd_scans_r(F, sc, dtv, a_f, a_b);
            if (tid < 128) { sc[SC_RSF + tid] = __expf(sc[SC_CSF + tid]); sc[SC_RSB + tid] = __expf(sc[SC_EBT] - sc[SC_EB + tid]); }
#pragma unroll
            for (int lt = 0; lt < 2; ++lt) { const int l = lb + lt * 16 + (lane & 15); const float csl = sc[SC_CSF + l], ebl = sc[SC_EB + l];
#pragma unroll
                for (int st = 0; st < 4; ++st) { const int s0 = sb + st * 16 + (lane >> 4) * 4; float w[4];
                    const int dtile = ((sb >> 4) + st) - ((lb >> 4) + lt);
                    if (dtile < 0) { const f32x4 cs4 = *(const LAS f32x4*)(sc + SC_CSF + s0), d4 = *(const LAS f32x4*)(sc + SC_DTF + s0);
#pragma unroll
                        for (int j = 0; j < 4; ++j) w[j] = cb[lt][st][j] * (__expf(csl - cs4[j]) * d4[j]); }
                    else if (dtile > 0) { const f32x4 eb4 = *(const LAS f32x4*)(sc + SC_EB + s0), d4 = *(const LAS f32x4*)(sc + SC_DTB + s0);
#pragma unroll
                        for (int j = 0; j < 4; ++j) w[j] = cb[lt][st][j] * (__expf(eb4[j] - ebl) * d4[j]); }
                    else { const f32x4 cs4 = *(const LAS f32x4*)(sc + SC_CSF + s0), df4 = *(const LAS f32x4*)(sc + SC_DTF + s0), eb4 = *(const LAS f32x4*)(sc + SC_EB + s0), db4 = *(const LAS f32x4*)(sc + SC_DTB + s0);
#pragma unroll
                        for (int j = 0; j < 4; ++j) { const int s = s0 + j; float mk = 0.f;
                            if (s <= l) mk += __expf(csl - cs4[j]) * df4[j];
                            if (s >= l) mk += __expf(eb4[j] - ebl) * db4[j];
                            w[j] = cb[lt][st][j] * mk + (s == l ? dsk : 0.f); } }
                    u32x2 pk; pk.x = cvt_pk_c(w[0], w[1]); pk.y = cvt_pk_c(w[2], w[3]);
                    *(LAS u32x2*)(WM + (l * TP + s0) * 2) = pk; } }
            LDS_BARRIER();
            { f32x4 aD[4], aF[4], aB[4];
#pragma unroll
              for (int pt = 0; pt < 4; ++pt) { aD[pt] = (f32x4){0.f, 0.f, 0.f, 0.f}; aF[pt] = aD[pt]; aB[pt] = aD[pt]; }
              const int l = wave * 16 + (lane & 15);
#pragma unroll
              for (int k0 = 0; k0 < 128; k0 += 32) { const bf16x8 wv = frag16(WM, l, k0, lane), cv = frag16(CM, l, k0, lane);
#pragma unroll
                  for (int pt = 0; pt < 4; ++pt) { const int pr = 32 * (pt >> 1) + 8 * ((lane & 15) >> 2) + 4 * (pt & 1) + (lane & 3);
                      aD[pt] = __builtin_amdgcn_mfma_f32_16x16x32_bf16(frag16(XT, pr, k0, lane), wv, aD[pt], 0, 0, 0);
                      aF[pt] = __builtin_amdgcn_mfma_f32_16x16x32_bf16(frag16(SF, pr, k0, lane), cv, aF[pt], 0, 0, 0);
                      aB[pt] = __builtin_amdgcn_mfma_f32_16x16x32_bf16(frag16(SB, pr, k0, lane), cv, aB[pt], 0, 0, 0); } }
              const float rsf = sc[SC_RSF + l], rsb = sc[SC_RSB + l];
              bf16_t* yrow = P + (size_t)(m0 + l) * PW + PC_X + h * 64;
#pragma unroll
              for (int k = 0; k < 2; ++k) { const f32x4 y0 = aD[2 * k] + aF[2 * k] * rsf + aB[2 * k] * rsb, y1 = aD[2 * k + 1] + aF[2 * k + 1] * rsf + aB[2 * k + 1] * rsb; const int p = 32 * k + (lane >> 4) * 8;
                  u32x4 pk; pk.x = cvt_pk_c(y0[0], y0[1]); pk.y = cvt_pk_c(y0[2], y0[3]); pk.z = cvt_pk_c(y1[0], y1[1]); pk.w = cvt_pk_c(y1[2], y1[3]); *(u32x4*)(yrow + p) = pk; } }
            LDS_BARRIER();
        }
    }
}
namespace att {
constexpr int D = 128, NW = 8, QBLK = 32, KVBLK = 64;
constexpr float SCALE = 0.088388347648318440f;
constexpr float THR = 8.f;
constexpr int LDQ = PW, LDK = PW, LDO = PW;
constexpr size_t SHM_V = KVBLK * D * 2, SHM_K = KVBLK * D * 2, SHM_ATTN = 3 * SHM_V + 2 * SHM_K + NW * 64 * 4;
#define KSWZ(row, colB) ((row) * 256 + ((colB) ^ (((row) & 7) << 4)))
#define SBAR() __builtin_amdgcn_sched_barrier(0)
__device__ __forceinline__ int crow(int r, int hi) { return (r & 3) + 8 * (r >> 2) + 4 * hi; }
__device__ __forceinline__ void partialSM(f32x16& p0, f32x16& p1, float& m_reg, float& mn, float& alpha) {
  constexpr float C = SCALE * 1.4426950408889634f;
  float pmax = p0[0]; for (int r = 1; r < 16; ++r) pmax = fmaxf(pmax, p0[r]); for (int r = 0; r < 16; ++r) pmax = fmaxf(pmax, p1[r]);
  { auto rr = __builtin_amdgcn_permlane32_swap(__float_as_uint(pmax), __float_as_uint(pmax), false, false);
    pmax = fmaxf(__uint_as_float(rr[0]), __uint_as_float(rr[1])); }
  if (__builtin_expect(__all(pmax - m_reg <= THR / SCALE), 1)) { mn = m_reg; alpha = 1.f; }
  else { mn = fmaxf(m_reg, pmax); alpha = __builtin_amdgcn_exp2f((m_reg - mn) * C); m_reg = mn; }
  float mnC = -mn * C;
  for (int r = 0; r < 16; ++r) p0[r] = fmaf(p0[r], C, mnC); for (int r = 0; r < 16; ++r) p1[r] = fmaf(p1[r], C, mnC);
  for (int r = 0; r < 16; ++r) p0[r] = __builtin_amdgcn_exp2f(p0[r]);
}
__device__ __forceinline__ void finishSM(f32x16& p0, f32x16& p1, float alpha, float& l_reg, bf16x8& pa0, bf16x8& pa1, bf16x8& pa2, bf16x8& pa3) {
  for (int r = 0; r < 16; ++r) p1[r] = __builtin_amdgcn_exp2f(p1[r]);
  float ps = 0; for (int r = 0; r < 16; ++r) ps += p0[r]; for (int r = 0; r < 16; ++r) ps += p1[r];
  { auto rr = __builtin_amdgcn_permlane32_swap(__float_as_uint(ps), __float_as_uint(ps), false, false);
    ps = __uint_as_float(rr[0]) + __uint_as_float(rr[1]); }
  l_reg = l_reg * alpha + ps;
#define PK4(P, BASE, OUT) do { unsigned a0 = cvt_pk_bf16(P[BASE + 0], P[BASE + 1]), a1 = cvt_pk_bf16(P[BASE + 2], P[BASE + 3]);   \
    unsigned b0 = cvt_pk_bf16(P[BASE + 4], P[BASE + 5]), b1 = cvt_pk_bf16(P[BASE + 6], P[BASE + 7]);                              \
    auto r0 = __builtin_amdgcn_permlane32_swap(a0, b0, false, false); auto r1 = __builtin_amdgcn_permlane32_swap(a1, b1, false, false); \
    u32x4 w = {r0[0], r1[0], r0[1], r1[1]}; OUT = *reinterpret_cast<bf16x8*>(&w); } while (0)
  PK4(p0, 0, pa0); PK4(p0, 8, pa1); PK4(p1, 0, pa2); PK4(p1, 8, pa3);
#undef PK4
}
__device__ __forceinline__ void qkt(f32x16& p0, f32x16& p1, const bf16_t* Ks, const bf16x8* qr, int r32, int hi) {
  p0 = f32x16{}; p1 = f32x16{};
  for (int d0 = 0; d0 < 8; ++d0) { int cb = (d0 * 16 + hi * 8) * 2;
    bf16x8 b0 = *reinterpret_cast<const bf16x8*>((const char*)Ks + KSWZ(r32, cb));
    bf16x8 b1 = *reinterpret_cast<const bf16x8*>((const char*)Ks + KSWZ(32 + r32, cb));
    p0 = __builtin_amdgcn_mfma_f32_32x32x16_bf16(b0, qr[d0], p0, 0, 0, 0);
    p1 = __builtin_amdgcn_mfma_f32_32x32x16_bf16(b1, qr[d0], p1, 0, 0, 0); }
}
__device__ __forceinline__ int v_st(int k, int c) { const int kk = (k & ~0xC) | ((k & 4) << 1) | ((k & 8) >> 1); return ((kk >> 3) * 4 + (c >> 5)) * 512 + ((kk & 7) * 32 + (c & 31)) * 2; }
__device__ __forceinline__ int v_rd_base(int lane) { return ((lane & 3) << 3) | (((lane >> 2) & 3) << 6) | (((lane >> 4) & 1) << 5) | (((lane >> 5) & 1) << 8); }
constexpr int v_rd_off(int d0, int ks, int half) { return d0 * 512 + ks * 4096 + half * 2048; }
template <int OFF> __device__ __forceinline__ s16x4 tr_read(int vb) {
  s16x4 r; asm volatile("ds_read_b64_tr_b16 %0, %1 offset:%2" : "=&v"(r) : "v"(vb), "i"(OFF) : "memory"); return r;
}
struct VFrag { s16x4 l0, h0, l1, h1, l2, h2, l3, h3; };
template <int D0> __device__ __forceinline__ void v_reads(VFrag& f, int vb) {
  f.l0 = tr_read<v_rd_off(D0, 0, 0)>(vb); f.h0 = tr_read<v_rd_off(D0, 0, 1)>(vb); f.l1 = tr_read<v_rd_off(D0, 1, 0)>(vb); f.h1 = tr_read<v_rd_off(D0, 1, 1)>(vb);
  f.l2 = tr_read<v_rd_off(D0, 2, 0)>(vb); f.h2 = tr_read<v_rd_off(D0, 2, 1)>(vb); f.l3 = tr_read<v_rd_off(D0, 3, 0)>(vb); f.h3 = tr_read<v_rd_off(D0, 3, 1)>(vb);
}
__device__ __forceinline__ void pv_mma(f32x16& od, const VFrag& f, bf16x8 pa0, bf16x8 pa1, bf16x8 pa2, bf16x8 pa3) {
#define PK(L, H) (bf16x8){L[0], L[1], L[2], L[3], H[0], H[1], H[2], H[3]}
  od = __builtin_amdgcn_mfma_f32_32x32x16_bf16(pa0, PK(f.l0, f.h0), od, 0, 0, 0);
  od = __builtin_amdgcn_mfma_f32_32x32x16_bf16(pa1, PK(f.l1, f.h1), od, 0, 0, 0);
  od = __builtin_amdgcn_mfma_f32_32x32x16_bf16(pa2, PK(f.l2, f.h2), od, 0, 0, 0);
  od = __builtin_amdgcn_mfma_f32_32x32x16_bf16(pa3, PK(f.l3, f.h3), od, 0, 0, 0);
#undef PK
}
__device__ __forceinline__ void pv_d0(f32x16* o, int vb, bf16x8 pa0, bf16x8 pa1, bf16x8 pa2, bf16x8 pa3) {
  VFrag A, B;
  v_reads<0>(A, vb); v_reads<1>(B, vb);
  asm volatile("s_waitcnt lgkmcnt(8)" ::: "memory"); SBAR(); pv_mma(o[0], A, pa0, pa1, pa2, pa3); SBAR();
  v_reads<2>(A, vb);
  asm volatile("s_waitcnt lgkmcnt(8)" ::: "memory"); SBAR(); pv_mma(o[1], B, pa0, pa1, pa2, pa3); SBAR();
  v_reads<3>(B, vb);
  asm volatile("s_waitcnt lgkmcnt(8)" ::: "memory"); SBAR(); pv_mma(o[2], A, pa0, pa1, pa2, pa3);
  asm volatile("s_waitcnt lgkmcnt(0)" ::: "memory"); SBAR(); pv_mma(o[3], B, pa0, pa1, pa2, pa3);
}
__device__ __forceinline__ void attn_dense_body(const bf16_t* Qb, const bf16_t* Kh, const bf16_t* Vh,
                                                bf16_t* Ob, int seq, LAS unsigned char* ldsl) {
#if MK_FUSED
  int tid_ = threadIdx.x; asm volatile("" : "+v"(tid_)); const int tid = tid_ & 511;
#else
  const int tid = threadIdx.x;
#endif
  char* lds = (char*)ldsl;
  const int wid = tid >> 6, lane = tid & 63, r32 = lane & 31, hi = lane >> 5, widu = __builtin_amdgcn_readfirstlane(wid);
  bf16_t* V_lds = (bf16_t*)lds; bf16_t* K_lds = (bf16_t*)(lds + 3 * SHM_V);
  float* ws = (float*)(lds + 3 * SHM_V + 2 * SHM_K) + wid * 64; float* li_l = ws; float* al_l = ws + 32;
  float m_reg = -1e30f, l_reg = 0; f32x16 o[4] = {}; bf16x8 qr[8];
  const bf16_t* Qw = Qb + (long)(wid * QBLK + r32) * LDQ + hi * 8;
#pragma unroll
  for (int d0 = 0; d0 < 8; ++d0) qr[d0] = *reinterpret_cast<const bf16x8*>(Qw + d0 * 16);
  const int vb0 = (int)(uintptr_t)V_lds + v_rd_base(lane);
  unsigned kof[2], vof[2];
#pragma unroll
  for (int i = 0; i < 2; ++i) { const int sl = i * 512 + tid, row = sl >> 4, ch = (sl & 15) ^ (row & 7);
    kof[i] = (unsigned)(row * LDK + ch * 8) * 2u;
    const int kk = ((sl >> 7) << 3) | ((sl & 31) >> 2), k = (kk & ~0xC) | ((kk & 4) << 1) | ((kk & 8) >> 1), c = ((sl >> 5) & 3) * 32 + (sl & 3) * 8;
    vof[i] = (unsigned)(k * LDK + c) * 2u; }
  const unsigned ldsw = (unsigned)widu * 1024u;
#define ADMA(t, kb, voff) do { const char* kp_ = (const char*)(Kh + (long)(t) * KVBLK * LDK); const char* vp_ = (const char*)(Vh + (long)(t) * KVBLK * LDK); \
    _Pragma("unroll") for (int i_ = 0; i_ < 2; ++i_) { \
      __builtin_amdgcn_global_load_lds((const unsigned*)(kp_ + kof[i_]), (LAS unsigned*)(ldsl + 3 * SHM_V + (kb) * SHM_K + ldsw + i_ * 8192), 16, 0, 0); \
      __builtin_amdgcn_global_load_lds((const unsigned*)(vp_ + vof[i_]), (LAS unsigned*)(ldsl + (voff) + ldsw + i_ * 8192), 16, 0, 0); } } while (0)
#define AWAIT() asm volatile("s_waitcnt vmcnt(0)" ::: "memory")
#define RESC(a) do { if (__any((a) < 1.f)) { if (hi == 0) al_l[r32] = (a); asm volatile("s_waitcnt lgkmcnt(0)" ::: "memory"); \
    for (int d = 0; d < 4; ++d) for (int r = 0; r < 16; ++r) o[d][r] *= al_l[crow(r, hi)]; } } while (0)
  f32x16 pA0, pA1, pB0, pB1; float mnA, mnB, alA, alB; bf16x8 pa0, pa1, pa2, pa3; const int NT = seq / KVBLK;
  int va = 0, vb = (int)SHM_V, vc = 2 * (int)SHM_V;
  ADMA(0, 0, 0); AWAIT(); __syncthreads();
  ADMA(1, 1, (unsigned)SHM_V);
  qkt(pA0, pA1, K_lds, qr, r32, hi); partialSM(pA0, pA1, m_reg, mnA, alA);
  AWAIT();
  for (int t = 1; t + 1 < NT; t += 2) {
    __syncthreads();
    ADMA(t + 1, 0, (unsigned)vc);
    SBAR(); qkt(pB0, pB1, (bf16_t*)((char*)K_lds + SHM_K), qr, r32, hi);
    finishSM(pA0, pA1, alA, l_reg, pa0, pa1, pa2, pa3); SBAR();
    pv_d0(o, vb0 + va, pa0, pa1, pa2, pa3); partialSM(pB0, pB1, m_reg, mnB, alB);
    RESC(alB);
    AWAIT();
    { const int t_ = va; va = vb; vb = vc; vc = t_; }
    __syncthreads();
    if (t + 2 < NT) ADMA(t + 2, 1, (unsigned)vc);
    SBAR(); qkt(pA0, pA1, K_lds, qr, r32, hi);
    finishSM(pB0, pB1, alB, l_reg, pa0, pa1, pa2, pa3); SBAR();
    pv_d0(o, vb0 + va, pa0, pa1, pa2, pa3); partialSM(pA0, pA1, m_reg, mnA, alA);
    RESC(alA);
    AWAIT();
    { const int t_ = va; va = vb; vb = vc; vc = t_; }
  }
  __syncthreads();
  SBAR(); qkt(pB0, pB1, (bf16_t*)((char*)K_lds + SHM_K), qr, r32, hi);
  finishSM(pA0, pA1, alA, l_reg, pa0, pa1, pa2, pa3); SBAR();
  pv_d0(o, vb0 + va, pa0, pa1, pa2, pa3); partialSM(pB0, pB1, m_reg, mnB, alB);
  RESC(alB);
  finishSM(pB0, pB1, alB, l_reg, pa0, pa1, pa2, pa3); SBAR();
  pv_d0(o, vb0 + vb, pa0, pa1, pa2, pa3);
  if (hi == 0) li_l[r32] = l_reg; asm volatile("s_waitcnt lgkmcnt(0)" ::: "memory");
  float rli[16];
#pragma unroll
  for (int r = 0; r < 16; ++r) rli[r] = __builtin_amdgcn_rcpf(li_l[crow(r, hi)]);
  bf16_t* Ow = Ob + (long)(wid * QBLK) * LDO;
#pragma unroll
  for (int r = 0; r < 16; r += 2) {
    const int odd = lane & 1, orow = crow(r + odd, hi);
    for (int d0 = 0; d0 < 4; ++d0) { const float a = o[d0][r] * rli[r], b = o[d0][r + 1] * rli[r + 1];
      const float recv = __shfl_xor(odd ? a : b, 1);
      *(unsigned*)(Ow + (long)orow * LDO + d0 * 32 + (r32 & ~1)) = odd ? cvt_pk_c(recv, b) : cvt_pk_c(a, recv); } }
#undef ADMA
#undef AWAIT
#undef RESC
}
#undef KSWZ
#undef SBAR
}

__device__ __forceinline__ void phase_attention(Frame& F) {
    bf16_t* P = (bf16_t*)(F.ws + WS_PROJ);
    const int vcu = (F.G % 8 == 0) ? (F.bid % 8) * (F.G / 8) + F.bid / 8 : F.bid;
    for (int u = vcu; u < NSEQ * AH * (SEQ / 256); u += F.G) {
        const int qb = u % (SEQ / 256), h = (u / (SEQ / 256)) % AH, b = u / ((SEQ / 256) * AH), kvh = h / (AH / AKV);
        bf16_t* Qb = P + (size_t)(b * SEQ + qb * 256) * PW + PC_Q + h * AD;
        const bf16_t* Kh = P + (size_t)(b * SEQ) * PW + PC_K + kvh * AD; const bf16_t* Vh = P + (size_t)(b * SEQ) * PW + PC_V + kvh * AD;
        att::attn_dense_body(Qb, Kh, Vh, Qb, SEQ, F.lds);
        __syncthreads();
    }
}
__device__ __forceinline__ void phase_xa_softmax(Frame& F) {
    const float* SC = (const float*)(F.ws + WS_SC); bf16_t* Pm = (bf16_t*)(F.ws + WS_P);
    const int gw = F.bid * 8 + F.wave, NGW = F.G * 8, lane = F.lane;
    for (int m = gw; m < T; m += NGW) {
#pragma unroll
        for (int hh = 0; hh < XAH; ++hh) {
            const f32x4 s = *(const f32x4*)(SC + (size_t)m * 1024 + hh * 256 + lane * 4);
            const float mx = wave_max(fmaxf(fmaxf(s.x, s.y), fmaxf(s.z, s.w)));
            const float e0 = __expf(s.x - mx), e1 = __expf(s.y - mx), e2 = __expf(s.z - mx), e3 = __expf(s.w - mx);
            const float inv = 1.0f / wave_sum((e0 + e1) + (e2 + e3));
            u32x2 w; w.x = cvt_pk_bf16(e0 * inv, e1 * inv); w.y = cvt_pk_bf16(e2 * inv, e3 * inv);
            *(u32x2*)(Pm + (size_t)m * 1024 + hh * 256 + lane * 4) = w;
        }
    }
}
__device__ __forceinline__ void phase_ffn_fix(Frame& F, int layer) {
    const bf16_t* SB = (const bf16_t*)(F.ws + WS_SB); bf16_t* ACT = (bf16_t*)(F.ws + WS_ACT);
    const float* cw = inp(I_FCW) + (size_t)layer * 3 * F2; const float* cb = inp(I_FCB) + (size_t)layer * F2;
    const int nitem = (T / 64) * 2 * (DFF / 8);
    for (int it = F.bid * 512 + F.tid; it < nitem; it += F.G * 512) {
        const int oc = it % (DFF / 8), rest = it / (DFF / 8), which = rest & 1, blk = rest >> 1, f = oc * 8, bs = blk % (SEQ / 64);
        const bf16_t* pp = which ? SB + ((size_t)blk * 4 + 2) * F2 : SB + ((size_t)(blk - 1) * 4 + 3) * F2;
        const bf16_t* ps = which ? SB + ((size_t)blk * 4 + 3) * F2 : SB + ((size_t)blk * 4 + 0) * F2;
        const bf16_t* pn = which ? SB + ((size_t)(blk + 1) * 4 + 0) * F2 : SB + ((size_t)blk * 4 + 1) * F2;
        const bool hasp = which ? true : (bs != 0), hasn = which ? (bs != SEQ / 64 - 1) : true;
        float gp[8], gq[8], gn[8], up[8], uq[8], un[8];
        unpack8(*(const u32x4*)(ps + f), gq); unpack8(*(const u32x4*)(ps + DFF + f), uq);
        if (hasp) { unpack8(*(const u32x4*)(pp + f), gp); unpack8(*(const u32x4*)(pp + DFF + f), up); }
        else {
#pragma unroll
            for (int j = 0; j < 8; ++j) { gp[j] = 0.f; up[j] = 0.f; } }
        if (hasn) { unpack8(*(const u32x4*)(pn + f), gn); unpack8(*(const u32x4*)(pn + DFF + f), un); }
        else {
#pragma unroll
            for (int j = 0; j < 8; ++j) { gn[j] = 0.f; un[j] = 0.f; } }
        float o[8];
#pragma unroll
        for (int j = 0; j < 8; ++j) {
            const float G = cb[f + j] + cw[f + j] * gp[j] + cw[F2 + f + j] * gq[j] + cw[2 * F2 + f + j] * gn[j];
            const float U = cb[DFF + f + j] + cw[DFF + f + j] * up[j] + cw[F2 + DFF + f + j] * uq[j] + cw[2 * F2 + DFF + f + j] * un[j];
            o[j] = silu_f(G) * U; }
        *(u32x4*)(ACT + (size_t)(blk * 64 + (which ? 63 : 0)) * DFF + f) = pack8(o);
    }
}

__device__ __forceinline__ void phase_hy_kern(Frame& F, int e) {
    const float* h3 = (const float*)(F.ws + WS_H3); float* KERN = (float*)(F.ws + WS_KERN); const float* wo = inp(I_FWO) + (size_t)e * 64 * 4096;
    typedef float f32x16c __attribute__((ext_vector_type(16)));
    const f32x16c __attribute__((address_space(4)))* wo16 = (const f32x16c __attribute__((address_space(4)))*)(uintptr_t)wo;
    LAS f32x4* hl = (LAS f32x4*)F.lds;
    for (int u = F.bid; u < 16 * 32; u += F.G) {
        const int tb = u & 15, cbk = u >> 4, t = tb * 512 + F.tid;
#pragma unroll
        for (int j = 0; j < 16; ++j) hl[j * 512 + F.tid] = *(const f32x4*)(h3 + (size_t)t * 64 + j * 4);
        const float tl = (float)t / (float)(SEQ - 1);
#pragma unroll 1
        for (int cb16 = 0; cb16 < 8; ++cb16) {
            const int c2b = __builtin_amdgcn_readfirstlane(cbk * 128 + cb16 * 16);
            float a[16];
#pragma unroll
            for (int i = 0; i < 16; ++i) a[i] = 0.f;
#pragma unroll 1
            for (int j4 = 0; j4 < 16; ++j4) {
                const f32x4 h = hl[j4 * 512 + F.tid];
#pragma unroll
                for (int q = 0; q < 4; ++q) { const f32x16c w16 = wo16[((j4 * 4 + q) * 4096 + c2b) >> 4];
#pragma unroll
                    for (int i = 0; i < 16; ++i) a[i] += h[q] * w16[i]; }
            }
#pragma unroll
            for (int i = 0; i < 16; ++i) {
                const int c2 = c2b + i, ch = c2 & (DM - 1);
                const float delta = fabsf(-3.0701134573253944f + (float)ch * ((-15.350567286626972f + 3.0701134573253944f) / (float)(DM - 1)));
                const float val = a[i] * __expf(-tl * delta);
                if (c2 < DM) KERN[(size_t)ch * FFTN + t] = val;
                else { if (t >= 1) KERN[(size_t)ch * FFTN + FFTN - t] = val; else KERN[(size_t)ch * FFTN + SEQ] = 0.f; }
            }
        }
    }
}
__device__ __forceinline__ void phase_hy_tout(Frame& F, int e) {
    const bf16_t* PHT = (const bf16_t*)(F.ws + WS_PHY); const bf16_t* UT = (const bf16_t*)(F.ws + WS_UT); bf16_t* Y = F.h;
    const float* cw = inp(I_HCW) + (size_t)e * 3 * HYW; const float* cb = inp(I_HCB) + (size_t)e * HYW;
    LAS bf16_t* tile = (LAS bf16_t*)(F.lds + F.wave * (64 * 72 * 2));
    const int gw = F.bid * 8 + F.wave, NGW = F.G * 8, lane = F.lane;
    for (int it = gw; it < (T / 64) * (DM / 64); it += NGW) {
        const int cblk = it % (DM / 64), tblk = it / (DM / 64), m0 = tblk * 64, t0 = m0 % SEQ, b = m0 / SEQ, c0 = cblk * 64;
        u32x4 xw[8], yw[8]; unsigned xl[8], xh[8];
#pragma unroll
        for (int ps = 0; ps < 8; ++ps) { const int c = (lane >> 3) + 8 * ps, to = (lane & 7) * 8, ch = c0 + c, t = t0 + to;
            const bf16_t* xr = PHT + (size_t)ch * T + (size_t)b * SEQ + t;
            xw[ps] = *(const u32x4*)xr; yw[ps] = *(const u32x4*)(UT + ((size_t)(b * DM + ch)) * SEQ + t);
            xl[ps] = t > 0 ? (unsigned)xr[-1] : 0u; xh[ps] = t + 8 < SEQ ? (unsigned)xr[8] : 0u; }
#pragma unroll
        for (int ps = 0; ps < 8; ++ps) {
            const int c = (lane >> 3) + 8 * ps, to = (lane & 7) * 8, ch = c0 + c;
            float x[10], y[8];
            unpack8(xw[ps], *(float (*)[8])&x[1]); unpack8(yw[ps], y);
            x[0] = bf2f(xl[ps]); x[9] = bf2f(xh[ps]);
            const float w0 = cw[ch], w1 = cw[HYW + ch], w2 = cw[2 * HYW + ch], bb = cb[ch];
            float ov[8];
#pragma unroll
            for (int j = 0; j < 8; ++j) ov[j] = (bb + w0 * x[j] + w1 * x[j + 1] + w2 * x[j + 2]) * y[j];
            *(LAS u32x4*)(tile + c * 72 + to) = pack8(ov);
        }
        LDS_WAIT(); asm volatile("" ::: "memory");
        const int o = lane & 7, rs = lane >> 3;
        for (int ps = 0; ps < 8; ++ps) {
            const int r = rs + 8 * ps; unsigned short v[8];
#pragma unroll
            for (int j = 0; j < 8; ++j) v[j] = tile[(o * 8 + j) * 72 + r];
            u32x4 w; w.x = v[0] | ((unsigned)v[1] << 16); w.y = v[2] | ((unsigned)v[3] << 16); w.z = v[4] | ((unsigned)v[5] << 16); w.w = v[6] | ((unsigned)v[7] << 16);
            *(u32x4*)(Y + (size_t)(m0 + r) * DM + c0 + o * 8) = w;
        }
        LDS_WAIT(); asm volatile("" ::: "memory");
    }
}
__device__ __forceinline__ f32x2 mk2(float a, float b) { f32x2 r; r.x = a; r.y = b; return r; }
__device__ __forceinline__ void dft16(f32x2 (&x)[16]) {
  f32x2 a[4][4];
  { const f32x2 s0 = x[0] + x[8], s1 = x[0] - x[8], s2 = x[4] + x[12], t3 = x[4] - x[12]; const f32x2 s3 = mk2(t3.y, -t3.x);
    a[0][0] = s0 + s2; a[0][1] = s1 + s3; a[0][2] = s0 - s2; a[0][3] = s1 - s3; }
  { const f32x2 s0 = x[1] + x[9], s1 = x[1] - x[9], s2 = x[5] + x[13], t3 = x[5] - x[13]; const f32x2 s3 = mk2(t3.y, -t3.x);
    a[1][0] = s0 + s2; a[1][1] = s1 + s3; a[1][2] = s0 - s2; a[1][3] = s1 - s3; }
  { const f32x2 s0 = x[2] + x[10], s1 = x[2] - x[10], s2 = x[6] + x[14], t3 = x[6] - x[14]; const f32x2 s3 = mk2(t3.y, -t3.x);
    a[2][0] = s0 + s2; a[2][1] = s1 + s3; a[2][2] = s0 - s2; a[2][3] = s1 - s3; }
  { const f32x2 s0 = x[3] + x[11], s1 = x[3] - x[11], s2 = x[7] + x[15], t3 = x[7] - x[15]; const f32x2 s3 = mk2(t3.y, -t3.x);
    a[3][0] = s0 + s2; a[3][1] = s1 + s3; a[3][2] = s0 - s2; a[3][3] = s1 - s3; }
  a[1][1] = mk2(a[1][1].x * 0.9238795325112867f - a[1][1].y * -0.3826834323650898f, a[1][1].x * -0.3826834323650898f + a[1][1].y * 0.9238795325112867f);
  a[1][2] = mk2(a[1][2].x * 0.7071067811865476f - a[1][2].y * -0.7071067811865475f, a[1][2].x * -0.7071067811865475f + a[1][2].y * 0.7071067811865476f);
  a[1][3] = mk2(a[1][3].x * 0.38268343236508984f - a[1][3].y * -0.9238795325112867f, a[1][3].x * -0.9238795325112867f + a[1][3].y * 0.38268343236508984f);
  a[2][1] = mk2(a[2][1].x * 0.7071067811865476f - a[2][1].y * -0.7071067811865475f, a[2][1].x * -0.7071067811865475f + a[2][1].y * 0.7071067811865476f);
  a[2][2] = mk2(a[2][2].x * 6.123233995736766e-17f - a[2][2].y * -1.0f, a[2][2].x * -1.0f + a[2][2].y * 6.123233995736766e-17f);
  a[2][3] = mk2(a[2][3].x * -0.7071067811865475f - a[2][3].y * -0.7071067811865476f, a[2][3].x * -0.7071067811865476f + a[2][3].y * -0.7071067811865475f);
  a[3][1] = mk2(a[3][1].x * 0.38268343236508984f - a[3][1].y * -0.9238795325112867f, a[3][1].x * -0.9238795325112867f + a[3][1].y * 0.38268343236508984f);
  a[3][2] = mk2(a[3][2].x * -0.7071067811865475f - a[3][2].y * -0.7071067811865476f, a[3][2].x * -0.7071067811865476f + a[3][2].y * -0.7071067811865475f);
  a[3][3] = mk2(a[3][3].x * -0.9238795325112868f - a[3][3].y * 0.38268343236508967f, a[3][3].x * 0.38268343236508967f + a[3][3].y * -0.9238795325112868f);
  { const f32x2 s0 = a[0][0] + a[2][0], s1 = a[0][0] - a[2][0], s2 = a[1][0] + a[3][0], t3 = a[1][0] - a[3][0]; const f32x2 s3 = mk2(t3.y, -t3.x);
    x[0] = s0 + s2; x[4] = s1 + s3; x[8] = s0 - s2; x[12] = s1 - s3; }
  { const f32x2 s0 = a[0][1] + a[2][1], s1 = a[0][1] - a[2][1], s2 = a[1][1] + a[3][1], t3 = a[1][1] - a[3][1]; const f32x2 s3 = mk2(t3.y, -t3.x);
    x[1] = s0 + s2; x[5] = s1 + s3; x[9] = s0 - s2; x[13] = s1 - s3; }
  { const f32x2 s0 = a[0][2] + a[2][2], s1 = a[0][2] - a[2][2], s2 = a[1][2] + a[3][2], t3 = a[1][2] - a[3][2]; const f32x2 s3 = mk2(t3.y, -t3.x);
    x[2] = s0 + s2; x[6] = s1 + s3; x[10] = s0 - s2; x[14] = s1 - s3; }
  { const f32x2 s0 = a[0][3] + a[2][3], s1 = a[0][3] - a[2][3], s2 = a[1][3] + a[3][3], t3 = a[1][3] - a[3][3]; const f32x2 s3 = mk2(t3.y, -t3.x);
    x[3] = s0 + s2; x[7] = s1 + s3; x[11] = s0 - s2; x[15] = s1 - s3; }
}
constexpr int FFT_PAD_ELEMS = FFTN + FFTN / 16;
__device__ __forceinline__ int pidx(int i) { return i + (i >> 4); }
__device__ __forceinline__ f32x2 cmul(f32x2 a, f32x2 b) { return mk2(a.x * b.x - a.y * b.y, a.x * b.y + a.y * b.x); }
template <bool HALF_IN, int P>
__device__ __forceinline__ void fft_pass16(LAS f32x2* data, const f32x2* tw, f32x2 (&v)[32], int tid) {
    constexpr int sh = 4 * P, Ns = 1 << sh, pst = Ns + (Ns >> 4);
    { const LAS f32x2* rd = data + pidx(tid);
#pragma unroll
      for (int i = 0; i < 2; ++i)
#pragma unroll
          for (int r = 0; r < 16; ++r) { if (HALF_IN && P == 0 && r >= 8) v[16 * i + r] = mk2(0.f, 0.f); else v[16 * i + r] = rd[544 * i + 1088 * r]; } }
    LDS_BARRIER();
#pragma unroll
    for (int i = 0; i < 2; ++i) { const int j = tid + 512 * i, k = j & (Ns - 1);
        f32x2 (&x)[16] = *(f32x2 (*)[16])&v[16 * i];
        if (P > 0) {
            const f32x2 w1 = tw[k * (1024 >> sh)];
            const f32x2 w2 = cmul(w1, w1), w4 = cmul(w2, w2), w8 = cmul(w4, w4);
            x[1] = cmul(x[1], w1); x[2] = cmul(x[2], w2); x[4] = cmul(x[4], w4); x[8] = cmul(x[8], w8);
            { const f32x2 w3 = cmul(w2, w1); x[3] = cmul(x[3], w3); x[6] = cmul(x[6], cmul(w3, w3)); x[11] = cmul(x[11], cmul(w8, w3));
              const f32x2 w7 = cmul(w4, w3); x[7] = cmul(x[7], w7); x[14] = cmul(x[14], cmul(w7, w7)); x[15] = cmul(x[15], cmul(w8, w7)); x[12] = cmul(x[12], cmul(w8, w4)); }
            { const f32x2 w5 = cmul(w4, w1); x[5] = cmul(x[5], w5); x[10] = cmul(x[10], cmul(w5, w5)); x[13] = cmul(x[13], cmul(w8, w5)); x[9] = cmul(x[9], cmul(w8, w1)); }
        }
        dft16(x);
        LAS f32x2* wr = data + pidx(((j >> sh) << (sh + 4)) + k);
#pragma unroll
        for (int r = 0; r < 16; ++r) wr[r * pst] = x[r];
        __builtin_amdgcn_sched_barrier(0); }
    LDS_BARRIER();
}
template <bool HALF_IN>
__device__ __forceinline__ void fft16k(LAS f32x2* data, const f32x2* tw, f32x2 (&v)[32], int tid) {
    fft_pass16<HALF_IN, 0>(data, tw, v, tid); fft_pass16<HALF_IN, 1>(data, tw, v, tid); fft_pass16<HALF_IN, 2>(data, tw, v, tid);
    { const LAS f32x2* rd = data + pidx(tid);
#pragma unroll
      for (int i = 0; i < 8; ++i)
#pragma unroll
          for (int r = 0; r < 4; ++r) v[4 * i + r] = rd[544 * i + 4352 * r]; }
    LDS_BARRIER();
#pragma unroll
    for (int i = 0; i < 8; ++i) { const int j = tid + 512 * i;
        const f32x2 w1 = tw[j], w2 = cmul(w1, w1), w3 = cmul(w2, w1);
        const f32x2 x0 = v[4 * i], x1 = cmul(v[4 * i + 1], w1), x2 = cmul(v[4 * i + 2], w2), x3 = cmul(v[4 * i + 3], w3);
        const f32x2 a = x0 + x2, bq = x0 - x2, c = x1 + x3, d0 = x1 - x3; const f32x2 d = mk2(d0.y, -d0.x);
        v[4 * i] = a + c; v[4 * i + 1] = bq + d; v[4 * i + 2] = a - c; v[4 * i + 3] = bq - d; }
}
__device__ __forceinline__ void phase_hy_fft(Frame& F, int e) {
    LAS f32x2* data = (LAS f32x2*)F.lds; LAS float* red = (LAS float*)(F.lds + FFT_PAD_ELEMS * 8);
    const float* KERN = (const float*)(F.ws + WS_KERN); bf16_t* UT = (bf16_t*)(F.ws + WS_UT); const f32x2* tw = (const f32x2*)(F.ws + WS_TW);
    const bf16_t* PHT = (const bf16_t*)(F.ws + WS_PHY); const float* hcw = inp(I_HCW) + (size_t)e * 3 * HYW; const float* hcb = inp(I_HCB) + (size_t)e * HYW;
    const int tid = F.tid & 511, lane = F.lane, wave = F.wave; const unsigned utid = (unsigned)tid;
    const int pt = pidx(tid), pt8 = 8 * tid + (tid >> 1);
    for (int ch = F.bid; ch < DM; ch += F.G) {
        float asum = 0.f;
        for (int i = 0; i < 32; ++i) { const float val = (KERN + (size_t)ch * FFTN + 512 * i)[utid]; data[pt + 544 * i] = mk2(val, 0.f); asum += fabsf(val); }
        asum = wave_sum(asum);
        if (lane == 0) red[wave] = asum;
        LDS_BARRIER();
        float tot = 0.f;
#pragma unroll
        for (int w = 0; w < 8; ++w) tot += red[w];
        const float kscale = 1.0f / (tot * (float)FFTN), skip = inp(I_HSKIP)[e * DM + ch] * (1.0f / (float)FFTN);
        f32x2 v[32];
        f32x2* ks = (f32x2*)(F.ws + WS_KS) + (size_t)F.bid * FFTN;
        fft16k<false>(data, tw, v, tid);
#pragma unroll
        for (int q = 0; q < 32; ++q) (ks + q * 512)[utid] = mk2(v[q].x * kscale + skip, v[q].y * kscale);
        LDS_BARRIER();
        for (int pi = 0; pi < 3; ++pi) {
            const int b0 = 2 * pi, b1 = 2 * pi + 1;
            bf16_t* u0 = UT + ((size_t)(b0 * DM + ch)) * SEQ; bf16_t* u1 = UT + ((size_t)((b1 < NSEQ ? b1 : b0) * DM + ch)) * SEQ;
            {
              const float a0 = hcw[2048 + ch], a1 = hcw[HYW + 2048 + ch], a2 = hcw[2 * HYW + 2048 + ch], ab = hcb[2048 + ch];
              const float c0 = hcw[4096 + ch], c1 = hcw[HYW + 4096 + ch], c2 = hcw[2 * HYW + 4096 + ch], cbv = hcb[4096 + ch];
              const bf16_t* r1 = PHT + (size_t)(2048 + ch) * T; const bf16_t* rv = PHT + (size_t)(4096 + ch) * T;
#pragma unroll
              for (int i = 0; i < 2; ++i) { const unsigned t8 = (utid + 512u * i) * 8u; float pr[2][8];
#pragma unroll
                  for (int q = 0; q < 2; ++q) { const int bq = q ? b1 : b0;
                      if (bq < NSEQ) { const bf16_t* p1 = r1 + (size_t)bq * SEQ + t8; const bf16_t* pv = rv + (size_t)bq * SEQ + t8; float x[10], w[10];
                          unpack8(*(const u32x4*)p1, *(float (*)[8])&x[1]); unpack8(*(const u32x4*)pv, *(float (*)[8])&w[1]);
                          x[0] = t8 > 0u ? bf2f(p1[-1]) : 0.f; x[9] = t8 + 8u < (unsigned)SEQ ? bf2f(p1[8]) : 0.f;
                          w[0] = t8 > 0u ? bf2f(pv[-1]) : 0.f; w[9] = t8 + 8u < (unsigned)SEQ ? bf2f(pv[8]) : 0.f;
#pragma unroll
                          for (int j = 0; j < 8; ++j) pr[q][j] = (ab + a0 * x[j] + a1 * x[j + 1] + a2 * x[j + 2]) * (cbv + c0 * w[j] + c1 * w[j + 1] + c2 * w[j + 2]); }
                      else {
#pragma unroll
                          for (int j = 0; j < 8; ++j) pr[q][j] = 0.f; } }
#pragma unroll
                  for (int j = 0; j < 8; ++j) data[pt8 + 4352 * i + j] = mk2(pr[0][j], pr[1][j]); } }
            LDS_BARRIER();
            fft16k<true>(data, tw, v, tid);
            LDS_BARRIER();
#pragma unroll
            for (int i = 0; i < 8; ++i)
#pragma unroll
                for (int r = 0; r < 4; ++r) { const f32x2 a = v[4 * i + r], k = (ks + (4 * i + r) * 512)[utid];
                    data[pt + 544 * i + 4352 * r] = mk2(a.x * k.x - a.y * k.y, -(a.x * k.y + a.y * k.x)); }
            LDS_BARRIER();
            fft16k<false>(data, tw, v, tid);
#pragma unroll
            for (int i = 0; i < 8; ++i)
#pragma unroll
                for (int r = 0; r < 2; ++r) { (u0 + 512 * i + 4096 * r)[utid] = f2bf(v[4 * i + r].x); if (b1 < NSEQ) (u1 + 512 * i + 4096 * r)[utid] = f2bf(-v[4 * i + r].y); }
            LDS_BARRIER();
        }
    }
}
constexpr int SPL = 32;
#ifndef EVEN_ON
#define EVEN_ON 1
#endif
#ifndef ODD_ON
#define ODD_ON 1
#endif
#ifndef STEPMASK
#define STEPMASK 0xffffffffu
#endif
#define RUN(k) ((ONLY >= 0) ? ((k) == ONLY) : ((((STEPMASK >> (k)) & 1u) != 0u) && (layer * SPL + (k)) >= args.s_lo && (layer * SPL + (k)) < args.s_hi))
#define PH() do { int t_ = threadIdx.x; asm volatile("" : "+v"(t_)); F.tid = t_; F.lane = t_ & 63; F.wave = __builtin_amdgcn_readfirstlane(t_ >> 6); } while (0)
#ifndef MK_DUP
#define MK_DUP 0u
#endif
#define REP(k) for (int rep_ = 0; rep_ < (((MK_DUP >> (k)) & 1u) ? 2 : 1); ++rep_)
#define SEAM() do { if (ONLY < 0) xcd_barrier(bar); } while (0)
template <int ONLY, int PAR, int LAYER> __device__ __forceinline__ void layer_body(const Args& args, Frame& F, const XcdBarrier& bar) {
    unsigned char* ws = args.ws;
    bf16_t* H = F.h;
    const int layer = (LAYER >= 0) ? LAYER : args.l_lo;
    {
        const int e = layer >> 1;
        if (RUN(0)) { PH(); REP(0) phase_prep(F, layer); SEAM(); }
        if (!(layer & 1) && EVEN_ON && PAR != 1) {
            bf16_t* PR = (bf16_t*)(ws + WS_PROJ);
            if (RUN(1)) { PH();
                { pg8::Gemm g{H, (const bf16_t*)(ws + W_IN), DM, DM, DM, T / 256, PW / 256, 1, 1, 0, 0, 0, 0}; pg8::Order S; S.init(g, F.G, F.bid);
                  pg8::EpiBf16 E{PR, PW, 1, 0, 0, 1.0f}; pg8::gemm_phase(F.lds, g, S, E); }
                { pg8::Gemm g{H, (const bf16_t*)(ws + W_DT), DM, DM, DM, T / 256, 1, 1, 1, 0, 0, 0, 0}; pg8::Order S; S.init(g, F.G, F.bid);
                  pg8::EpiDt E{(float*)(ws + WS_DT), inp(I_DTB) + e * 64}; pg8::gemm_phase(F.lds, g, S, E); }
                { pg8::Gemm g{(const bf16_t*)(ws + WS_MEMN), (const bf16_t*)(ws + W_K), DM, DM, DM, MROWS / 256, DM / 256, 1, 1, 0, 0, 0, 0}; pg8::Order S; S.init(g, F.G, (F.bid + F.G - 160) % F.G);
                  pg8::EpiBf16 E{(bf16_t*)(ws + WS_MK), DM, 1, 0, 0, 1.0f}; pg8::gemm_phase(F.lds, g, S, E); }
                { pg8::Gemm g{(const bf16_t*)(ws + WS_MEMN), (const bf16_t*)(ws + W_V), DM, DM, DM, MROWS / 256, DM / 256, 1, 1, 0, 0, 0, 0}; pg8::Order S; S.init(g, F.G, (F.bid + F.G - 200) % F.G);
                  pg8::EpiBf16 E{(bf16_t*)(ws + WS_MV), DM, 1, 0, 0, 1.0f}; pg8::gemm_phase(F.lds, g, S, E); }
                SEAM();
            }
            if (RUN(2)) { PH(); REP(2) phase_ssd_conv(F, e); phase_qk_rope(F, e); SEAM(); }
            if (RUN(3)) { PH(); REP(3) phase_ssd_states(F, e); SEAM(); }
            if (RUN(4)) { PH(); phase_ssd_scan(F); SEAM(); }
            if (RUN(5)) { PH(); REP(5) phase_ssd_out(F, e); SEAM(); }
            if (RUN(6)) { PH(); phase_attention(F); SEAM(); }
            if (RUN(7)) { PH(); phase_ssd_gate_norm(F, e); SEAM(); }
            if (RUN(8)) { PH();
                pg8::Gemm g{PR, (const bf16_t*)(ws + W_OUT), PW, 4096, 4096, T / 256, DM / 256, 1, 1, 0, 0, 0, 0}; pg8::Order S; S.init(g, F.G, F.bid);
                pg8::EpiResAddPS E{F.x16, DM, (float*)(ws + WS_PS)}; pg8::gemm_phase(F.lds, g, S, E);
                { pg8::Gemm g{(const bf16_t*)(ws + WS_MK), (const bf16_t*)(ws + W_Q), DM, DM, XAD, 1, DM / 256, NSEQ * XAH, XAH, (long)NMEM * DM, XAD, 0, XAD}; pg8::Order S; S.init(g, F.G, F.bid);
                  pg8::EpiBf16G E{(bf16_t*)(ws + WS_WQK), DM, XAH, (long)XAH * NMEM * DM, (long)NMEM * DM, inp(I_NXA) + (size_t)layer * DM}; pg8::gemm_phase(F.lds, g, S, E); }
                SEAM();
            }
        } else if ((layer & 1) && ODD_ON && PAR != 0) {
            if (RUN(1)) { PH();
                { pg8::Gemm g{(const bf16_t*)(ws + HW_IN), H, DM, DM, DM, HYW / 256, T / 256, 1, 1, 0, 0, 0, 0}; pg8::Order S; S.init(g, F.G, F.bid);
                  pg8::EpiBf16 E{(bf16_t*)(ws + WS_PHY), T, 1, 0, 0, 1.0f}; pg8::gemm_phase(F.lds, g, S, E); }
                { pg8::Gemm g{(const bf16_t*)(ws + WS_MEMN), (const bf16_t*)(ws + W_K), DM, DM, DM, MROWS / 256, DM / 256, 1, 1, 0, 0, 0, 0}; pg8::Order S; S.init(g, F.G, F.bid);
                  pg8::EpiBf16 E{(bf16_t*)(ws + WS_MK), DM, 1, 0, 0, 1.0f}; pg8::gemm_phase(F.lds, g, S, E); }
                { pg8::Gemm g{(const bf16_t*)(ws + WS_MEMN), (const bf16_t*)(ws + W_V), DM, DM, DM, MROWS / 256, DM / 256, 1, 1, 0, 0, 0, 0}; pg8::Order S; S.init(g, F.G, (F.bid + F.G - 40) % F.G);
                  pg8::EpiBf16 E{(bf16_t*)(ws + WS_MV), DM, 1, 0, 0, 1.0f}; pg8::gemm_phase(F.lds, g, S, E); }
                REP(24) phase_hy_kern(F, e);
                SEAM();
            }
            if (RUN(3)) { PH(); phase_hy_fft(F, e); SEAM(); }
            if (RUN(4)) { PH(); REP(26) phase_hy_tout(F, e); SEAM(); }
            if (RUN(5)) { PH();
                pg8::Gemm g{H, (const bf16_t*)(ws + HW_OUT), DM, DM, DM, T / 256, DM / 256, 1, 1, 0, 0, 0, 0}; pg8::Order S; S.init(g, F.G, F.bid);
                pg8::EpiResAddPS E{F.x16, DM, (float*)(ws + WS_PS)}; pg8::gemm_phase(F.lds, g, S, E);
                { pg8::Gemm g{(const bf16_t*)(ws + WS_MK), (const bf16_t*)(ws + W_Q), DM, DM, XAD, 1, DM / 256, NSEQ * XAH, XAH, (long)NMEM * DM, XAD, 0, XAD}; pg8::Order S; S.init(g, F.G, F.bid);
                  pg8::EpiBf16G E{(bf16_t*)(ws + WS_WQK), DM, XAH, (long)XAH * NMEM * DM, (long)NMEM * DM, inp(I_NXA) + (size_t)layer * DM}; pg8::gemm_phase(F.lds, g, S, E); }
                SEAM();
            }
        }
        if (RUN(10)) { PH();
            pg8::Gemm g{F.x16, (const bf16_t*)(ws + WS_WQK), DM, DM, DM, SEQ / 256, (XAH * NMEM) / 256, NSEQ, 1, (long)SEQ * DM, 0, (long)XAH * NMEM * DM, 0}; pg8::Order S; S.init(g, F.G, F.bid);
            pg8::EpiSoftmax E{(bf16_t*)(ws + WS_P), XAH * NMEM, (long)SEQ * XAH * NMEM, 0.044194173824159216f * 1.4426950408889634f, (LAS float*)(F.lds + pg8::STAGE_BYTES), (const float*)(ws + WS_PS)}; pg8::gemm_phase(F.lds, g, S, E);
            if (2 * F.bid >= F.G) { pg8::Gemm g2{(const bf16_t*)(ws + W_O), (const bf16_t*)(ws + WS_MV), DM, DM, XAD, DM / 256, 1, NSEQ * XAH, XAH, 0, XAD, (long)NMEM * DM, XAD}; pg8::Order S2; S2.init(g2, F.G - F.G / 2, F.bid - F.G / 2);
                  pg8::EpiBf16 E2{(bf16_t*)(ws + WS_VWOT), XAH * NMEM, XAH, (long)DM * XAH * NMEM, NMEM, 1.0f}; pg8::gemm_phase(F.lds, g2, S2, E2); }
            SEAM();
        }
        if (RUN(14)) { PH();
            pg8::Gemm g{(const bf16_t*)(ws + WS_P), (const bf16_t*)(ws + WS_VWOT), XAH * NMEM, XAH * NMEM, XAH * NMEM, SEQ / 256, DM / 256, NSEQ, 1, (long)SEQ * XAH * NMEM, 0, (long)DM * XAH * NMEM, 0}; pg8::Order S; S.init(g, F.G, F.bid);
            pg8::EpiResAdd E{F.x16, DM, (long)SEQ * DM}; pg8::gemm_phase(F.lds, g, S, E);
            SEAM();
        }
        if (RUN(15)) { PH(); REP(15) phase_rms_x(F, inp(I_NFFN) + (size_t)layer * DM, false); SEAM(); }
        if (RUN(16)) { PH();
            pg8::Gemm g{H, (const bf16_t*)(ws + W_FIN), DM, DM, DM, T / 256, F2 / 256, 1, 1, 0, 0, 0, 0}; pg8::Order S; S.init(g, F.G, F.bid);
            pg8::EpiFfnGate E{(bf16_t*)(ws + WS_ACT), (bf16_t*)(ws + WS_SB), inp(I_FCW) + (size_t)layer * 3 * F2, inp(I_FCB) + (size_t)layer * F2}; pg8::gemm_phase(F.lds, g, S, E);
            SEAM();
        }
        if (RUN(17)) { PH(); phase_ffn_fix(F, layer); SEAM(); }
        if (RUN(21)) { PH();
            pg8::Gemm g{(const bf16_t*)(ws + WS_ACT), (const bf16_t*)(ws + W_FOUT), DFF, DFF, DFF, T / 256, DM / 256, 1, 1, 0, 0, 0, 0}; pg8::Order S; S.init(g, F.G, F.bid);
            pg8::EpiResAdd E{F.x16, DM, 0}; pg8::gemm_phase(F.lds, g, S, E);
            SEAM();
        }
        if (layer == 3 && RUN(22)) { PH(); phase_final_norm(F); }
    }
}
#undef RUN
#undef SEAM
#undef PH
#undef REP
template <int ONLY, int PAR> __device__ __forceinline__ void program(const Args& args) {
    extern __shared__ __attribute__((aligned(16))) unsigned char lds_raw[];
    Frame F;
    F.lds = (LAS unsigned char*)lds_raw;
    F.tid = threadIdx.x; F.lane = F.tid & 63; F.wave = __builtin_amdgcn_readfirstlane(F.tid >> 6);
    F.G = gridDim.x; F.bid = blockIdx.x;
    F.out = args.out; F.ws = args.ws; F.h = (bf16_t*)args.out; F.x16 = (bf16_t*)(args.ws + WS_H);
    unsigned char* ws = args.ws;
    volatile LAS unsigned* MISC = (volatile LAS unsigned*)(F.lds + LDS_CTL);
    if (F.tid < 64) MISC[F.tid] = 0u;
    __syncthreads();
    XcdBarrier bar; bar.bar = (unsigned*)(ws + WS_CTL) + 4096; bar.x = 0; bar.st = nullptr;
    if (ONLY < 0) bar = xcd_barrier_post((unsigned*)(ws + WS_CTL) + 4096, MISC + 8);
    if (ONLY >= 0) layer_body<ONLY, PAR, -1>(args, F, bar);
    else { layer_body<-1, 0, 0>(args, F, bar); layer_body<-1, 1, 1>(args, F, bar); layer_body<-1, 0, 2>(args, F, bar); layer_body<-1, 1, 3>(args, F, bar); }
}
template <int ONLY, int PAR> __global__ void __launch_bounds__(512, 2) trunk_step(Args args) { program<ONLY, PAR>(args); }
__global__ void __launch_bounds__(512, 2) trunk_fwd(Args args) { program<-1, -1>(args); }
typedef void (*StepFn)(Args);
template <int K> struct StepTab { static void fill(StepFn (*t)[2]) { t[K][0] = trunk_step<K, 0>; t[K][1] = trunk_step<K, (K <= 5) ? 1 : 0>; StepTab<K - 1>::fill(t); } };
template <> struct StepTab<-1> { static void fill(StepFn (*)[2]) {} };

static const int kSteps[2][23] = {
    {0, 1, 2, 3, 4, 5, 6, 7, 8, 9, 10, 12, 14, 15, 16, 17, 21, 22, -1, -1, -1, -1, -1},
    {0, 1, 3, 4, 5, 9, 10, 12, 14, 15, 16, 17, 21, 22, -1, -1, -1, -1, -1, -1, -1, -1, -1}};
static StepFn g_steps[23][2];
extern "C" void kernel_launch(void* const* d_in, const int* in_sizes, int n_in, void* d_out, int out_size, void* d_ws, size_t ws_size, hipStream_t stream) {
    static int grid = 0;
    if (grid == 0) {
        if (n_in != 40 || out_size != T * DM || ws_size < WS_END) { fprintf(stderr, "kernel_launch: unexpected shapes: n_in %d out %d ws %zu (need %zu)\n", n_in, out_size, ws_size, (size_t)WS_END); grid = -1; return; }
        int dev = 0, cus = 0;
        if (hipGetDevice(&dev) != hipSuccess || hipDeviceGetAttribute(&cus, hipDeviceAttributeMultiprocessorCount, dev) != hipSuccess) { grid = -1; return; }
        if (hipFuncSetAttribute((const void*)trunk_fwd, hipFuncAttributeMaxDynamicSharedMemorySize, LDS_BYTES) != hipSuccess) { fprintf(stderr, "kernel_launch: hipFuncSetAttribute failed\n"); grid = -1; return; }
#if MK_FUSED != 1
        StepTab<22>::fill(g_steps);
        for (int k = 0; k < 23; ++k) for (int p = 0; p < 2; ++p)
            if (hipFuncSetAttribute((const void*)g_steps[k][p], hipFuncAttributeMaxDynamicSharedMemorySize, LDS_BYTES) != hipSuccess) { fprintf(stderr, "kernel_launch: hipFuncSetAttribute failed (step %d)\n", k); grid = -1; return; }
#endif
        (void)hipGetLastError();
        grid = cus;
    }
    if (grid < 0) return;
    (void)hipMemsetAsync((char*)d_ws + WS_CTL, 0, CTL_BYTES, stream);
    Args a{};
    for (int i = 0; i < 40; ++i) a.in[i] = (const float*)d_in[i];
    a.out = (float*)d_out; a.ws = (unsigned char*)d_ws;
#if MK_FUSED == 1
    { static const int cuts[] = { MK_CUTS };
      const int ncut = (int)(sizeof(cuts) / sizeof(cuts[0]));
      for (int ci = 0; ci + 1 < ncut; ++ci) {
          if (ci > 0) (void)hipMemsetAsync((char*)d_ws + WS_CTL, 0, CTL_BYTES, stream);
          a.l_lo = 0; a.l_hi = 4; a.s_lo = cuts[ci]; a.s_hi = cuts[ci + 1]; a.fused = 1; a.pad = 0;
          hipLaunchKernelGGL(trunk_fwd, dim3(grid), dim3(512), LDS_BYTES, stream, a); } }
#else
    for (int layer = 0; layer < 4; ++layer)
        for (int si = 0; si < 23; ++si) {
            const int k = kSteps[layer & 1][si]; if (k < 0) continue; if (k == 22 && layer != 3) continue;
            a.l_lo = layer; a.l_hi = layer + 1; a.s_lo = layer * SPL + k; a.s_hi = a.s_lo + 1; a.fused = 0; a.pad = 0;
#if MK_FUSED == 2
            if (((MK_FSET >> k) & 1u) && (layer & 1) == MK_FPAR) { (void)hipMemsetAsync((char*)d_ws + WS_CTL, 0, CTL_BYTES, stream); a.l_lo = 0; a.l_hi = 4; hipLaunchKernelGGL(trunk_fwd, dim3(grid), dim3(512), LDS_BYTES, stream, a); continue; }
#endif
            hipLaunchKernelGGL(g_steps[k][layer & 1], dim3(grid), dim3(512), LDS_BYTES, stream, a);
        }
#endif
    const hipError_t le = hipPeekAtLastError();
    if (le != hipSuccess) fprintf(stderr, "kernel_launch: launch failed: %s\n", hipGetErrorName(le));
}
```
